# Optimizing an MI355X kernel written in HIP

```python
import math
import jax
import jax.numpy as jnp
from jax import lax
import numpy as np

D_MODEL = 1024
BATCH = 8
SEQ = 4096
DEPTH = 1

N_ATTN_HEADS = 8
HEAD_DIM = 64
D_ATTN = N_ATTN_HEADS * HEAD_DIM
ROT_DIM = HEAD_DIM // 4
ROPE_THETA = 500000.0
MOBA_BLOCK = 256
MOBA_TOPK = 3
MOBA_Q_CHUNK = 32

N_SSM_HEADS = 16
SSM_HEAD_DIM = 64
D_SSM = N_SSM_HEADS * SSM_HEAD_DIM
SSM_GROUPS = 2
SSM_HEADS_PER_GROUP = N_SSM_HEADS // SSM_GROUPS
D_STATE = 128
CONV_K = 4
SSD_CHUNK = 256
D_CONV = D_SSM + 2 * SSM_GROUPS * D_STATE
DT_MIN = 0.001
DT_MAX = 0.1

D_MIX = D_ATTN + D_SSM
D_IN_PROJ = 3 * D_ATTN + D_SSM + D_CONV + N_SSM_HEADS
SPLIT_POINTS = (D_ATTN, 2 * D_ATTN, 3 * D_ATTN, 3 * D_ATTN + D_SSM, 3 * D_ATTN + D_SSM + D_CONV)
D_FF = 2816
FFN_RESIDUAL_WEIGHT = 0.5
EPS = 1e-6

kernel_name = "hymba_moba_ssd_macaron_layer"


def rms_norm(x, w):
    xf = x.astype(jnp.float32)
    y = xf * lax.rsqrt(jnp.mean(xf * xf, axis=-1, keepdims=True) + EPS)
    return (y * w.astype(jnp.float32)).astype(x.dtype)


def swiglu(h, w1, w3, w2):
    return (jax.nn.silu(h @ w1) * (h @ w3)) @ w2


def pad_seq(t, axis, multiple):
    pad = (-t.shape[axis]) % multiple
    widths = [(0, 0)] * t.ndim
    widths[axis] = (0, pad)
    return jnp.pad(t, widths)


def rotary_tables(seq_len):
    inv_freq = ROPE_THETA ** (-jnp.arange(0, ROT_DIM, 2, dtype=jnp.float32) / ROT_DIM)
    ang = jnp.arange(seq_len, dtype=jnp.float32)[:, None] * inv_freq[None, :]
    return jnp.cos(ang), jnp.sin(ang)


def partial_rotary(t, cos, sin):
    half = ROT_DIM // 2
    tf = t[..., :ROT_DIM].astype(jnp.float32)
    r1, r2 = tf[..., :half], tf[..., half:]
    rot = jnp.concatenate([r1 * cos - r2 * sin, r2 * cos + r1 * sin], axis=-1)
    return jnp.concatenate([rot.astype(t.dtype), t[..., ROT_DIM:]], axis=-1)


def moba_attention(q, k, v):
    Bn, Hn, S, Dh = q.shape
    q, k, v = (pad_seq(t, 2, MOBA_BLOCK) for t in (q, k, v))
    S_pad = q.shape[2]
    nb = S_pad // MOBA_BLOCK
    topk = min(MOBA_TOPK, nb)
    kb = k.reshape(Bn, Hn, nb, MOBA_BLOCK, Dh)
    vb = v.reshape(Bn, Hn, nb, MOBA_BLOCK, Dh)
    k_mean = jnp.mean(kb.astype(jnp.float32), axis=3)
    n_chunks = S_pad // MOBA_Q_CHUNK
    q_chunks = jnp.moveaxis(q.reshape(Bn, Hn, n_chunks, MOBA_Q_CHUNK, Dh), 2, 0)
    b_idx = jnp.arange(Bn)[:, None, None, None]
    h_idx = jnp.arange(Hn)[None, :, None, None]
    scale = Dh ** -0.5
    L = MOBA_BLOCK

    def one_chunk(args):
        q_c, c = args
        q_pos = c * MOBA_Q_CHUNK + jnp.arange(MOBA_Q_CHUNK)
        own = (c * MOBA_Q_CHUNK) // MOBA_BLOCK
        gate = jnp.einsum('bhqd,bhnd->bhqn', q_c.astype(jnp.float32), k_mean)
        fully_past = jnp.arange(nb) < own
        gate = jnp.where(fully_past, gate, -jnp.inf)
        top_val, top_idx = lax.top_k(gate, topk)
        valid = jnp.isfinite(top_val)
        k_sel = kb[b_idx, h_idx, top_idx]
        v_sel = vb[b_idx, h_idx, top_idx]
        s_sel = jnp.einsum('bhqd,bhqjld->bhqjl', q_c, k_sel).astype(jnp.float32) * scale
        s_sel = jnp.where(valid[..., None], s_sel, -jnp.inf).reshape(Bn, Hn, MOBA_Q_CHUNK, topk * L)
        k_own = lax.dynamic_index_in_dim(kb, own, axis=2, keepdims=False)
        v_own = lax.dynamic_index_in_dim(vb, own, axis=2, keepdims=False)
        s_own = jnp.einsum('bhqd,bhld->bhql', q_c, k_own).astype(jnp.float32) * scale
        k_pos = own * MOBA_BLOCK + jnp.arange(MOBA_BLOCK)
        s_own = jnp.where(k_pos[None, :] <= q_pos[:, None], s_own, -jnp.inf)
        p = jax.nn.softmax(jnp.concatenate([s_sel, s_own], axis=-1), axis=-1).astype(v.dtype)
        p_sel = p[..., :topk * L].reshape(Bn, Hn, MOBA_Q_CHUNK, topk, L)
        p_own = p[..., topk * L:]
        return (jnp.einsum('bhqjl,bhqjld->bhqd', p_sel, v_sel)
                + jnp.einsum('bhql,bhld->bhqd', p_own, v_own))

    out = lax.map(one_chunk, (q_chunks, jnp.arange(n_chunks)))
    out = jnp.moveaxis(out, 0, 2).reshape(Bn, Hn, S_pad, Dh)
    return out[:, :, :S]


def causal_depthwise_conv(u, w, b):
    C = u.shape[-1]
    y = lax.conv_general_dilated(u, w[:, None, :].astype(u.dtype), window_strides=(1,),
                                 padding=[(CONV_K - 1, 0)],
                                 dimension_numbers=('NWC', 'WIO', 'NWC'),
                                 feature_group_count=C)
    return y + b


def segsum(a):
    T = a.shape[-1]
    cs = jnp.cumsum(a, axis=-1)
    diff = cs[..., :, None] - cs[..., None, :]
    mask = jnp.tril(jnp.ones((T, T), dtype=bool))
    return jnp.where(mask, diff, -jnp.inf)


def ssd_mixer(z, xBC, dt_raw, conv_w, conv_b, dt_bias, A_log, D_skip, norm_w):
    Bn, S, _ = xBC.shape
    G, R, P, N, Lc = SSM_GROUPS, SSM_HEADS_PER_GROUP, SSM_HEAD_DIM, D_STATE, SSD_CHUNK
    xBC = jax.nn.silu(causal_depthwise_conv(xBC, conv_w, conv_b))
    xs, Bm, Cm = jnp.split(xBC, (D_SSM, D_SSM + G * N), axis=-1)
    dt = jax.nn.softplus(dt_raw.astype(jnp.float32) + dt_bias.astype(jnp.float32))
    A = -jnp.exp(A_log.astype(jnp.float32)).reshape(G, R)
    xs, Bm, Cm, dt = (pad_seq(t, 1, Lc) for t in (xs, Bm, Cm, dt))
    S_pad = xs.shape[1]
    nc = S_pad // Lc
    X = xs.reshape(Bn, nc, Lc, G, R, P)
    Bc = Bm.reshape(Bn, nc, Lc, G, N)
    Cc = Cm.reshape(Bn, nc, Lc, G, N)
    dtc = dt.reshape(Bn, nc, Lc, G, R)
    a = jnp.transpose(dtc * A, (0, 3, 4, 1, 2))
    a_cs = jnp.cumsum(a, axis=-1)
    Xdt = X * dtc[..., None]
    decay_in = jnp.exp(segsum(a))
    CB = jnp.einsum('bclgn,bcsgn->bgcls', Cc, Bc)
    y_diag = jnp.einsum('bgrcls,bcsgrp->bclgrp', CB[:, :, None] * decay_in, Xdt)
    decay_states = jnp.exp(a_cs[..., -1:] - a_cs)
    states = jnp.einsum('bclgn,bgrcl,bclgrp->bcgrpn', Bc, decay_states, Xdt)
    states = jnp.concatenate([jnp.zeros_like(states[:, :1]), states], axis=1)
    a_last = jnp.pad(a_cs[..., -1], ((0, 0), (0, 0), (0, 0), (1, 0)))
    decay_chunk = jnp.exp(segsum(a_last))
    states = jnp.einsum('bgrzc,bcgrpn->bzgrpn', decay_chunk, states)[:, :-1]
    y_off = jnp.einsum('bclgn,bcgrpn,bgrcl->bclgrp', Cc, states, jnp.exp(a_cs))
    y = y_diag + y_off + X * D_skip.astype(jnp.float32).reshape(G, R)[:, :, None]
    y = y.reshape(Bn, S_pad, D_SSM)[:, :S]
    y = y * jax.nn.silu(z.astype(jnp.float32))
    y = rms_norm(y.reshape(Bn, S, G, D_SSM // G), norm_w.reshape(G, D_SSM // G))
    return y.reshape(Bn, S, D_SSM).astype(z.dtype)


def setup_inputs(seed: int = 0) -> dict:
    key = jax.random.key(seed)
    ks = jax.random.split(key, 20)
    f32 = jnp.float32

    def normal(k, shape, scale):
        return jax.random.normal(k, shape, f32) * scale

    def gain(k, shape):
        return 1.0 + 0.02 * jax.random.normal(k, shape, f32)

    dt_init = jnp.exp(jax.random.uniform(ks[9], (DEPTH, N_SSM_HEADS), f32,
                                         math.log(DT_MIN), math.log(DT_MAX)))
    return {
        "x": normal(ks[0], (BATCH, SEQ, D_MODEL), 1.0),
        "ffn1_norm": gain(ks[1], (DEPTH, D_MODEL)),
        "ffn1_w1": normal(ks[2], (DEPTH, D_MODEL, D_FF), D_MODEL ** -0.5),
        "ffn1_w3": normal(ks[3], (DEPTH, D_MODEL, D_FF), D_MODEL ** -0.5),
        "ffn1_w2": normal(ks[4], (DEPTH, D_FF, D_MODEL), D_FF ** -0.5),
        "mix_norm": gain(ks[5], (DEPTH, D_MODEL)),
        "w_in": normal(ks[6], (DEPTH, D_MODEL, D_IN_PROJ), D_MODEL ** -0.5),
        "conv_w": normal(ks[7], (DEPTH, CONV_K, D_CONV), CONV_K ** -0.5),
        "conv_b": normal(ks[8], (DEPTH, D_CONV), 0.01),
        "dt_bias": dt_init + jnp.log(-jnp.expm1(-dt_init)),
        "A_log": jnp.log(jax.random.uniform(ks[10], (DEPTH, N_SSM_HEADS), f32, 1.0, 16.0)),
        "D_skip": 1.0 + 0.1 * jax.random.normal(ks[11], (DEPTH, N_SSM_HEADS), f32),
        "attn_out_norm": gain(ks[12], (DEPTH, D_ATTN)),
        "ssd_out_norm": gain(ks[13], (DEPTH, D_SSM)),
        "w_out": normal(ks[14], (DEPTH, D_MIX, D_MODEL), D_MIX ** -0.5),
        "ffn2_norm": gain(ks[15], (DEPTH, D_MODEL)),
        "ffn2_w1": normal(ks[16], (DEPTH, D_MODEL, D_FF), D_MODEL ** -0.5),
        "ffn2_w3": normal(ks[17], (DEPTH, D_MODEL, D_FF), D_MODEL ** -0.5),
        "ffn2_w2": normal(ks[18], (DEPTH, D_FF, D_MODEL), D_FF ** -0.5),
        "final_norm": gain(ks[19], (D_MODEL,)),
    }


def reference(x, ffn1_norm, ffn1_w1, ffn1_w3, ffn1_w2, mix_norm, w_in, conv_w, conv_b,
              dt_bias, A_log, D_skip, attn_out_norm, ssd_out_norm, w_out,
              ffn2_norm, ffn2_w1, ffn2_w3, ffn2_w2, final_norm):
    Bn, S, _ = x.shape
    cos, sin = rotary_tables(S)

    def heads(t):
        return t.reshape(Bn, S, N_ATTN_HEADS, HEAD_DIM).transpose(0, 2, 1, 3)

    for l in range(DEPTH):
        h = rms_norm(x, ffn1_norm[l])
        x = x + FFN_RESIDUAL_WEIGHT * swiglu(h, ffn1_w1[l], ffn1_w3[l], ffn1_w2[l])
        h = rms_norm(x, mix_norm[l])
        proj = h @ w_in[l]
        q, k, v, z, xBC, dt_raw = jnp.split(proj, SPLIT_POINTS, axis=-1)
        attn = moba_attention(partial_rotary(heads(q), cos, sin),
                              partial_rotary(heads(k), cos, sin), heads(v))
        attn = rms_norm(attn.transpose(0, 2, 1, 3).reshape(Bn, S, D_ATTN), attn_out_norm[l])
        ssd = ssd_mixer(z, xBC, dt_raw, conv_w[l], conv_b[l], dt_bias[l], A_log[l],
                        D_skip[l], ssd_out_norm[l])
        x = x + jnp.concatenate([attn, ssd], axis=-1) @ w_out[l]
        h = rms_norm(x, ffn2_norm[l])
        x = x + FFN_RESIDUAL_WEIGHT * swiglu(h, ffn2_w1[l], ffn2_w3[l], ffn2_w2[l])
    return rms_norm(x, final_norm)
```

```cpp
#include <hip/hip_runtime.h>
#include <cstdio>
#include <cstdint>
#include <cmath>

namespace nv {
constexpr int S = 4096, DM = 1024, DFF = 2816, NB = 8;
constexpr int DATTN = 512, DSSM = 1024, DCONV = 1536, NPROJ = 4112, DMIX = 1536;
constexpr int OFF_Q = 0, OFF_K = 512, OFF_V = 1024, OFF_Z = 1536, OFF_XBC = 2560, OFF_DT = 4096;
constexpr float EPS = 1e-6f;

__device__ __forceinline__ float wave_sum(float v) {
#pragma unroll
    for (int o = 1; o < 64; o <<= 1) v += __shfl_xor(v, o);
    return v;
}
__device__ __forceinline__ float wave_max(float v) {
#pragma unroll
    for (int o = 1; o < 64; o <<= 1) v = fmaxf(v, __shfl_xor(v, o));
    return v;
}
__device__ __forceinline__ float silu(float x) { return x / (1.f + expf(-x)); }

__global__ void __launch_bounds__(256) rmsnorm(const float* in, int ld_in, const float* g, float* out, int ld_out, int width) {
    __shared__ float red[4];
    const int row = blockIdx.x, tid = threadIdx.x;
    const float* x = in + (size_t)row * ld_in;
    float s = 0.f;
    for (int i = tid; i < width; i += 256) s += x[i] * x[i];
    s = wave_sum(s);
    if ((tid & 63) == 0) red[tid >> 6] = s;
    __syncthreads();
    const float tot = red[0] + red[1] + red[2] + red[3];
    const float rstd = rsqrtf(tot / (float)width + EPS);
    for (int i = tid; i < width; i += 256) out[(size_t)row * ld_out + i] = x[i] * rstd * g[i];
}

__global__ void __launch_bounds__(256) gemm(const float* A, int lda, const float* W, int ldw, float* C, int ldc,
                                             const float* R, int ldr, float alpha, int M, int N, int K) {
    __shared__ float As[16][68];
    __shared__ float Ws[16][68];
    const int tid = threadIdx.x, tx = tid & 15, ty = tid >> 4;
    const int m0 = blockIdx.y * 64, n0 = blockIdx.x * 64;
    float acc[4][4];
#pragma unroll
    for (int i = 0; i < 4; ++i)
#pragma unroll
        for (int j = 0; j < 4; ++j) acc[i][j] = 0.f;
    for (int k0 = 0; k0 < K; k0 += 16) {
#pragma unroll
        for (int i = 0; i < 4; ++i) {
            const int idx = tid + 256 * i;
            const int r = idx >> 4, c = idx & 15;
            As[c][r] = A[(size_t)(m0 + r) * lda + k0 + c];
            const int kk = idx >> 6, n = idx & 63;
            Ws[kk][n] = (n0 + n < N) ? W[(size_t)(k0 + kk) * ldw + n0 + n] : 0.f;
        }
        __syncthreads();
#pragma unroll
        for (int kk = 0; kk < 16; ++kk) {
            float a[4], b[4];
#pragma unroll
            for (int i = 0; i < 4; ++i) { a[i] = As[kk][ty * 4 + i]; b[i] = Ws[kk][tx * 4 + i]; }
#pragma unroll
            for (int i = 0; i < 4; ++i)
#pragma unroll
                for (int j = 0; j < 4; ++j) acc[i][j] = fmaf(a[i], b[j], acc[i][j]);
        }
        __syncthreads();
    }
#pragma unroll
    for (int i = 0; i < 4; ++i)
#pragma unroll
        for (int j = 0; j < 4; ++j) {
            const int m = m0 + ty * 4 + i, n = n0 + tx * 4 + j;
            if (n < N) {
                float v = alpha * acc[i][j];
                if (R) v += R[(size_t)m * ldr + n];
                C[(size_t)m * ldc + n] = v;
            }
        }
}

__global__ void swiglu(const float* a, const float* b, float* out, size_t n) {
    size_t i = (size_t)blockIdx.x * blockDim.x + threadIdx.x;
    if (i < n) out[i] = silu(a[i]) * b[i];
}

__global__ void rotary(float* proj) {
    const int idx = blockIdx.x * blockDim.x + threadIdx.x;
    if (idx >= S * 128) return;
    const int i = idx & 7, hd = (idx >> 3) & 7, qk = (idx >> 6) & 1, pos = idx >> 7;
    const float inv_freq = powf(500000.0f, -(float)i / 8.0f);
    const float ang = (float)pos * inv_freq;
    const float c = cosf(ang), s = sinf(ang);
    float* p = proj + (size_t)pos * NPROJ + (qk ? OFF_K : OFF_Q) + hd * 64 + i;
    const float r1 = p[0], r2 = p[8];
    p[0] = r1 * c - r2 * s;
    p[8] = r2 * c + r1 * s;
}

__global__ void __launch_bounds__(64) kmean_k(const float* proj, float* kmean) {
    const int h = blockIdx.x >> 4, n = blockIdx.x & 15, d = threadIdx.x;
    float s = 0.f;
    for (int l = 0; l < 256; ++l) s += proj[(size_t)(n * 256 + l) * NPROJ + OFF_K + h * 64 + d];
    kmean[(h * 16 + n) * 64 + d] = s * (1.0f / 256.0f);
}

__global__ void __launch_bounds__(256) moba(const float* proj, const float* kmean, float* out) {
    __shared__ float qs[4][64];
    __shared__ float ps[4][1024];
    const int tid = threadIdx.x, w = tid >> 6, lane = tid & 63;
    const int gw = blockIdx.x * 4 + w;
    const int h = gw / S, q = gw % S;
    const int own = q >> 8;
    const float qv = proj[(size_t)q * NPROJ + OFF_Q + h * 64 + lane];
    qs[w][lane] = qv;
    float gate[16];
#pragma unroll
    for (int n = 0; n < 16; ++n) {
        float g = -INFINITY;
        if (n < own) g = wave_sum(qv * kmean[(h * 16 + n) * 64 + lane]);
        gate[n] = g;
    }
    int sel[3];
#pragma unroll
    for (int j = 0; j < 3; ++j) {
        int best = -1; float bv = -INFINITY;
#pragma unroll
        for (int n = 0; n < 16; ++n) if (gate[n] > bv) { bv = gate[n]; best = n; }
        sel[j] = best;
#pragma unroll
        for (int n = 0; n < 16; ++n) if (n == best) gate[n] = -INFINITY;
    }
    __syncthreads();
    float sc[4][4];
    float mx = -INFINITY;
#pragma unroll
    for (int jb = 0; jb < 4; ++jb) {
        const int blk = jb < 3 ? sel[jb] : own;
#pragma unroll
        for (int i = 0; i < 4; ++i) {
            float s = -INFINITY;
            if (blk >= 0) {
                const int key = blk * 256 + lane + 64 * i;
                if (jb < 3 || key <= q) {
                    const float* kp = proj + (size_t)key * NPROJ + OFF_K + h * 64;
                    float a = 0.f;
                    for (int d = 0; d < 64; ++d) a = fmaf(qs[w][d], kp[d], a);
                    s = a * 0.125f;
                }
            }
            sc[jb][i] = s;
            mx = fmaxf(mx, s);
        }
    }
    mx = wave_max(mx);
    float sum = 0.f;
#pragma unroll
    for (int jb = 0; jb < 4; ++jb)
#pragma unroll
        for (int i = 0; i < 4; ++i) { sc[jb][i] = expf(sc[jb][i] - mx); sum += sc[jb][i]; }
    sum = wave_sum(sum);
    const float inv = 1.0f / sum;
#pragma unroll
    for (int jb = 0; jb < 4; ++jb)
#pragma unroll
        for (int i = 0; i < 4; ++i) ps[w][jb * 256 + lane + 64 * i] = sc[jb][i] * inv;
    __syncthreads();
    float o = 0.f;
#pragma unroll
    for (int jb = 0; jb < 4; ++jb) {
        const int blk = jb < 3 ? sel[jb] : own;
        if (blk >= 0) {
            const float* vp = proj + (size_t)(blk * 256) * NPROJ + OFF_V + h * 64 + lane;
            const int nk = (jb < 3) ? 256 : (q - own * 256 + 1);
            for (int kk = 0; kk < nk; ++kk) o = fmaf(ps[w][jb * 256 + kk], vp[(size_t)kk * NPROJ], o);
        }
    }
    out[(size_t)q * DATTN + h * 64 + lane] = o;
}

__global__ void conv_silu(const float* proj, const float* w, const float* b, float* xc) {
    const int idx = blockIdx.x * blockDim.x + threadIdx.x;
    if (idx >= S * DCONV) return;
    const int c = idx % DCONV, t = idx / DCONV;
    float a = b[c];
#pragma unroll
    for (int k = 0; k < 4; ++k) { const int tt = t - 3 + k; if (tt >= 0) a = fmaf(w[k * DCONV + c], proj[(size_t)tt * NPROJ + OFF_XBC + c], a); }
    xc[idx] = silu(a);
}

__global__ void dt_k(const float* proj, const float* dt_bias, float* dt) {
    const int idx = blockIdx.x * blockDim.x + threadIdx.x;
    if (idx >= S * 16) return;
    const int hh = idx & 15, t = idx >> 4;
    const float x = proj[(size_t)t * NPROJ + OFF_DT + hh] + dt_bias[hh];
    dt[idx] = x > 20.f ? x : log1pf(expf(x));
}

__global__ void __launch_bounds__(256) ssd_scan(const float* xc, const float* dt, const float* A_log, const float* Dskip, float* y) {
    __shared__ float sB[32][128], sC[32][128], sX[32][64], sdt[32];
    const int hh = blockIdx.x, g = hh >> 3, tid = threadIdx.x, p = tid >> 2, nq = tid & 3;
    const float A = -expf(A_log[hh]), D = Dskip[hh];
    float hreg[32];
#pragma unroll
    for (int i = 0; i < 32; ++i) hreg[i] = 0.f;
    for (int t0 = 0; t0 < S; t0 += 32) {
        __syncthreads();
        for (int i = tid; i < 32 * 128; i += 256) {
            const int tt = i >> 7, n = i & 127;
            sB[tt][n] = xc[(size_t)(t0 + tt) * DCONV + 1024 + g * 128 + n];
            sC[tt][n] = xc[(size_t)(t0 + tt) * DCONV + 1280 + g * 128 + n];
        }
        for (int i = tid; i < 32 * 64; i += 256) { const int tt = i >> 6, pp = i & 63; sX[tt][pp] = xc[(size_t)(t0 + tt) * DCONV + hh * 64 + pp]; }
        if (tid < 32) sdt[tid] = dt[(t0 + tid) * 16 + hh];
        __syncthreads();
        for (int tt = 0; tt < 32; ++tt) {
            const float dtv = sdt[tt], dA = expf(dtv * A), xv = sX[tt][p], dx = dtv * xv;
            float acc = 0.f;
#pragma unroll
            for (int i = 0; i < 32; ++i) { hreg[i] = fmaf(dA, hreg[i], dx * sB[tt][nq * 32 + i]); acc = fmaf(sC[tt][nq * 32 + i], hreg[i], acc); }
            acc += __shfl_xor(acc, 1); acc += __shfl_xor(acc, 2);
            if (nq == 0) y[(size_t)(t0 + tt) * DSSM + hh * 64 + p] = acc + D * xv;
        }
    }
}

__global__ void __launch_bounds__(256) gate_norm(const float* y, const float* proj, const float* w, float* mix) {
    __shared__ float red[4];
    const int t = blockIdx.x, tid = threadIdx.x;
    float v[4]; float s = 0.f;
#pragma unroll
    for (int i = 0; i < 4; ++i) {
        const int c = tid + 256 * i;
        v[i] = y[(size_t)t * DSSM + c] * silu(proj[(size_t)t * NPROJ + OFF_Z + c]);
    }
    float s0 = v[0] * v[0] + v[1] * v[1], s1 = v[2] * v[2] + v[3] * v[3];
    s0 = wave_sum(s0);
    if ((tid & 63) == 0) red[tid >> 6] = s0;
    __syncthreads();
    const float t0 = red[0] + red[1] + red[2] + red[3];
    __syncthreads();
    s1 = wave_sum(s1);
    if ((tid & 63) == 0) red[tid >> 6] = s1;
    __syncthreads();
    const float t1 = red[0] + red[1] + red[2] + red[3];
    const float r0 = rsqrtf(t0 / 512.f + EPS), r1 = rsqrtf(t1 / 512.f + EPS);
    (void)s;
#pragma unroll
    for (int i = 0; i < 4; ++i) { const int c = tid + 256 * i; mix[(size_t)t * DMIX + 512 + c] = v[i] * (i < 2 ? r0 : r1) * w[c]; }
}
}

extern "C" void kernel_launch(void* const* d_in, const int* in_sizes, int n_in, void* d_out, int out_size, void* d_ws, size_t ws_size, hipStream_t stream) {
    using namespace nv;
    const float* x = (const float*)d_in[0];
    const float* ffn1_norm = (const float*)d_in[1]; const float* ffn1_w1 = (const float*)d_in[2]; const float* ffn1_w3 = (const float*)d_in[3]; const float* ffn1_w2 = (const float*)d_in[4];
    const float* mix_norm = (const float*)d_in[5]; const float* w_in = (const float*)d_in[6]; const float* conv_w = (const float*)d_in[7]; const float* conv_b = (const float*)d_in[8];
    const float* dt_bias = (const float*)d_in[9]; const float* A_log = (const float*)d_in[10]; const float* D_skip = (const float*)d_in[11];
    const float* attn_out_norm = (const float*)d_in[12]; const float* ssd_out_norm = (const float*)d_in[13]; const float* w_out = (const float*)d_in[14];
    const float* ffn2_norm = (const float*)d_in[15]; const float* ffn2_w1 = (const float*)d_in[16]; const float* ffn2_w3 = (const float*)d_in[17]; const float* ffn2_w2 = (const float*)d_in[18];
    const float* final_norm = (const float*)d_in[19];
    float* out = (float*)d_out;
    float* ws = (float*)d_ws;
    size_t o = 0;
    float* h = ws + o;     o += (size_t)S * DM;
    float* fa = ws + o;    o += (size_t)S * DFF;
    float* fb = ws + o;    o += (size_t)S * DFF;
    float* x1 = ws + o;    o += (size_t)S * DM;
    float* proj = ws + o;  o += (size_t)S * NPROJ;
    float* xc = ws + o;    o += (size_t)S * DCONV;
    float* dt = ws + o;    o += (size_t)S * 16;
    float* km = ws + o;    o += 8 * 16 * 64;
    float* att = ws + o;   o += (size_t)S * DATTN;
    float* yb = ws + o;    o += (size_t)S * DSSM;
    float* mix = ws + o;   o += (size_t)S * DMIX;
    float* x2 = ws + o;    o += (size_t)S * DM;
    float* x3 = ws + o;    o += (size_t)S * DM;
    if (o * 4 > ws_size) { fprintf(stderr, "ws too small\n"); return; }
    for (int b = 0; b < NB; ++b) {
        const float* xb = x + (size_t)b * S * DM;
        rmsnorm<<<S, 256, 0, stream>>>(xb, DM, ffn1_norm, h, DM, DM);
        gemm<<<dim3(DFF / 64, S / 64), 256, 0, stream>>>(h, DM, ffn1_w1, DFF, fa, DFF, nullptr, 0, 1.f, S, DFF, DM);
        gemm<<<dim3(DFF / 64, S / 64), 256, 0, stream>>>(h, DM, ffn1_w3, DFF, fb, DFF, nullptr, 0, 1.f, S, DFF, DM);
        swiglu<<<(S * DFF + 255) / 256, 256, 0, stream>>>(fa, fb, fa, (size_t)S * DFF);
        gemm<<<dim3(DM / 64, S / 64), 256, 0, stream>>>(fa, DFF, ffn1_w2, DM, x1, DM, xb, DM, 0.5f, S, DM, DFF);
        rmsnorm<<<S, 256, 0, stream>>>(x1, DM, mix_norm, h, DM, DM);
        gemm<<<dim3((NPROJ + 63) / 64, S / 64), 256, 0, stream>>>(h, DM, w_in, NPROJ, proj, NPROJ, nullptr, 0, 1.f, S, NPROJ, DM);
        rotary<<<(S * 128 + 255) / 256, 256, 0, stream>>>(proj);
        kmean_k<<<8 * 16, 64, 0, stream>>>(proj, km);
        moba<<<8 * S / 4, 256, 0, stream>>>(proj, km, att);
        rmsnorm<<<S, 256, 0, stream>>>(att, DATTN, attn_out_norm, mix, DMIX, DATTN);
        conv_silu<<<(S * DCONV + 255) / 256, 256, 0, stream>>>(proj, conv_w, conv_b, xc);
        dt_k<<<(S * 16 + 255) / 256, 256, 0, stream>>>(proj, dt_bias, dt);
        ssd_scan<<<16, 256, 0, stream>>>(xc, dt, A_log, D_skip, yb);
        gate_norm<<<S, 256, 0, stream>>>(yb, proj, ssd_out_norm, mix);
        gemm<<<dim3(DM / 64, S / 64), 256, 0, stream>>>(mix, DMIX, w_out, DM, x2, DM, x1, DM, 1.f, S, DM, DMIX);
        rmsnorm<<<S, 256, 0, stream>>>(x2, DM, ffn2_norm, h, DM, DM);
        gemm<<<dim3(DFF / 64, S / 64), 256, 0, stream>>>(h, DM, ffn2_w1, DFF, fa, DFF, nullptr, 0, 1.f, S, DFF, DM);
        gemm<<<dim3(DFF / 64, S / 64), 256, 0, stream>>>(h, DM, ffn2_w3, DFF, fb, DFF, nullptr, 0, 1.f, S, DFF, DM);
        swiglu<<<(S * DFF + 255) / 256, 256, 0, stream>>>(fa, fb, fa, (size_t)S * DFF);
        gemm<<<dim3(DM / 64, S / 64), 256, 0, stream>>>(fa, DFF, ffn2_w2, DM, x3, DM, x2, DM, 0.5f, S, DM, DFF);
        rmsnorm<<<S, 256, 0, stream>>>(x3, DM, final_norm, out + (size_t)b * S * DM, DM, DM);
    }
}
```

```cpp
#include <hip/hip_runtime.h>
#include <hip/hip_bf16.h>
#include <cstdio>
#include <cstdint>
#include <cmath>
__device__ __forceinline__ float shx(float v, int k) { int lid; asm volatile("v_mbcnt_lo_u32_b32 %0, -1, 0\n\tv_mbcnt_hi_u32_b32 %0, -1, %0" : "=v"(lid)); return __int_as_float(__builtin_amdgcn_ds_bpermute((lid ^ k) << 2, __float_as_int(v))); }
__device__ __forceinline__ float partner16(float v, int fq) { auto r = __builtin_amdgcn_permlane16_swap(__float_as_uint(v), __float_as_uint(v), false, false); return __uint_as_float((fq & 1) ? r[0] : r[1]); }
__device__ __forceinline__ float sum16(float v) { auto r = __builtin_amdgcn_permlane16_swap(__float_as_uint(v), __float_as_uint(v), false, false); return __uint_as_float(r[0]) + __uint_as_float(r[1]); }
__device__ __forceinline__ float sum32(float v) { auto r = __builtin_amdgcn_permlane32_swap(__float_as_uint(v), __float_as_uint(v), false, false); return __uint_as_float(r[0]) + __uint_as_float(r[1]); }
#ifndef T_NOLDS
#define T_NOLDS 0
#endif
#ifndef MK_FP8
#define MK_FP8 1
#endif
#ifndef MK_STAMP_DIV
#define MK_STAMP_DIV 4.0f
#endif
#ifndef MK_FP8_FFN1
#define MK_FP8_FFN1 0
#endif
#ifndef MK_FUSE_FINAL
#define MK_FUSE_FINAL 0
#endif
#ifndef MK_LITE
#define MK_LITE 0
#endif
#ifndef MK_WGM
#define MK_WGM 8
#endif
#ifndef MK_SP2_FP8
#define MK_SP2_FP8 true
#endif
#ifndef MK_ALIGN3
#define MK_ALIGN3 true
#endif
#ifndef MK_MERGE45
#define MK_MERGE45 1
#endif
#ifndef MK_NT
#define MK_NT 0
#endif
namespace pg8 {
#define PG8_LAS __attribute__((address_space(3)))
typedef unsigned short bf16_t;
typedef short bf16x8 __attribute__((ext_vector_type(8)));
typedef float f32x4 __attribute__((ext_vector_type(4)));
typedef unsigned u32x4 __attribute__((ext_vector_type(4)));
constexpr int BM = 256, BK = 64, HALF = 128, HTB = HALF * BK * 2  , STAGE_BYTES = 8 * HTB, NXCD = 8, WGM = MK_WGM;

__host__ __device__ __forceinline__ int lds_byte(int r, int c) { const int st = (r >> 4) * 2 + (c >> 5), rr = r & 15, cc = c & 31, ob = rr * 64 + cc * 2; return st * 1024 + (ob ^ (((ob >> 9) & 1) << 5)); }
__host__ __device__ __forceinline__ void stage_rc(int b, int& R, int& C) { const int st = b / 1024, sb = b % 1024, swz = sb ^ (((sb >> 9) & 1) << 5); R = (st >> 1) * 16 + swz / 64; C = (st & 1) * 32 + (swz % 64) / 2; }
__host__ __device__ __forceinline__ int perm32(int rho) { const int n = rho >> 4, i = rho & 15; return 8 * (i >> 2) + 4 * n + (i & 3); }

struct Unit { int pm, pn; };
struct Gemm { const bf16_t* A; const bf16_t* Bt; int M, N, K; };

struct StaticOrder {
    int nM, nN, nwg, G, c;
    __host__ __device__ void init(int M, int N, int G_, int c_) { nM = M / BM; nN = N / BM; nwg = nM * nN; G = G_; c = c_; }
    __host__ __device__ __forceinline__ bool next(int i, Unit& u) const {
        const long L = (long)i * G + c; if (L >= nwg) return false;
        int wgid = (int)L; { const int q = nwg / NXCD, r = nwg % NXCD, xcd = wgid % NXCD, off = wgid / NXCD; wgid = (xcd < r ? xcd * (q + 1) : r * (q + 1) + (xcd - r) * q) + off; }
        const int nig = WGM * nN, gid = wgid / nig, fm = gid * WGM, gsz = (nM - fm) < WGM ? (nM - fm) : WGM;
        u.pm = fm + ((wgid % nig) % gsz); u.pn = (wgid % nig) / gsz; return true;
    }
    __device__ __forceinline__ void a_ready(const Unit&) const {}
    __device__ __forceinline__ void done(const Unit&) const {}
};
typedef float f32x2_t __attribute__((ext_vector_type(2))); typedef __bf16 bf16x2_t __attribute__((ext_vector_type(2)));
typedef unsigned u32x2 __attribute__((ext_vector_type(2)));
__device__ __forceinline__ unsigned cvt_pk_bf16(float lo, float hi) { f32x2_t v = {lo, hi}; bf16x2_t b = __builtin_convertvector(v, bf16x2_t); return __builtin_bit_cast(unsigned, b); }
constexpr float RMS_EPS = 1e-6f;
__device__ __forceinline__ float silu_f(float x) { return x * __builtin_amdgcn_rcpf(1.0f + __builtin_amdgcn_exp2f(-1.4426950408889634f * x)); }

__device__ __forceinline__ unsigned cvt4_fp8(float a, float b, float c, float d) { int w = __builtin_amdgcn_cvt_pk_fp8_f32(a, b, 0, false); w = __builtin_amdgcn_cvt_pk_fp8_f32(c, d, w, true); return (unsigned)w; }
template <bool OUT8, int SB> struct EpiSwigluT {
    static constexpr bool PERM = true, AFTER_DRAIN = false, KHOOK = false; static constexpr int SCALE_B = SB;
    bf16_t* H; const float* ss; int ldh;
    __device__ __forceinline__ void operator()(const f32x4 (&acc)[2][2][4][2], const Unit& u, int wr, int wc, int fr, int fq) const {
        const int row0 = u.pm * BM + wr * 64 + fr, col0 = u.pn * HALF + wc * 32 + 8 * fq;
        float ssv[2][4];
#pragma unroll
        for (int ai = 0; ai < 2; ++ai)
#pragma unroll
            for (int m = 0; m < 4; ++m) ssv[ai][m] = ss[row0 + ai * HALF + m * 16];
#pragma unroll
        for (int ai = 0; ai < 2; ++ai)
#pragma unroll
            for (int m = 0; m < 4; ++m) asm volatile("" : "+v"(ssv[ai][m]));
#pragma unroll
        for (int ai = 0; ai < 2; ++ai)
#pragma unroll
            for (int m = 0; m < 4; ++m) {
                const int row = row0 + ai * HALF + m * 16;
                const float rs = rsqrtf(ssv[ai][m] * (1.0f / 1024.0f) + RMS_EPS);
                float h[8];
#pragma unroll
                for (int n = 0; n < 2; ++n)
#pragma unroll
                    for (int i = 0; i < 4; ++i) h[4 * n + i] = silu_f(acc[ai][0][m][n][i] * rs) * (acc[ai][1][m][n][i] * rs);
                if constexpr (OUT8) { u32x2 w; w.x = cvt4_fp8(h[0], h[1], h[2], h[3]); w.y = cvt4_fp8(h[4], h[5], h[6], h[7]);
#if MK_NT
                    __builtin_nontemporal_store(w, (u32x2*)((unsigned char*)H + (size_t)row * ldh + col0));
#else
                    *(u32x2*)((unsigned char*)H + (size_t)row * ldh + col0) = w;
#endif
                }
                else { u32x4 w; w.x = cvt_pk_bf16(h[0], h[1]); w.y = cvt_pk_bf16(h[2], h[3]); w.z = cvt_pk_bf16(h[4], h[5]); w.w = cvt_pk_bf16(h[6], h[7]);
#if MK_NT
                __builtin_nontemporal_store(w, (u32x4*)(H + (size_t)row * ldh + col0));
#else
                *(u32x4*)(H + (size_t)row * ldh + col0) = w;
#endif
                }
            }
    }
};

template <bool KH, int SB = 0> struct EpiResid {
    static constexpr bool PERM = true, AFTER_DRAIN = false, KHOOK = KH; static constexpr int SCALE_B = SB;
    static constexpr int K1 = 8, K2 = 16;
    bf16_t* XB; float* ss; float alpha;
    const float* ssa; const float* ssg;
    PG8_LAS float* tab;
    unsigned char* X8;
    __device__ __forceinline__ void unit_begin(const Unit& u, int wid, int wr, int fr, int fq) const {
        if constexpr (KH) {
            PG8_LAS float* t = tab + wid * 384;
            if (fq == 0) {
                float sa[2][4]; f32x2_t sg[2][4];
#pragma unroll
                for (int ai = 0; ai < 2; ++ai)
#pragma unroll
                    for (int m = 0; m < 4; ++m) { const int row = u.pm * BM + ai * HALF + wr * 64 + m * 16 + fr;
                        sa[ai][m] = ((const __attribute__((address_space(1))) float*)ssa)[row]; sg[ai][m] = *(const __attribute__((address_space(1))) f32x2_t*)(ssg + 2 * row); }
#pragma unroll
                for (int ai = 0; ai < 2; ++ai)
#pragma unroll
                    for (int m = 0; m < 4; ++m) {
                        const float va = sa[ai][m] * (1.0f / 512.0f) + RMS_EPS, v0 = sg[ai][m].x * (1.0f / 512.0f) + RMS_EPS, v1 = sg[ai][m].y * (1.0f / 512.0f) + RMS_EPS;
                        const int e = (ai * 4 + m) * 16 + fr;
                        t[e] = sqrtf(v0 * __builtin_amdgcn_rcpf(va));
                        t[128 + e] = sqrtf(v1 * __builtin_amdgcn_rcpf(v0));
                        t[256 + e] = rsqrtf(v1);
                    }
            }
            asm volatile("s_waitcnt lgkmcnt(0)" ::: "memory");
        }
    }
    __device__ __forceinline__ void khook(f32x4 (&acc)[2][2][4][2], int t, int wid, int fr) const {
        if constexpr (KH) {
            const PG8_LAS float* tb = tab + wid * 384 + (t == K1 ? 0 : 128);
#pragma unroll
            for (int ai = 0; ai < 2; ++ai)
#pragma unroll
                for (int m = 0; m < 4; ++m) { const float f = tb[(ai * 4 + m) * 16 + fr];
#pragma unroll
                    for (int bj = 0; bj < 2; ++bj)
#pragma unroll
                        for (int n = 0; n < 2; ++n) acc[ai][bj][m][n] = acc[ai][bj][m][n] * f; }
        }
    }
    __device__ __forceinline__ void operator()(const f32x4 (&acc)[2][2][4][2], const Unit& u, int wr, int wc, int fr, int fq) const {
        const int row0 = u.pm * BM + wr * 64 + fr, col0 = u.pn * BM + wc * 32 + 8 * fq;
        const int wid = wr * 4 + wc;
        u32x4 rra[2][4][2];
        constexpr bool ALL = false;
        if constexpr (ALL) {
#pragma unroll
            for (int ai = 0; ai < 2; ++ai)
#pragma unroll
                for (int m = 0; m < 4; ++m)
#pragma unroll
                    for (int bj = 0; bj < 2; ++bj) rra[ai][m][bj] = *(const u32x4*)(XB + (size_t)(row0 + ai * HALF + m * 16) * 1024 + col0 + bj * HALF);
#pragma unroll
            for (int ai = 0; ai < 2; ++ai)
#pragma unroll
                for (int m = 0; m < 4; ++m)
#pragma unroll
                    for (int bj = 0; bj < 2; ++bj) asm volatile("" : "+v"(rra[ai][m][bj]));
        }
#pragma unroll
        for (int ai = 0; ai < 2; ++ai) {
            if constexpr (!ALL) {
#pragma unroll
                for (int m = 0; m < 4; ++m)
#pragma unroll
                    for (int bj = 0; bj < 2; ++bj) rra[ai][m][bj] = *(const u32x4*)(XB + (size_t)(row0 + ai * HALF + m * 16) * 1024 + col0 + bj * HALF);
#pragma unroll
                for (int m = 0; m < 4; ++m)
#pragma unroll
                    for (int bj = 0; bj < 2; ++bj) asm volatile("" : "+v"(rra[ai][m][bj]));
            }
#pragma unroll
            for (int m = 0; m < 4; ++m) {
                const int row = row0 + ai * HALF + m * 16;
                float f = alpha; if constexpr (KH) f *= tab[wid * 384 + 256 + (ai * 4 + m) * 16 + fr];
                float sq = 0.f;
#pragma unroll
                for (int bj = 0; bj < 2; ++bj) {
                    float v[8];
#pragma unroll
                    for (int n = 0; n < 2; ++n)
#pragma unroll
                        for (int i = 0; i < 2; ++i) { const unsigned w = rra[ai][m][bj][2 * n + i];
                            v[4 * n + 2 * i] = __uint_as_float(w << 16) + acc[ai][bj][m][n][2 * i] * f; v[4 * n + 2 * i + 1] = __uint_as_float(w & 0xffff0000u) + acc[ai][bj][m][n][2 * i + 1] * f; }
#pragma unroll
                    for (int j = 0; j < 8; ++j) sq += v[j] * v[j];
                    u32x4 w; w.x = cvt_pk_bf16(v[0], v[1]); w.y = cvt_pk_bf16(v[2], v[3]); w.z = cvt_pk_bf16(v[4], v[5]); w.w = cvt_pk_bf16(v[6], v[7]);
                    *(u32x4*)(XB + (size_t)row * 1024 + col0 + bj * HALF) = w;
                    if (X8) { u32x2 w8; w8.x = cvt4_fp8(v[0], v[1], v[2], v[3]); w8.y = cvt4_fp8(v[4], v[5], v[6], v[7]); *(u32x2*)(X8 + (size_t)row * 1024 + col0 + bj * HALF) = w8; }
                }
                sq = sum16(sq); sq = sum32(sq);
                if (fq == 0) atomicAdd(ss + row, sq);
            }
        }
    }
};

typedef EpiSwigluT<false, 0> EpiSwiglu;
template <int LITE> struct EpiProjT {
    static constexpr bool PERM = true, AFTER_DRAIN = false, KHOOK = false; static constexpr int SCALE_B = 0;
    bf16_t *Q, *Kb, *V, *Z, *XBC; const float* ss; const float* cs; float* kmsum; float qscale;
    __device__ __forceinline__ void operator()(const f32x4 (&acc)[2][2][4][2], const Unit& u, int wr, int wc, int fr, int fq) const {
        const int pn = u.pn;
        bf16_t* dst; int ld, cb;
        if (pn < 2) { dst = Q; ld = 512; cb = pn * 256; } else if (pn < 4) { dst = Kb; ld = 512; cb = (pn - 2) * 256; } else if (pn < 6) { dst = V; ld = 512; cb = (pn - 4) * 256; }
        else if (pn < 10) { dst = Z; ld = 1024; cb = (pn - 6) * 256; } else { dst = XBC; ld = 1536; cb = (pn - 10) * 256; }
        const bool rot = (LITE == 0) && (pn < 4) && ((wc & 1) == 0), isk = (LITE != 1) && (pn == 2 || pn == 3);
        const float sc = pn < 2 ? qscale : 1.0f;
        const int row0 = u.pm * BM + wr * 64 + fr, c0 = wc * 32 + 8 * fq;
        float csum[2][8];
#pragma unroll
        for (int bj = 0; bj < 2; ++bj)
#pragma unroll
            for (int j = 0; j < 8; ++j) csum[bj][j] = 0.f;
        f32x4 ncv[2], nsv[2];
        if (rot) { const float* cp = cs + (size_t)(row0 & 4095) * 16; ncv[0] = *(const f32x4*)cp; ncv[1] = *(const f32x4*)(cp + 4); nsv[0] = *(const f32x4*)(cp + 8); nsv[1] = *(const f32x4*)(cp + 12); }
        float ssv[2][4];
#pragma unroll
        for (int ai = 0; ai < 2; ++ai)
#pragma unroll
            for (int m = 0; m < 4; ++m) ssv[ai][m] = ss[row0 + ai * HALF + m * 16];
#pragma unroll
        for (int ai = 0; ai < 2; ++ai)
#pragma unroll
            for (int m = 0; m < 4; ++m) asm volatile("" : "+v"(ssv[ai][m]));
#pragma unroll
        for (int ai = 0; ai < 2; ++ai)
#pragma unroll
            for (int m = 0; m < 4; ++m) {
                const int row = row0 + ai * HALF + m * 16;
                const float rs = rsqrtf(ssv[ai][m] * (1.0f / 1024.0f) + RMS_EPS) * sc;
                f32x4 cv[2], sv[2];
                if (rot) {
                    cv[0] = ncv[0]; cv[1] = ncv[1]; sv[0] = nsv[0]; sv[1] = nsv[1];
                    if (ai * 4 + m < 7) {
                        constexpr float C16[8] = {-9.576594803e-01f, -9.992462593e-01f, 8.243765146e-01f, 9.932003012e-01f, 9.997440109e-01f, 9.999903729e-01f, 9.999996380e-01f, 9.999999864e-01f};
                        constexpr float S16[8] = {-2.879033167e-01f, 3.881898152e-02f, 5.660418378e-01f, 1.164180468e-01f, 2.262548617e-02f, 4.387956730e-03f, 8.509272408e-04f, 1.650141653e-04f};
                        constexpr float C80[8] = {-1.103872438e-01f, -9.812132344e-01f, -9.911539132e-01f, 8.345872775e-01f, 9.936068238e-01f, 9.997593311e-01f, 9.999909490e-01f, 9.999996596e-01f};
                        constexpr float S80[8] = {-9.938886539e-01f, 1.929263812e-01f, 1.327174458e-01f, 5.508757358e-01f, 1.128958803e-01f, 2.193809395e-02f, 4.254623881e-03f, 8.250707366e-04f};
#pragma unroll
                        for (int j = 0; j < 8; ++j) { const float cd = (m == 3) ? C80[j] : C16[j], sd = (m == 3) ? S80[j] : S16[j], c0_ = cv[j >> 2][j & 3], s0_ = sv[j >> 2][j & 3];
                            ncv[j >> 2][j & 3] = c0_ * cd - s0_ * sd; nsv[j >> 2][j & 3] = s0_ * cd + c0_ * sd; } } }
#pragma unroll
                for (int bj = 0; bj < 2; ++bj) {
                    float v[8];
#pragma unroll
                    for (int n = 0; n < 2; ++n)
#pragma unroll
                        for (int i = 0; i < 4; ++i) v[4 * n + i] = acc[ai][bj][m][n][i] * rs;
                    if (rot) {
#pragma unroll
                        for (int j = 0; j < 8; ++j) {
                            const float p = partner16(v[j], fq);
                            const float c = cv[j >> 2][j & 3], s = sv[j >> 2][j & 3];
                            const float r1 = v[j] * c - p * s, r2 = v[j] * c + p * s;
                            v[j] = fq == 0 ? r1 : (fq == 1 ? r2 : v[j]);
                        }
                    }
                    if (isk) {
#pragma unroll
                        for (int j = 0; j < 8; ++j) csum[bj][j] += v[j];
                    }
                    u32x4 w; w.x = cvt_pk_bf16(v[0], v[1]); w.y = cvt_pk_bf16(v[2], v[3]); w.z = cvt_pk_bf16(v[4], v[5]); w.w = cvt_pk_bf16(v[6], v[7]);
                    if (pn < 6) { const int col = cb + bj * HALF + c0;
                        *(u32x4*)(dst + ((size_t)((row >> 12) * 8 + (col >> 6)) * 4096 + (row & 4095)) * 64 + (col & 63)) = w; }
                    else *(u32x4*)(dst + (size_t)row * ld + cb + bj * HALF + c0) = w;
                }
            }
        if (isk) {
#pragma unroll
            for (int bj = 0; bj < 2; ++bj) {
                float mine = 0.f;
#pragma unroll
                for (int j = 0; j < 8; ++j) {
                    float s = csum[bj][j];
                    s += __builtin_bit_cast(float, __builtin_amdgcn_update_dpp(0, __builtin_bit_cast(int, s), 0x128, 0xf, 0xf, false));
                    s += __builtin_bit_cast(float, __builtin_amdgcn_update_dpp(0, __builtin_bit_cast(int, s), 0x124, 0xf, 0xf, false));
                    s += __builtin_bit_cast(float, __builtin_amdgcn_update_dpp(0, __builtin_bit_cast(int, s), 0x122, 0xf, 0xf, false));
                    s += __builtin_bit_cast(float, __builtin_amdgcn_update_dpp(0, __builtin_bit_cast(int, s), 0x121, 0xf, 0xf, false));
                    mine = ((fr & 7) == j) ? s : mine;
                }
                if (fr < 8) atomicAdd(kmsum + (size_t)u.pm * 512 + (pn - 2) * 256 + bj * HALF + c0 + fr, mine);
            }
        }
    }
};

typedef EpiProjT<0> EpiProj;
struct EpiNull {
    static constexpr bool PERM = true, AFTER_DRAIN = false, KHOOK = false; static constexpr int SCALE_B = 0;
    float* sink;
    __device__ __forceinline__ void operator()(const f32x4 (&acc)[2][2][4][2], const Unit& u, int wr, int wc, int fr, int fq) const {
        float s = 0.f;
#pragma unroll
        for (int ai = 0; ai < 2; ++ai)
#pragma unroll
            for (int bj = 0; bj < 2; ++bj)
#pragma unroll
                for (int m = 0; m < 4; ++m)
#pragma unroll
                    for (int n = 0; n < 2; ++n) s += (acc[ai][bj][m][n][0] + acc[ai][bj][m][n][1]) + (acc[ai][bj][m][n][2] + acc[ai][bj][m][n][3]);
        sink[(wr * 4 + wc) * 64 + fq * 16 + fr] = s;
    }
};
typedef float f32x16w __attribute__((ext_vector_type(16))); typedef int v8i32 __attribute__((ext_vector_type(8))); typedef int v4i32 __attribute__((ext_vector_type(4)));
__device__ __forceinline__ v8i32 cat8(bf16x8 a, bf16x8 b) { const v4i32 x = __builtin_bit_cast(v4i32, a), y = __builtin_bit_cast(v4i32, b); return __builtin_shufflevector(x, y, 0, 1, 2, 3, 4, 5, 6, 7); }
template <class Epi, class Sched, bool ALIGN_EPI = false, bool SP2 = false, bool FP8 = false, bool S32 = false>
__device__ __forceinline__ void gemm_phase(PG8_LAS unsigned char* lds, const Gemm g, const Sched& S, const Epi& E) {
    int tid_ = threadIdx.x; asm volatile("" : "+v"(tid_));
    const int tid = tid_, wid = __builtin_amdgcn_readfirstlane(tid >> 6), lane = tid & 63, wr = wid >> 2, wc = wid & 3, fr = lane & 15, fq = lane >> 4;
    const int K = g.K, nt = K / BK;
    unsigned voffA[2], voffB[2];
#pragma unroll
    for (int i = 0; i < 2; ++i) { int R, C; stage_rc(tid * 16 + i * 8192, R, C); const int Rb = Epi::PERM ? ((R & ~31) + perm32(R & 31)) : R;
        voffA[i] = (unsigned)(R * K + C) * 2u; voffB[i] = (unsigned)(Rb * K + C) * 2u; }
    const size_t p1step = (size_t)64 * K * 2;
    const size_t kstep = (size_t)(BK * 2);
    const size_t hstep = (size_t)HALF * K * 2;
    const size_t tstep = 2 * hstep;
    const unsigned ldsw = (unsigned)wid * 1024u;
    const int aoff = lds_byte(wr * 64 + fr, fq * 8), boff = lds_byte(wc * 32 + fr, fq * 8);
    constexpr int SCB = (127 - Epi::SCALE_B) | (127 << 8);
#define PG8_SA(b, h) (((b) * 2 + (h)) * HTB)
#define PG8_SB(b, h) ((4 + (b) * 2 + (h)) * HTB)
#define PG8_STAGE(bufoff, gbase, voff) do { _Pragma("unroll") for (int _i = 0; _i < 2; ++_i) \
        __builtin_amdgcn_global_load_lds((const unsigned*)((const char*)(gbase) + (size_t)_i * p1step + (voff)[0]), (PG8_LAS unsigned*)(lds + (bufoff) + ldsw + _i * 8192), 16, 0, 0); } while (0)
#define PG8_LDA(dst, b, h) do { if constexpr (FP8) { _Pragma("unroll") for (int m = 0; m < 4; ++m) { const v4i32 lo_ = *(const PG8_LAS v4i32*)(lds + PG8_SA(b, h) + aoff + m * 2048), hi_ = *(const PG8_LAS v4i32*)(lds + PG8_SA(b, h) + aoff + m * 2048 + 1024); dst##8[m] = __builtin_shufflevector(lo_, hi_, 0, 1, 2, 3, 4, 5, 6, 7); } } \
        else { _Pragma("unroll") for (int m = 0; m < 4; ++m) _Pragma("unroll") for (int k = 0; k < 2; ++k) dst[m][k] = *(const PG8_LAS bf16x8*)(lds + PG8_SA(b, h) + aoff + m * 2048 + k * 1024); } } while (0)
#define PG8_LDB(dst, b, h) do { if constexpr (FP8) { _Pragma("unroll") for (int n = 0; n < 2; ++n) { const v4i32 lo_ = *(const PG8_LAS v4i32*)(lds + PG8_SB(b, h) + boff + n * 2048), hi_ = *(const PG8_LAS v4i32*)(lds + PG8_SB(b, h) + boff + n * 2048 + 1024); dst##8[n] = __builtin_shufflevector(lo_, hi_, 0, 1, 2, 3, 4, 5, 6, 7); } } \
        else { _Pragma("unroll") for (int n = 0; n < 2; ++n) _Pragma("unroll") for (int k = 0; k < 2; ++k) dst[n][k] = *(const PG8_LAS bf16x8*)(lds + PG8_SB(b, h) + boff + n * 2048 + k * 1024); } } while (0)
#define PG8_MMA(ai, bj, At, Bt) do { __builtin_amdgcn_s_setprio(1); if constexpr (S32) { _Pragma("unroll") for (int t_ = 0; t_ < 2; ++t_) _Pragma("unroll") for (int ks_ = 0; ks_ < 4; ++ks_) \
        acc32[ai][bj][t_] = __builtin_amdgcn_mfma_f32_32x32x16_bf16(Bt[ks_ >> 1][ks_ & 1], At[t_ * 2 + (ks_ >> 1)][ks_ & 1], acc32[ai][bj][t_], 0, 0, 0); } else \
        _Pragma("unroll") for (int m = 0; m < 4; ++m) _Pragma("unroll") for (int n = 0; n < 2; ++n) { \
        if constexpr (FP8) { f32x16w& W_ = accw[ai][bj][m >> 1]; const int i_ = 4 * ((m & 1) * 2 + n); f32x4 c_ = {W_[i_], W_[i_ + 1], W_[i_ + 2], W_[i_ + 3]}; \
            c_ = __builtin_amdgcn_mfma_scale_f32_16x16x128_f8f6f4(Bt##8[n], At##8[m], c_, 0, 0, 0, SCB, 1, SCB); W_[i_] = c_[0]; W_[i_ + 1] = c_[1]; W_[i_ + 2] = c_[2]; W_[i_ + 3] = c_[3]; } \
        else { _Pragma("unroll") for (int k = 0; k < 2; ++k) acc[ai][bj][m][n] = __builtin_amdgcn_mfma_f32_16x16x32_bf16(Bt[n][k], At[m][k], acc[ai][bj][m][n], 0, 0, 0); } } __builtin_amdgcn_s_setprio(0); } while (0)
#define PG8_WAIT_V(n) asm volatile("s_waitcnt vmcnt(" #n ")" ::: "memory")
#define PG8_WAIT_L(n) asm volatile("s_waitcnt lgkmcnt(" #n ")" ::: "memory")
#define PG8_BAR __builtin_amdgcn_s_barrier()
#define PG8_SCHED __builtin_amdgcn_sched_barrier(0)
    Unit cur, nxt; int ui = 0;
    if (!S.next(0, cur)) return;
    f32x4 acc[2][2][4][2];
    f32x16w acc32[2][2][2];
    if constexpr (S32) { _Pragma("unroll") for (int a = 0; a < 2; ++a) _Pragma("unroll") for (int b = 0; b < 2; ++b) _Pragma("unroll") for (int q = 0; q < 2; ++q) acc32[a][b][q] = f32x16w{}; }
    f32x16w accw[2][2][2];
#define PG8_ZERO_W() do { if constexpr (FP8) { _Pragma("unroll") for (int a = 0; a < 2; ++a) _Pragma("unroll") for (int b = 0; b < 2; ++b) _Pragma("unroll") for (int q = 0; q < 2; ++q) accw[a][b][q] = f32x16w{}; } } while (0)
#define PG8_UNPACK_W() do { if constexpr (FP8) { _Pragma("unroll") for (int a = 0; a < 2; ++a) _Pragma("unroll") for (int b = 0; b < 2; ++b) _Pragma("unroll") for (int m = 0; m < 4; ++m) _Pragma("unroll") for (int n = 0; n < 2; ++n) { \
        const int i_ = 4 * ((m & 1) * 2 + n); acc[a][b][m][n] = (f32x4){accw[a][b][m >> 1][i_], accw[a][b][m >> 1][i_ + 1], accw[a][b][m >> 1][i_ + 2], accw[a][b][m >> 1][i_ + 3]}; } } } while (0)
    PG8_ZERO_W();
#pragma unroll
    for (int a = 0; a < 2; ++a)
#pragma unroll
        for (int b = 0; b < 2; ++b)
#pragma unroll
            for (int m = 0; m < 4; ++m)
#pragma unroll
                for (int n = 0; n < 2; ++n) acc[a][b][m][n] = (f32x4){0.f, 0.f, 0.f, 0.f};
    bf16x8 At[4][2], B0[2][2], B1[2][2]; v8i32 At8[4], B08[2], B18[2];
    const char* cA = (const char*)g.A + (size_t)cur.pm * tstep; const char* cB = (const char*)g.Bt + (size_t)cur.pn * tstep;
    S.a_ready(cur);
    if constexpr (SP2) {
        PG8_STAGE(PG8_SB(0, 0), cB, voffB); PG8_STAGE(PG8_SB(0, 1), cB + hstep, voffB); PG8_STAGE(PG8_SA(0, 0), cA, voffA); PG8_STAGE(PG8_SA(0, 1), cA + hstep, voffA);
        if (wr == 1) PG8_BAR;
        PG8_WAIT_V(2); PG8_BAR;
        PG8_STAGE(PG8_SB(1, 0), cB + kstep, voffB); PG8_STAGE(PG8_SA(1, 0), cA + kstep, voffA); PG8_STAGE(PG8_SB(1, 1), cB + hstep + kstep, voffB);
        PG8_WAIT_V(6); PG8_BAR;
    } else {
        PG8_STAGE(PG8_SB(0, 0), cB, voffB); PG8_STAGE(PG8_SA(0, 0), cA, voffA); PG8_STAGE(PG8_SB(0, 1), cB + hstep, voffB); PG8_STAGE(PG8_SA(0, 1), cA + hstep, voffA);
        if (wr == 1) PG8_BAR;
        PG8_WAIT_V(4); PG8_BAR;
        PG8_STAGE(PG8_SB(1, 0), cB + kstep, voffB); PG8_STAGE(PG8_SA(1, 0), cA + kstep, voffA); PG8_STAGE(PG8_SB(1, 1), cB + hstep + kstep, voffB);
        PG8_WAIT_V(6); PG8_BAR;
    }
    for (;;) {
        const bool has_next = S.next(ui + 1, nxt);
        if constexpr (Epi::KHOOK) E.unit_begin(cur, wid, wr, fr, fq);
        const char* nA = has_next ? (const char*)g.A + (size_t)nxt.pm * tstep : cA; const char* nB = has_next ? (const char*)g.Bt + (size_t)nxt.pn * tstep : cB;
#pragma unroll 1
        for (int t = 0; t < nt; t += 2) {
            const bool last = (t == nt - 2);
            if constexpr (Epi::KHOOK) { if (t == Epi::K1 || t == Epi::K2) { E.khook(acc, t, wid, fr); PG8_SCHED; } }
            const char* a1 = cA + (size_t)(t + 1) * kstep;
            const char* a2 = last ? nA : cA + (size_t)(t + 2) * kstep; const char* b2 = last ? nB : cB + (size_t)(t + 2) * kstep;
            const char* a3 = a2 + kstep; const char* b3 = b2 + kstep;
            if (last && has_next) S.a_ready(nxt);
            if constexpr (SP2) {
            PG8_LDB(B0, 0, 0); PG8_LDB(B1, 0, 1); PG8_SCHED; PG8_LDA(At, 0, 0); PG8_STAGE(PG8_SA(1, 1), a1 + hstep, voffA);
            PG8_WAIT_V(8); PG8_WAIT_L(0); PG8_BAR; PG8_MMA(0, 0, At, B0); PG8_MMA(0, 1, At, B1); PG8_BAR; PG8_SCHED;
            PG8_LDA(At, 0, 1); PG8_STAGE(PG8_SB(0, 0), b2, voffB); PG8_STAGE(PG8_SB(0, 1), b2 + hstep, voffB); PG8_STAGE(PG8_SA(0, 0), a2, voffA);
            PG8_WAIT_V(8); PG8_WAIT_L(0); PG8_BAR; PG8_MMA(1, 0, At, B0); PG8_MMA(1, 1, At, B1); PG8_BAR; PG8_SCHED;
            PG8_LDB(B0, 1, 0); PG8_LDB(B1, 1, 1); PG8_SCHED; PG8_LDA(At, 1, 0); PG8_STAGE(PG8_SA(0, 1), a2 + hstep, voffA);
            PG8_WAIT_V(8); PG8_WAIT_L(0); PG8_BAR; PG8_MMA(0, 0, At, B0); PG8_MMA(0, 1, At, B1); PG8_BAR; PG8_SCHED;
            PG8_LDA(At, 1, 1); PG8_STAGE(PG8_SB(1, 0), b3, voffB); PG8_STAGE(PG8_SB(1, 1), b3 + hstep, voffB); PG8_STAGE(PG8_SA(1, 0), a3, voffA);
            PG8_WAIT_V(8); PG8_WAIT_L(0); PG8_BAR; PG8_MMA(1, 0, At, B0); PG8_MMA(1, 1, At, B1); PG8_BAR; PG8_SCHED;
            } else {
            PG8_LDB(B0, 0, 0); PG8_SCHED; PG8_LDA(At, 0, 0); PG8_STAGE(PG8_SA(1, 1), a1 + hstep, voffA);
            PG8_WAIT_L(8); PG8_BAR; PG8_WAIT_L(0); PG8_MMA(0, 0, At, B0); PG8_BAR; PG8_SCHED;
            PG8_LDB(B1, 0, 1); PG8_STAGE(PG8_SB(0, 0), b2, voffB);
            PG8_BAR; PG8_WAIT_L(0); PG8_MMA(0, 1, At, B1); PG8_BAR;
            PG8_LDA(At, 0, 1); PG8_STAGE(PG8_SA(0, 0), a2, voffA);
            PG8_BAR; PG8_WAIT_L(0); PG8_MMA(1, 0, At, B0); PG8_BAR; PG8_SCHED;
            PG8_STAGE(PG8_SB(0, 1), b2 + hstep, voffB);
            PG8_WAIT_V(6); PG8_BAR; PG8_MMA(1, 1, At, B1); PG8_BAR;
            PG8_LDB(B0, 1, 0); PG8_SCHED; PG8_LDA(At, 1, 0); PG8_STAGE(PG8_SA(0, 1), a2 + hstep, voffA);
            PG8_WAIT_L(8); PG8_BAR; PG8_WAIT_L(0); PG8_MMA(0, 0, At, B0); PG8_BAR; PG8_SCHED;
            PG8_LDB(B1, 1, 1); PG8_STAGE(PG8_SB(1, 0), b3, voffB);
            PG8_BAR; PG8_WAIT_L(0); PG8_MMA(0, 1, At, B1); PG8_BAR;
            PG8_LDA(At, 1, 1); PG8_STAGE(PG8_SA(1, 0), a3, voffA);
            PG8_BAR; PG8_WAIT_L(0); PG8_MMA(1, 0, At, B0); PG8_BAR; PG8_SCHED;
            PG8_STAGE(PG8_SB(1, 1), b3 + hstep, voffB);
            PG8_WAIT_V(6); PG8_BAR; PG8_MMA(1, 1, At, B1); PG8_BAR;
            }
        }
        if constexpr (ALIGN_EPI) { if (wr == 0) PG8_BAR; }
        PG8_UNPACK_W();
        if constexpr (S32) { float s_ = 0.f; _Pragma("unroll") for (int a = 0; a < 2; ++a) _Pragma("unroll") for (int b = 0; b < 2; ++b) _Pragma("unroll") for (int q = 0; q < 2; ++q) { _Pragma("unroll") for (int e_ = 0; e_ < 16; ++e_) s_ += acc32[a][b][q][e_]; acc32[a][b][q] = f32x16w{}; } E.sink[(wr * 4 + wc) * 64 + fq * 16 + fr] = s_; }
        else if constexpr (!Epi::AFTER_DRAIN) { E(acc, cur, wr, wc, fr, fq); S.done(cur); }
        if (!has_next) break;
#pragma unroll
        for (int a = 0; a < 2; ++a)
#pragma unroll
            for (int b = 0; b < 2; ++b)
#pragma unroll
                for (int m = 0; m < 4; ++m)
#pragma unroll
                    for (int n = 0; n < 2; ++n) acc[a][b][m][n] = (f32x4){0.f, 0.f, 0.f, 0.f};
        PG8_ZERO_W();
        cur = nxt; cA = nA; cB = nB; ++ui;
        if constexpr (ALIGN_EPI) { if (wr == 1) PG8_BAR; }
    }
    PG8_WAIT_V(0);
    if constexpr (!ALIGN_EPI) { if (wr == 0) PG8_BAR; }
    PG8_BAR;
    if constexpr (Epi::AFTER_DRAIN) { E.fused(acc, cur, wr, wc, fr, fq, lds, wid, lane); S.done(cur); }
#undef PG8_ZERO_W
#undef PG8_UNPACK_W
#undef PG8_SA
#undef PG8_SB
#undef PG8_STAGE
#undef PG8_LDA
#undef PG8_LDB
#undef PG8_MMA
#undef PG8_WAIT_V
#undef PG8_WAIT_L
#undef PG8_BAR
#undef PG8_SCHED
}
}

#include <hip/hip_bf16.h>
#include <cmath>
namespace attn_body {
using bf16=__hip_bfloat16;
using bf16x8=__attribute__((ext_vector_type(8)))short;
using s16x4=__attribute__((ext_vector_type(4)))short;
using f32x16=__attribute__((ext_vector_type(16)))float;
using u32x4=__attribute__((ext_vector_type(4)))unsigned;
using f32x4v=__attribute__((ext_vector_type(4)))float;
constexpr int BATCH=8,NHEAD=8,SEQ=4096,D=64,DM=NHEAD*D,OPITCH=1536,HP=D;
constexpr int NW=8,QBLK=32,QB=QBLK*NW,KVBLK=64,NQB=SEQ/QB;
constexpr int ATTN_PITCH=DM, ATTN_UNIT_ROWS=QB;
__device__ __forceinline__ int crow(int r,int hi){return (r&3)+8*(r>>2)+4*hi;}
#define SBAR() __builtin_amdgcn_sched_barrier(0)
__device__ __forceinline__ void cmask(f32x16&p0,f32x16&p1,int jb,int qrel,int hi){
  const float NEG=-INFINITY; int kb=64*jb+4*hi;
  #pragma unroll
  for(int r=0;r<16;++r){int kv=kb+(r&3)+8*(r>>2); if(kv>qrel)p0[r]=NEG; if(kv+32>qrel)p1[r]=NEG;}
}

constexpr int NSLOT=3, SLOTB=8192;
constexpr int LDS_K=0, LDS_V=NSLOT*SLOTB, LDS_WS=2*NSLOT*SLOTB, LDS_OST=LDS_WS+NW*64*4, LDS_BYTES=LDS_OST+NW*4096;
constexpr float C2=0.125f*1.4426950408889634f;
__device__ __forceinline__ void glds16(const void*gsrc,unsigned lds_dst){unsigned keep;
  asm volatile("s_mov_b32 %0, m0\n\ts_mov_b32 m0, %2\n\ts_nop 0\n\tglobal_load_lds_dwordx4 %1, off\n\ts_mov_b32 m0, %0":"=&s"(keep):"v"(gsrc),"s"(lds_dst):"memory");}
__device__ __forceinline__ float max3f(float a,float b,float c){float r;asm("v_max3_f32 %0, %1, %2, %3":"=v"(r):"v"(a),"v"(b),"v"(c));return r;}
__device__ __forceinline__ float max2f(float a,float b){float r;asm("v_max_f32_e32 %0, %1, %2":"=v"(r):"v"(a),"v"(b));return r;}
__device__ __forceinline__ float fadd_s(float a,float b){float r;asm("v_add_f32_e32 %0, %1, %2":"=v"(r):"v"(a),"v"(b));return r;}
__device__ __forceinline__ float fsub_s(float a,float b){float r;asm("v_sub_f32_e32 %0, %1, %2":"=v"(r):"v"(a),"v"(b));return r;}
typedef float f32x2_t __attribute__((ext_vector_type(2))); typedef __bf16 bf16x2_t __attribute__((ext_vector_type(2)));
__device__ __forceinline__ unsigned cvtpk_s(float lo,float hi){f32x2_t v={lo,hi};bf16x2_t b=__builtin_convertvector(v,bf16x2_t);return __builtin_bit_cast(unsigned,b);}
#define WAIT_BAR(N) asm volatile("s_waitcnt vmcnt(" #N ") lgkmcnt(0)\n\ts_barrier":::"memory")

__device__ __forceinline__ void qkt(f32x16&p0,f32x16&p1,const char*Kslot,const bf16x8*qr,const f32x16&negm,int r32,int hi){
  const char*kb=Kslot+hi*1024+r32*16;
  #pragma unroll
  for(int d0=0;d0<4;++d0){
    const bf16x8 b0=*reinterpret_cast<const bf16x8*>(kb+d0*2048);
    const bf16x8 b1=*reinterpret_cast<const bf16x8*>(kb+d0*2048+512);
    if(d0==0){p0=__builtin_amdgcn_mfma_f32_32x32x16_bf16(b0,qr[0],negm,0,0,0);p1=__builtin_amdgcn_mfma_f32_32x32x16_bf16(b1,qr[0],negm,0,0,0);}
    else{p0=__builtin_amdgcn_mfma_f32_32x32x16_bf16(b0,qr[d0],p0,0,0,0);p1=__builtin_amdgcn_mfma_f32_32x32x16_bf16(b1,qr[d0],p1,0,0,0);}}
}
typedef __attribute__((address_space(3))) const char* lds_cptr;
typedef short v4i16_t __attribute__((ext_vector_type(4)));
__device__ __forceinline__ void kload8(bf16x8*kf,lds_cptr kp){
  kf[0]=*(const __attribute__((address_space(3))) bf16x8*)(kp);      kf[1]=*(const __attribute__((address_space(3))) bf16x8*)(kp+512);
  kf[2]=*(const __attribute__((address_space(3))) bf16x8*)(kp+2048); kf[3]=*(const __attribute__((address_space(3))) bf16x8*)(kp+2560);
  kf[4]=*(const __attribute__((address_space(3))) bf16x8*)(kp+4096); kf[5]=*(const __attribute__((address_space(3))) bf16x8*)(kp+4608);
  kf[6]=*(const __attribute__((address_space(3))) bf16x8*)(kp+6144); kf[7]=*(const __attribute__((address_space(3))) bf16x8*)(kp+6656);
}
__device__ __forceinline__ void kload2(bf16x8*kf,lds_cptr kp,int j){ kf[2*j]=*(const __attribute__((address_space(3))) bf16x8*)(kp+j*2048); kf[2*j+1]=*(const __attribute__((address_space(3))) bf16x8*)(kp+j*2048+512); }
__device__ __forceinline__ s16x4 vtr(lds_cptr p){ return __builtin_bit_cast(s16x4,__builtin_amdgcn_ds_read_tr16_b64_v4i16((__attribute__((address_space(3))) v4i16_t*)p)); }
__device__ __forceinline__ float rowmax(const f32x16&p0,const f32x16&p1){
  float a=max3f(p0[0],p0[1],p1[0]),b=max3f(p0[2],p0[3],p1[1]);a=max3f(a,p1[2],p1[3]);
  #pragma unroll
  for(int r=4;r<16;r+=4){a=max3f(a,p0[r],p0[r+1]);b=max3f(b,p0[r+2],p0[r+3]);a=max3f(a,p1[r],p1[r+1]);b=max3f(b,p1[r+2],p1[r+3]);}
  const float m=max2f(a,b);
  auto rr=__builtin_amdgcn_permlane32_swap(__float_as_uint(m),__float_as_uint(m),false,false);
  return max2f(__uint_as_float(rr[0]),__uint_as_float(rr[1]));
}
__device__ __forceinline__ void pv(f32x16*o,int vb,bf16x8 pa0,bf16x8 pa1,bf16x8 pa2,bf16x8 pa3){
  #pragma unroll
  for(int d0=0;d0<2;++d0){s16x4 lo[4],hi[4];
    #pragma unroll
    for(int ks=0;ks<4;++ks){
      asm volatile("ds_read_b64_tr_b16 %0,%1 offset:%c2":"=&v"(lo[ks]):"v"(vb),"i"(d0*4096+ks*1024):"memory");
      asm volatile("ds_read_b64_tr_b16 %0,%1 offset:%c2":"=&v"(hi[ks]):"v"(vb),"i"(d0*4096+ks*1024+512):"memory");}
    asm volatile("s_waitcnt lgkmcnt(0)":::"memory");SBAR();
    #define PK(k) (bf16x8){lo[k][0],lo[k][1],lo[k][2],lo[k][3],hi[k][0],hi[k][1],hi[k][2],hi[k][3]}
    o[d0]=__builtin_amdgcn_mfma_f32_32x32x16_bf16(pa0,PK(0),o[d0],0,0,0);
    o[d0]=__builtin_amdgcn_mfma_f32_32x32x16_bf16(pa1,PK(1),o[d0],0,0,0);
    o[d0]=__builtin_amdgcn_mfma_f32_32x32x16_bf16(pa2,PK(2),o[d0],0,0,0);
    o[d0]=__builtin_amdgcn_mfma_f32_32x32x16_bf16(pa3,PK(3),o[d0],0,0,0);
    #undef PK
  }
}

#ifndef ATTN_STORE16
#define ATTN_STORE16(p,v) (*(u32x4*)(p)=(v))
#endif
template<int THRL,bool MOBA> __device__ __forceinline__ void attn_unit(int b,int h,int qb,const bf16*Q,const bf16*__restrict__ K,const bf16*__restrict__ V,bf16*O,const float*kmsum,float*ssq,char*shm){
  int tid_=threadIdx.x; asm volatile("":"+v"(tid_)); const int tid=tid_,lane=tid&63,r32=lane&31,hi=lane>>5; const int wid=__builtin_amdgcn_readfirstlane(tid>>6);
  const long rowbase=(long)b*SEQ; const int q0=qb*QB;
  const long hbase=((long)(b*NHEAD+h)*SEQ)*HP;
  const bf16*Qw=Q+hbase+(long)(q0+wid*QBLK)*HP;
  const bf16*Kh=K+hbase,*Vh=V+hbase;
  const unsigned lds0=(unsigned)(uintptr_t)shm;
  float*wsf=(float*)(shm+LDS_WS)+wid*64;
  const bf16*ksrc=Kh+(long)lane*HP+wid*8;
  const bf16*vsrc=Vh+(long)(16*(wid&3)+(lane>>2))*HP+(wid>>2)*32+(lane&3)*8;
  const unsigned kdst=lds0+LDS_K+wid*1024, vdst=lds0+LDS_V+wid*1024;
  #define DMA_K(t,slot) glds16(ksrc+(long)(t)*KVBLK*HP,(unsigned)__builtin_amdgcn_readfirstlane(kdst+(slot)))
  #define DMA_V(t,slot) glds16(vsrc+(long)(t)*KVBLK*HP,(unsigned)__builtin_amdgcn_readfirstlane(vdst+(slot)))
  const int vb0=(int)(lds0+LDS_V)+((lane>>4)&1)*32+(lane&3)*8+(4*hi+((lane&15)>>2))*64;
  const char*Kbase=shm+LDS_K; bf16x8 kf[8];
  const lds_cptr shm3=(lds_cptr)shm; const lds_cptr kp0=shm3+LDS_K+hi*1024+r32*16; const lds_cptr vp0=shm3+LDS_V+((lane>>4)&1)*32+(lane&3)*8+(4*hi+((lane&15)>>2))*64;
  const int NT=(q0+QB)/KVBLK;
  DMA_K(0,0);DMA_V(0,0);DMA_K(1,SLOTB);
  bf16x8 qr[4];
  #pragma unroll
  for(int d0=0;d0<4;++d0)qr[d0]=*reinterpret_cast<const bf16x8*>(&Qw[(long)r32*HP+d0*16+hi*8]);
  if(MOBA){ const int n_=tid>>5, d_=(tid&31)*2; const float*src_=kmsum+((long)b*16+n_)*DM+h*D+d_; const float k0_=src_[0],k1_=src_[1];
    float*kml_=(float*)(shm+LDS_BYTES)+n_*64+d_; kml_[0]=k0_; kml_[1]=k1_; }
  unsigned selmask=0u;
  float mhat=0.f,l_reg=0.f;f32x16 o[2];o[0]=f32x16{};o[1]=f32x16{};
  const int qrel=wid*QBLK+r32;
  #define SELM(P0,P1,t) do{ const float bs_=(!MOBA||((selmask>>((t)>>2))&1u))?-mhat:-INFINITY; _Pragma("unroll") for(int r_=0;r_<16;++r_){P0[r_]+=bs_;P1[r_]+=bs_;} }while(0)
  #define CMASK(P0,P1,t) do{int jb_=(t)-(NT-4); if(jb_>=0){ const float bm_=-mhat; _Pragma("unroll") for(int r_=0;r_<16;++r_){P0[r_]+=bm_;P1[r_]+=bm_;} cmask(P0,P1,jb_,qrel,hi);} else SELM(P0,P1,t);}while(0)
  bool resc=false;
  #define START(P0,P1) do{ const float rm=rowmax(P0,P1); resc=false; \
    { const float dl=(rm>-1e30f)?rm:0.f; mhat=fadd_s(mhat,dl); \
      _Pragma("unroll") for(int r=0;r<16;++r){P0[r]=fsub_s(P0[r],dl);P1[r]=fsub_s(P1[r],dl);} \
      } \
    _Pragma("unroll") for(int r=0;r<16;++r)P0[r]=__builtin_amdgcn_exp2f(P0[r]); }while(0)
  #define RESC() do{ if(resc){ asm volatile("s_waitcnt lgkmcnt(0)":::"memory"); \
      _Pragma("unroll") for(int d_=0;d_<2;++d_) _Pragma("unroll") for(int r=0;r<16;++r)o[d_][r]*=wsf[crow(r,hi)]; } }while(0)
  f32x16 pA0,pA1,pB0,pB1;
  int sl_prev=0,sl_cur=0,sl_next=SLOTB;
  #define ROT() do{sl_prev=sl_cur;sl_cur=sl_next;sl_next=(sl_next==(NSLOT-1)*SLOTB)?0:sl_next+SLOTB;}while(0)
  DMA_K(2,2*SLOTB);
  if(MOBA) asm volatile("s_waitcnt lgkmcnt(0)\n\ts_barrier":::"memory");
  if(MOBA){ float g[16];
    #pragma unroll
    for(int n=0;n<16;++n)g[n]=-INFINITY;
    const float*kmb=(const float*)(shm+LDS_BYTES)+hi*8;
    #pragma unroll
    for(int n=0;n<15;++n){ if(n<qb){ float a=0.f;
        #pragma unroll
        for(int d0=0;d0<4;++d0){ const f32x4v k0=*reinterpret_cast<const f32x4v*>(kmb+n*64+d0*16), k1=*reinterpret_cast<const f32x4v*>(kmb+n*64+d0*16+4);
          #pragma unroll
          for(int j=0;j<4;++j){ a+=__uint_as_float(((unsigned)(unsigned short)qr[d0][j])<<16)*k0[j]; a+=__uint_as_float(((unsigned)(unsigned short)qr[d0][4+j])<<16)*k1[j]; } }
        a=sum32(a); g[n]=a; } }
    #pragma unroll
    for(int j=0;j<3;++j){ int best=-1; float bv=-INFINITY;
      #pragma unroll
      for(int n=0;n<15;++n) if(g[n]>bv){bv=g[n];best=n;}
      if(best>=0)selmask|=1u<<best;
      #pragma unroll
      for(int n=0;n<15;++n) if(n==best)g[n]=-INFINITY; } }
  WAIT_BAR(3);
  qkt(pA0,pA1,Kbase,qr,f32x16{},r32,hi);asm volatile("s_nop 15\n\ts_nop 7":"+v"(pA0),"+v"(pA1));CMASK(pA0,pA1,0);
  START(pA0,pA1);
  _Pragma("unroll") for(int r=0;r<16;++r)pA1[r]=__builtin_amdgcn_exp2f(pA1[r]);
  WAIT_BAR(0);
  DMA_K(3,0);DMA_V(1,SLOTB);
  ROT();
  kload8(kf,kp0+sl_cur);
  WAIT_BAR(2);
  s16x4 vlo[8],vhi[8]; u32x4 pw0,pw1,pw2,pw3;
  #define PKW(P,B) cvtpk_s(P[B],P[B+1])
  #define PAF(k) __builtin_bit_cast(bf16x8,pw##k)
  #define VFR(i) (bf16x8){vlo[i][0],vlo[i][1],vlo[i][2],vlo[i][3],vhi[i][0],vhi[i][1],vhi[i][2],vhi[i][3]}
  #define PIN(x) asm volatile("":"+v"(x))
  #define MX3(a,b,c) __builtin_fmaxf(__builtin_fmaxf((a),(b)),(c))
  #define GAPA(MF,A0,A1,A2,A3,W0,W1,PW) do{ MF; sacc+=A0; sacc+=A1; sacc+=A2; sacc+=A3; PIN(sacc); W0; W1; PIN(PW); SBAR(); }while(0)
  #define EX(v) __builtin_amdgcn_exp2f(v)
  #define GAPB(MF,X,B) do{ MF; X[B]=EX(X[B]); X[B+1]=EX(X[B+1]); X[B+2]=EX(X[B+2]); X[B+3]=EX(X[B+3]); PIN(X); SBAR(); }while(0)
  #define VRD(i) do{ vlo[i]=vtr(vp_+(((i)>>2)*4096+((i)&3)*1024)); vhi[i]=vtr(vp_+(((i)>>2)*4096+((i)&3)*1024+512)); }while(0)
  #define KRD(G,j) do{ if(G){ kload2(kf,kp0+sl_next,j); SBAR(); } }while(0)
  #define STEP(C0,C1,P0,P1,t,GK,GV,GL) do{ SBAR(); \
    const lds_cptr vp_=vp0+sl_prev; \
    VRD(0); SBAR(); float sacc=(P0[0]+P0[1]); \
    GAPA(C0=__builtin_amdgcn_mfma_f32_32x32x16_bf16(kf[0],qr[0],(f32x16{}),0,0,0), P0[2],P0[3],P0[4],P0[5],     pw0[0]=PKW(P0,0), pw0[1]=PKW(P0,2), pw0); \
    VRD(4); SBAR(); GAPA(C1=__builtin_amdgcn_mfma_f32_32x32x16_bf16(kf[1],qr[0],(f32x16{}),0,0,0), P0[6],P0[7],P0[8],P0[9],     pw0[2]=PKW(P0,4), pw0[3]=PKW(P0,6), pw0); \
    VRD(1); SBAR(); GAPA(C0=__builtin_amdgcn_mfma_f32_32x32x16_bf16(kf[2],qr[1],C0,0,0,0),   P0[10],P0[11],P0[12],P0[13], pw1[0]=PKW(P0,8), pw1[1]=PKW(P0,10), pw1); \
    VRD(5); SBAR(); GAPA(C1=__builtin_amdgcn_mfma_f32_32x32x16_bf16(kf[3],qr[1],C1,0,0,0),   P0[14],P0[15],P1[0],P1[1],   pw1[2]=PKW(P0,12),pw1[3]=PKW(P0,14), pw1); \
    VRD(2); SBAR(); GAPA(C0=__builtin_amdgcn_mfma_f32_32x32x16_bf16(kf[4],qr[2],C0,0,0,0),   P1[2],P1[3],P1[4],P1[5],     pw2[0]=PKW(P1,0), pw2[1]=PKW(P1,2), pw2); \
    VRD(6); SBAR(); GAPA(C1=__builtin_amdgcn_mfma_f32_32x32x16_bf16(kf[5],qr[2],C1,0,0,0),   P1[6],P1[7],P1[8],P1[9],     pw2[2]=PKW(P1,4), pw2[3]=PKW(P1,6), pw2); \
    VRD(3); SBAR(); GAPA(C0=__builtin_amdgcn_mfma_f32_32x32x16_bf16(kf[6],qr[3],C0,0,0,0),   P1[10],P1[11],P1[12],P1[13], pw3[0]=PKW(P1,8), pw3[1]=PKW(P1,10), pw3); \
    VRD(7); SBAR(); GAPA(C1=__builtin_amdgcn_mfma_f32_32x32x16_bf16(kf[7],qr[3],C1,0,0,0),   P1[14],P1[15],0.f,0.f,       pw3[2]=PKW(P1,12),pw3[3]=PKW(P1,14), pw3); \
    l_reg+=sacc; \
    if(GK){DMA_K((t)+3,sl_cur);} if(GV){DMA_V((t)+1,sl_next);} \
    CMASK(C0,C1,t); \
    { float a=MX3(C0[0],C0[1],C1[0]),b=MX3(C0[2],C0[3],C1[1]); a=MX3(a,C1[2],C1[3]); \
      _Pragma("unroll") for(int r=4;r<16;r+=4){a=MX3(a,C0[r],C0[r+1]);b=MX3(b,C0[r+2],C0[r+3]);a=MX3(a,C1[r],C1[r+1]);b=MX3(b,C1[r+2],C1[r+3]);} \
      float rm=__builtin_fmaxf(a,b); { auto rr=__builtin_amdgcn_permlane32_swap(__float_as_uint(rm),__float_as_uint(rm),false,false); rm=__builtin_fmaxf(__uint_as_float(rr[0]),__uint_as_float(rr[1])); } \
      resc=false; \
      if(__builtin_expect(__any(rm>(float)THRL),0)){ const float dl=__builtin_fmaxf(rm,0.f); mhat+=dl; \
        _Pragma("unroll") for(int r=0;r<16;++r){C0[r]-=dl;C1[r]-=dl;} \
        const float f=__builtin_amdgcn_exp2f(-dl); l_reg*=f; if(hi==0)wsf[r32]=f; resc=true; } } \
    SBAR(); \
    GAPB(o[0]=__builtin_amdgcn_mfma_f32_32x32x16_bf16(PAF(0),VFR(0),o[0],0,0,0), C0,0); \
    GAPB(o[1]=__builtin_amdgcn_mfma_f32_32x32x16_bf16(PAF(0),VFR(4),o[1],0,0,0), C0,4); \
    KRD(GL,0); GAPB(o[0]=__builtin_amdgcn_mfma_f32_32x32x16_bf16(PAF(1),VFR(1),o[0],0,0,0), C0,8); \
    KRD(GL,1); GAPB(o[1]=__builtin_amdgcn_mfma_f32_32x32x16_bf16(PAF(1),VFR(5),o[1],0,0,0), C0,12); \
    KRD(GL,2); GAPB(o[0]=__builtin_amdgcn_mfma_f32_32x32x16_bf16(PAF(2),VFR(2),o[0],0,0,0), C1,0); \
    KRD(GL,3); GAPB(o[1]=__builtin_amdgcn_mfma_f32_32x32x16_bf16(PAF(2),VFR(6),o[1],0,0,0), C1,4); \
    GAPB(o[0]=__builtin_amdgcn_mfma_f32_32x32x16_bf16(PAF(3),VFR(3),o[0],0,0,0), C1,8); \
    GAPB(o[1]=__builtin_amdgcn_mfma_f32_32x32x16_bf16(PAF(3),VFR(7),o[1],0,0,0), C1,12); \
    }while(0)
  int t=1;
  #undef CMASK
  #define CMASK(P0,P1,t) SELM(P0,P1,t)
  for(;t+5<NT;t+=2){
    STEP(pB0,pB1,pA0,pA1,t,true,true,true);     WAIT_BAR(2); RESC(); ROT();
    STEP(pA0,pA1,pB0,pB1,t+1,true,true,true);   WAIT_BAR(2); RESC(); ROT();
  }
  #undef CMASK
  #define CMASK(P0,P1,t) do{int jb_=(t)-(NT-4); if(jb_>=0){ const float bm_=-mhat; _Pragma("unroll") for(int r_=0;r_<16;++r_){P0[r_]+=bm_;P1[r_]+=bm_;} cmask(P0,P1,jb_,qrel,hi);} else SELM(P0,P1,t);}while(0)
  #define ENDW(tt) do{ if((tt)+3<NT){WAIT_BAR(2);} else if((tt)+2<NT){WAIT_BAR(1);} else {WAIT_BAR(0);} }while(0)
  for(;t+1<NT;t+=2){
    STEP(pB0,pB1,pA0,pA1,t,(t+3<NT),(t+1<NT),(t+1<NT));       ENDW(t);   RESC(); ROT();
    STEP(pA0,pA1,pB0,pB1,t+1,(t+4<NT),(t+2<NT),(t+2<NT));     ENDW(t+1); RESC(); ROT();
  }
  STEP(pB0,pB1,pA0,pA1,NT-1,false,false,false); RESC();
  { float sacc=pB0[0]+pB0[1]; _Pragma("unroll") for(int r=2;r<16;++r)sacc+=pB0[r]; _Pragma("unroll") for(int r=0;r<16;++r)sacc+=pB1[r]; l_reg+=sacc;
    pw0=(u32x4){PKW(pB0,0),PKW(pB0,2),PKW(pB0,4),PKW(pB0,6)};pw1=(u32x4){PKW(pB0,8),PKW(pB0,10),PKW(pB0,12),PKW(pB0,14)};pw2=(u32x4){PKW(pB1,0),PKW(pB1,2),PKW(pB1,4),PKW(pB1,6)};pw3=(u32x4){PKW(pB1,8),PKW(pB1,10),PKW(pB1,12),PKW(pB1,14)};
    SBAR(); pv(o,vb0+sl_cur,PAF(0),PAF(1),PAF(2),PAF(3)); }
  #undef PKW
  #undef PAF
  #undef VFR
  #undef PIN
  #undef MX3
  #undef GAPA
  #undef GAPB
  #undef EX
  #undef VRD
  #undef KRD
  #undef STEP
  #undef ENDW
  {auto rr=__builtin_amdgcn_permlane32_swap(__float_as_uint(l_reg),__float_as_uint(l_reg),false,false);l_reg=__uint_as_float(rr[0])+__uint_as_float(rr[1]);}
  if(hi==0)wsf[32+r32]=l_reg;asm volatile("s_waitcnt lgkmcnt(0)":::"memory");
  float rli[16];
  #pragma unroll
  for(int r=0;r<16;++r)rli[r]=__builtin_amdgcn_rcpf(wsf[32+crow(r,hi)]);
  bf16*Ow=O+(rowbase+q0+wid*QBLK)*OPITCH+h*D;
  { bf16*stg=(bf16*)(shm+LDS_OST)+wid*2048;
    #pragma unroll
    for(int r=0;r<16;++r){const int orow=crow(r,hi);
      #pragma unroll
      for(int d0=0;d0<2;++d0)stg[orow*64+d0*32+r32]=__float2bfloat16(o[d0][r]*rli[r]);}
    asm volatile("s_waitcnt lgkmcnt(0)":::"memory");
    #pragma unroll
    for(int i=0;i<4;++i){const int row=i*8+(lane>>3),ch=lane&7; const u32x4 v=*(const u32x4*)(stg+row*64+ch*8); ATTN_STORE16(Ow+(long)row*OPITCH+ch*8,v);
      float sq=0.f;
      #pragma unroll
      for(int e=0;e<4;++e){const float lo=__uint_as_float(v[e]<<16),hi_=__uint_as_float(v[e]&0xffff0000u); sq+=lo*lo+hi_*hi_;}
      sq+=shx(sq,1);sq+=shx(sq,2);sq+=shx(sq,4); if(ch==0)atomicAdd(ssq+rowbase+q0+wid*QBLK+row,sq);} }
  asm volatile("s_waitcnt lgkmcnt(0)\n\ts_barrier":::"memory");
  #undef DMA_K
  #undef DMA_V
  #undef CMASK
  #undef SELM
  #undef START
  #undef RESC
  #undef ROT
}
constexpr int ATTN_LDS_BYTES=LDS_BYTES;
struct AttnTensors { const bf16* Q; const bf16* K; const bf16* V; bf16* O; const float* kmsum; float* ssq; };
struct AttnUnit { int bh; int qb; };
struct StaticOrder {
  int vcu,G;
  __device__ __forceinline__ explicit StaticOrder(int grid,int vcu_):vcu(vcu_),G(grid){}
  __device__ __forceinline__ bool next(int i,AttnUnit&u)const{ const int k=vcu+i*G; if(k>=1024)return false; const int v=k&255,ii=k>>8,s=v&7; u.bh=(v>>3)+32*(ii>>1); u.qb=(ii&1)?s:15-s; return true; }
  __device__ __forceinline__ void a_ready(const AttnUnit&)const{}
  __device__ __forceinline__ void done(const AttnUnit&)const{}
};
template<class Sched,bool MOBA=true,int THRL=8> __device__ __forceinline__ void attn_phase(char*lds,const AttnTensors&T,const Sched&S){
  AttnUnit u;
  for(int i=0;S.next(i,u);++i){ S.a_ready(u); attn_unit<THRL,MOBA>(u.bh/NHEAD,u.bh%NHEAD,u.qb,T.Q,T.K,T.V,T.O,T.kmsum,T.ssq,lds); S.done(u); }
}
template<class Sched,bool MOBA=true,int THRL=8> __device__ __forceinline__ void attn_range(char*lds,const AttnTensors&T,const Sched&S,const int i0,const int i1){
  AttnUnit u;
  for(int i=i0;i<i1&&S.next(i,u);++i){ attn_unit<THRL,MOBA>(u.bh/NHEAD,u.bh%NHEAD,u.qb,T.Q,T.K,T.V,T.O,T.kmsum,T.ssq,lds); }
}
#undef SBAR
#undef WAIT_BAR
}

constexpr int NWAVES = 8;
constexpr int BATCH = 8, SEQ = 4096, T = BATCH * SEQ, DMODEL = 1024, DFF = 2816, NCHUNK = 16;
constexpr int DATTN = 512, DSSM = 1024, DCONV = 1536, NPROJ = 4112, DMIX = 1536, NHSSM = 16, DSTATE = 128;
constexpr size_t MiB = 1u << 20;
constexpr size_t WS_CTL = 0, WS_ACC = 1 * MiB, CTL_ZERO_BYTES = 2 * MiB;
constexpr size_t ACC_SSX1 = WS_ACC, ACC_SSX2 = WS_ACC + 128 * 1024, ACC_SSX3 = WS_ACC + 256 * 1024, ACC_SSA = WS_ACC + 384 * 1024, ACC_SSG = WS_ACC + 512 * 1024  , ACC_KM = WS_ACC + 768 * 1024  ;
constexpr size_t WS_SSX0 = 2 * MiB, WS_CS = 2 * MiB + 256 * 1024  , WS_DTRAW = 3 * MiB  , WS_DTH = 5 * MiB  , WS_ACSH = 7 * MiB;
constexpr size_t WS_W13 = 10 * MiB  , WS_W2 = 21 * MiB  , WS_WIN = 27 * MiB  , WS_WDT = 35 * MiB  , WS_WOUT = 36 * MiB  ;
constexpr size_t WS_XB = 48 * MiB;
constexpr size_t WS_XT = 112 * MiB;
constexpr size_t WS_R = 240 * MiB;
constexpr size_t WS_Q = WS_R, WS_K = WS_R + 32 * MiB, WS_V = WS_R + 64 * MiB, WS_Z = WS_R + 96 * MiB, WS_BT = WS_R + 160 * MiB;
constexpr size_t WS_S = 416 * MiB;
constexpr size_t WS_ST = WS_S, WS_SP = WS_S + 64 * MiB;
constexpr size_t WS_XA8 = 176 * MiB;
constexpr size_t WS_END = 512 * MiB;
constexpr size_t DO_OY = 0, DO_BC = 96 * MiB;
constexpr int CW_BAR = 4096;
constexpr int CW_PANEL = 16384;
constexpr int RING_OFF = 0, RING_BYTES = 131072, LDSCTL_OFF = RING_BYTES, MISC_OFF = LDSCTL_OFF + 320, TAB_OFF = LDSCTL_OFF + 1024  , LDS_BYTES = 147456;
static_assert(TAB_OFF + 8 * 384 * 4 <= LDS_BYTES, "LDS map");

#define GAS __attribute__((address_space(1)))
#define LAS __attribute__((address_space(3)))
typedef unsigned short bf16;
typedef unsigned v4u __attribute__((ext_vector_type(4)));
typedef float f32x4 __attribute__((ext_vector_type(4)));
typedef short bf16x8 __attribute__((ext_vector_type(8)));
typedef GAS unsigned gu32;
typedef GAS unsigned long long gu64;
#define RLX_AGENT __ATOMIC_RELAXED, __HIP_MEMORY_SCOPE_AGENT
#define LDS_WAIT() asm volatile("s_waitcnt lgkmcnt(0)" ::: "memory")
#define VM_WAIT() asm volatile("s_waitcnt vmcnt(0)" ::: "memory")
__device__ __forceinline__ unsigned long long rt() { return __builtin_amdgcn_s_memrealtime(); }
__device__ __forceinline__ unsigned f2bf(float f) { unsigned u = __builtin_bit_cast(unsigned, f); return (u + 0x7fffu + ((u >> 16) & 1u)) >> 16; }
__device__ __forceinline__ unsigned pk2(float lo, float hi) { return f2bf(lo) | (f2bf(hi) << 16); }

#define XB_TMO      128
#define XB_XCNT(j)  (256  + 64 * (j))
#define XB_XSUB(j)  (1280 + 64 * (j))
#define XB_XGEN(j)  (2304 + 64 * (j))
#define XB_TOP      3328
#define XB_TOPGEN   3392
#define XCD_BAR_WORDS 3456
#define XB_SPIN_CAP (1u << 18)

__device__ __forceinline__ unsigned xb_ld(unsigned* p)              { return __hip_atomic_load(p, __ATOMIC_RELAXED, __HIP_MEMORY_SCOPE_AGENT); }
__device__ __forceinline__ unsigned xb_add(unsigned* p, unsigned v) { return __hip_atomic_fetch_add(p, v, __ATOMIC_RELAXED, __HIP_MEMORY_SCOPE_AGENT); }
__device__ __forceinline__ unsigned xb_xcc_id() { return (unsigned)__builtin_amdgcn_s_getreg((3 << 11) | 20) & 0xFu; }
#define XB_SPIN(cond, bar) do { unsigned _sp = 0; while (cond) { __builtin_amdgcn_s_sleep(1); \
    if ((++_sp & 255u) == 0u) { if (xb_ld(&(bar)[XB_TMO])) break; if (_sp > XB_SPIN_CAP) { atomicAdd(&(bar)[XB_TMO], 1u); break; } } } } while (0)

struct XcdBarrier {
    unsigned* bar; unsigned x;
    volatile LAS unsigned* st;
};

__device__ __forceinline__ XcdBarrier xcd_barrier_post(unsigned* bar, volatile LAS unsigned* st) {
    XcdBarrier b; b.bar = bar; b.x = xb_xcc_id(); b.st = st;
    if (threadIdx.x == 0) (void)xb_add(&bar[XB_XCNT(b.x)], 1u);
    return b;
}
__device__ __forceinline__ void xcd_barrier_complete(unsigned* bar, unsigned x, unsigned& nloc, unsigned& nx) {
    const unsigned G = gridDim.x * gridDim.y * gridDim.z;
    unsigned sum, cnt, mine, sp = 0u;
    for (;;) {
        sum = 0u; cnt = 0u; mine = 0u;
#pragma unroll
        for (unsigned j = 0; j < 16; ++j) { const unsigned c = xb_ld(&bar[XB_XCNT(j)]); sum += c; cnt += (c > 0u) ? 1u : 0u; mine = (j == x) ? c : mine; }
        if (sum == G) break;
        __builtin_amdgcn_s_sleep(1);
        if ((++sp & 255u) == 0u) { if (xb_ld(&bar[XB_TMO])) break; if (sp > XB_SPIN_CAP) { atomicAdd(&bar[XB_TMO], 1u); break; } }
    }
    nloc = mine > 0u ? mine : 1u; nx = cnt > 0u ? cnt : 1u;
}

__device__ __forceinline__ void xcd_barrier(const XcdBarrier& b) {
    asm volatile("s_waitcnt vmcnt(0)" ::: "memory");
    __syncthreads();
    if (threadIdx.x == 0) {
        unsigned* bar = b.bar;
        __builtin_amdgcn_s_waitcnt(0);
        unsigned nloc = b.st[0], nx = b.st[1];
        if (nloc == 0u) { xcd_barrier_complete(bar, b.x, nloc, nx); b.st[0] = nloc; b.st[1] = nx; }
        const unsigned old = xb_add(&bar[XB_XSUB(b.x)], 1u);
        const unsigned gen = old / nloc;
        if (old + 1u == (gen + 1u) * nloc) {
            __builtin_amdgcn_fence(__ATOMIC_RELEASE, "agent");
            asm volatile("s_waitcnt vmcnt(0)" ::: "memory");
            const unsigned og = xb_add(&bar[XB_TOP], 1u);
            const unsigned tg = og / nx;
            if (og + 1u == (tg + 1u) * nx) xb_add(&bar[XB_TOPGEN], 1u);
            else XB_SPIN(xb_ld(&bar[XB_TOPGEN]) == tg, bar);
            __builtin_amdgcn_fence(__ATOMIC_ACQUIRE, "agent");
            xb_add(&bar[XB_XGEN(b.x)], 1u);
            asm volatile("s_waitcnt vmcnt(0)" ::: "memory");
        } else {
            XB_SPIN(xb_ld(&bar[XB_XGEN(b.x)]) == gen, bar);
            __builtin_amdgcn_fence(__ATOMIC_ACQUIRE, "agent");
            asm volatile("s_waitcnt vmcnt(0)" ::: "memory");
        }
    }
    __syncthreads();
}

typedef float f32x16 __attribute__((ext_vector_type(16)));
typedef unsigned u32x2v __attribute__((ext_vector_type(2)));
__device__ __forceinline__ float bf2f(unsigned short h) { return __uint_as_float(((unsigned)h) << 16); }
__device__ __forceinline__ unsigned pkbf(float lo, float hi) { return pg8::cvt_pk_bf16(lo, hi); }
__device__ __forceinline__ int crow(int r, int hi) { return (r & 3) + 8 * (r >> 2) + 4 * hi; }
__device__ __forceinline__ int perm16(int i) { return 8 * ((i & 7) >> 2) + 4 * (i >> 3) + (i & 3); }

struct Frame {
    LAS unsigned char* lds;
    volatile LAS unsigned* MISC;
    gu32* ctl;
    int tid, lane, wave, vcu, G;
    float* out; unsigned char* ws;
};
struct Args { const float* in[20]; float* out; unsigned char* ws; };
__device__ __forceinline__ const float* inp(int i) { const __attribute__((address_space(4))) Args* p = (const __attribute__((address_space(4))) Args*)__builtin_amdgcn_kernarg_segment_ptr(); asm volatile("" : "+s"(p)); return p->in[i]; }
__device__ __forceinline__ float wave_sum(float v) {
#pragma unroll
    for (int o = 1; o < 64; o <<= 1) v += shx(v, o);
    return v;
}

__device__ __forceinline__ void wconv_item(const float* W, int K, int N, int item, int mode, const float* gain, const float* gain2, bf16* dst, bf16* dst2, LAS float* scr, int lane) {
    const int nblk = (N + 31) / 32, kb = item / nblk, nb = item % nblk, k0 = 64 * kb, n0 = 32 * nb;
    const bool nok = (n0 + (lane & 31)) < N;
    float wv_[32];
#pragma unroll
    for (int i = 0; i < 32; ++i) { const int kk = 2 * i + (lane >> 5); wv_[i] = nok ? ((const GAS float*)W)[(size_t)(k0 + kk) * N + n0 + (lane & 31)] : 0.f; }
#pragma unroll
    for (int i = 0; i < 32; ++i) { const int kk = 2 * i + (lane >> 5); scr[kk * 33 + (lane & 31)] = wv_[i]; }
    if (false)
    for (int i = 0; i < 32; ++i) { const int kk = 2 * i + (lane >> 5); scr[kk * 33 + (lane & 31)] = nok ? ((const GAS float*)W)[(size_t)(k0 + kk) * N + n0 + (lane & 31)] : 0.f; }
    LDS_WAIT(); asm volatile("" ::: "memory");
    const int c = lane & 7;
    float gv[8];
#pragma unroll
    for (int e = 0; e < 8; ++e) gv[e] = 1.0f;
    if (gain) {
        const int kb8 = k0 + 8 * c; const GAS float* gp = (gain2 && kb8 >= 512) ? (const GAS float*)gain2 + (kb8 - 512) : (const GAS float*)gain + kb8;
        const f32x4 g0 = *(const GAS f32x4*)gp, g1 = *(const GAS f32x4*)(gp + 4);
        gv[0] = g0.x; gv[1] = g0.y; gv[2] = g0.z; gv[3] = g0.w; gv[4] = g1.x; gv[5] = g1.y; gv[6] = g1.z; gv[7] = g1.w; }
#pragma unroll
    for (int j = 0; j < 4; ++j) { const int nl = (lane >> 3) + 8 * j, n = n0 + nl; const LAS float* s = scr + (8 * c) * 33 + nl;
        v4u o; o.x = pkbf(s[0 * 33] * gv[0], s[1 * 33] * gv[1]); o.y = pkbf(s[2 * 33] * gv[2], s[3 * 33] * gv[3]); o.z = pkbf(s[4 * 33] * gv[4], s[5 * 33] * gv[5]); o.w = pkbf(s[6 * 33] * gv[6], s[7 * 33] * gv[7]);
        bf16* d = dst; int nr = n;
        if (mode == 1) nr = 256 * (n >> 7) + (n & 127); else if (mode == 2) nr = 256 * (n >> 7) + 128 + (n & 127); else if (mode == 3 && n >= 4096) { d = dst2; nr = n - 4096; }
        if (n < N) *(GAS v4u*)(d + (size_t)nr * K + k0 + 8 * c) = o; }
    LDS_WAIT(); asm volatile("" ::: "memory");
}
__device__ __forceinline__ void wconv_item8(const float* W, int K, int N, int item, int mode, const float* gain, float scale, unsigned char* dst, LAS float* scr, int lane) {
    const int nblk = N / 32, kb = item / nblk, nb = item % nblk, k0 = 64 * kb, n0 = 32 * nb;
    float wv_[32];
#pragma unroll
    for (int i = 0; i < 32; ++i) { const int kk = 2 * i + (lane >> 5); wv_[i] = ((const GAS float*)W)[(size_t)(k0 + kk) * N + n0 + (lane & 31)]; }
#pragma unroll
    for (int i = 0; i < 32; ++i) { const int kk = 2 * i + (lane >> 5); scr[kk * 33 + (lane & 31)] = wv_[i]; }
    LDS_WAIT(); asm volatile("" ::: "memory");
    const int c = lane & 7;
    float gv[8];
#pragma unroll
    for (int e = 0; e < 8; ++e) gv[e] = scale;
    if (gain) { const GAS float* gp = (const GAS float*)gain + k0 + 8 * c; const f32x4 g0 = *(const GAS f32x4*)gp, g1 = *(const GAS f32x4*)(gp + 4);
        gv[0] *= g0.x; gv[1] *= g0.y; gv[2] *= g0.z; gv[3] *= g0.w; gv[4] *= g1.x; gv[5] *= g1.y; gv[6] *= g1.z; gv[7] *= g1.w; }
#pragma unroll
    for (int j = 0; j < 4; ++j) { const int nl = (lane >> 3) + 8 * j, n = n0 + nl; const LAS float* s = scr + (8 * c) * 33 + nl;
        pg8::u32x2 o; o.x = pg8::cvt4_fp8(s[0 * 33] * gv[0], s[1 * 33] * gv[1], s[2 * 33] * gv[2], s[3 * 33] * gv[3]); o.y = pg8::cvt4_fp8(s[4 * 33] * gv[4], s[5 * 33] * gv[5], s[6 * 33] * gv[6], s[7 * 33] * gv[7]);
        int nr = n; if (mode == 1) nr = 256 * (n >> 7) + (n & 127); else if (mode == 2) nr = 256 * (n >> 7) + 128 + (n & 127);
        *(GAS pg8::u32x2*)(dst + (size_t)nr * K + k0 + 8 * c) = o; }
    LDS_WAIT(); asm volatile("" ::: "memory");
}
constexpr int FP8_SB13 = 5, FP8_SB2 = 6;
__device__ __forceinline__ void ffn_weights8(Frame& F, const float* w1, const float* w3, const float* w2, const float* gain, int gw, int NGW, LAS float* scr) {
    constexpr int I13 = (DMODEL / 64) * (DFF / 32), I2 = (DFF / 64) * (DMODEL / 32);
    unsigned char* W13 = F.ws + WS_W13; unsigned char* W2 = F.ws + WS_W2;
    for (int it = gw; it < 2 * I13 + I2; it += NGW) {
        int r = it;
        if (r < I13) { wconv_item8(w1, DMODEL, DFF, r, 1, gain, (float)(1 << FP8_SB13), W13, scr, F.lane); continue; } r -= I13;
        if (r < I13) { wconv_item8(w3, DMODEL, DFF, r, 2, gain, (float)(1 << FP8_SB13), W13, scr, F.lane); continue; } r -= I13;
        wconv_item8(w2, DFF, DMODEL, r, 0, nullptr, (float)(1 << FP8_SB2), W2, scr, F.lane);
    }
}
__device__ __forceinline__ void ffn_weights(Frame& F, const float* w1, const float* w3, const float* w2, const float* gain, int gw, int NGW, LAS float* scr) {
    constexpr int I13 = (DMODEL / 64) * (DFF / 32), I2 = (DFF / 64) * (DMODEL / 32);
    bf16* W13 = (bf16*)(F.ws + WS_W13); bf16* W2 = (bf16*)(F.ws + WS_W2);
    for (int it = gw; it < 2 * I13 + I2; it += NGW) {
        int r = it;
        if (r < I13) { wconv_item(w1, DMODEL, DFF, r, 1, gain, nullptr, W13, nullptr, scr, F.lane); continue; } r -= I13;
        if (r < I13) { wconv_item(w3, DMODEL, DFF, r, 2, gain, nullptr, W13, nullptr, scr, F.lane); continue; } r -= I13;
        wconv_item(w2, DFF, DMODEL, r, 0, nullptr, nullptr, W2, nullptr, scr, F.lane);
    }
}

__device__ __forceinline__ void ffn_weights_sel(Frame& F, const float* w1, const float* w3, const float* w2, const float* gain, int gw, int NGW, LAS float* scr, bool up8, bool dn8) {
    constexpr int I13 = (DMODEL / 64) * (DFF / 32), I2 = (DFF / 64) * (DMODEL / 32);
    for (int it = gw; it < 2 * I13 + I2; it += NGW) {
        int r = it;
        if (r < 2 * I13) { const bool third = r >= I13; const int rr = third ? r - I13 : r; const float* w = third ? w3 : w1;
            if (up8) wconv_item8(w, DMODEL, DFF, rr, third ? 2 : 1, gain, (float)(1 << FP8_SB13), F.ws + WS_W13, scr, F.lane);
            else wconv_item(w, DMODEL, DFF, rr, third ? 2 : 1, gain, nullptr, (bf16*)(F.ws + WS_W13), nullptr, scr, F.lane);
            continue; }
        r -= 2 * I13;
        if (dn8) wconv_item8(w2, DFF, DMODEL, r, 0, nullptr, (float)(1 << FP8_SB2), F.ws + WS_W2, scr, F.lane);
        else wconv_item(w2, DFF, DMODEL, r, 0, nullptr, nullptr, (bf16*)(F.ws + WS_W2), nullptr, scr, F.lane);
    }
}
__device__ __forceinline__ void p0_prologue(Frame& F) {
    LAS float* scr = (LAS float*)(F.lds + RING_OFF + F.wave * 16384);
    const int gw = F.vcu * NWAVES + F.wave, NGW = F.G * NWAVES;
    ffn_weights_sel(F, inp(2), inp(3), inp(4), inp(1), gw, NGW, scr, MK_FP8_FFN1 == 1 || MK_FP8_FFN1 == 2, MK_FP8_FFN1 == 1 || MK_FP8_FFN1 == 3);
    {
        constexpr int IIN = (DMODEL / 64) * ((NPROJ + 31) / 32), IOUT = (DMIX / 64) * (DMODEL / 32);
        for (int it = gw; it < IIN + IOUT; it += NGW) {
            if (it < IIN) wconv_item(inp(6), DMODEL, NPROJ, it, 3, inp(5), nullptr, (bf16*)(F.ws + WS_WIN), (bf16*)(F.ws + WS_WDT), scr, F.lane);
            else wconv_item(inp(14), DMIX, DMODEL, it - IIN, 0, inp(12), inp(13), (bf16*)(F.ws + WS_WOUT), nullptr, scr, F.lane);
        }
    }
    {
        float* cs = (float*)(F.ws + WS_CS);
        for (int i = (F.vcu * NWAVES * 64) + F.tid; i < SEQ * 8; i += F.G * NWAVES * 64) {
            const int pos = i >> 3, k = i & 7;
            const float inv = powf(500000.0f, -(float)k * 0.125f), ang = (float)pos * inv;
            cs[pos * 16 + k] = cosf(ang); cs[pos * 16 + 8 + k] = sinf(ang);
        }
    }
    {
        const float* x = inp(0); bf16* XB = (bf16*)(F.ws + WS_XB); float* ss0 = (float*)(F.ws + WS_SSX0);
        f32x4 v[4][4], nv[4][4];
#define P0_LOAD(dst, mm0) do { _Pragma("unroll") for (int r_ = 0; r_ < 4; ++r_) { const int m_ = (mm0) + r_ * NGW; const GAS f32x4* xr_ = (const GAS f32x4*)(x + (size_t)(m_ < T ? m_ : 0) * DMODEL) + F.lane; \
            _Pragma("unroll") for (int j_ = 0; j_ < 4; ++j_) dst[r_][j_] = xr_[64 * j_]; } } while (0)
        if (gw < T) P0_LOAD(v, gw);
        for (int m0 = gw; m0 < T; m0 += 4 * NGW) {
            const bool more = (m0 + 4 * NGW) < T;
            if (more) P0_LOAD(nv, m0 + 4 * NGW);
#pragma unroll
            for (int r = 0; r < 4; ++r) { const int m = m0 + r * NGW; if (m < T) { float s = 0.f;
#pragma unroll
                for (int j = 0; j < 4; ++j) s += (v[r][j].x * v[r][j].x + v[r][j].y * v[r][j].y) + (v[r][j].z * v[r][j].z + v[r][j].w * v[r][j].w);
                s = wave_sum(s);
                if (F.lane == 0) ss0[m] = s;
                GAS unsigned long long* o8 = (GAS unsigned long long*)(XB + (size_t)m * DMODEL) + F.lane;
#pragma unroll
                for (int j = 0; j < 4; ++j) o8[64 * j] = (unsigned long long)pkbf(v[r][j].x, v[r][j].y) | ((unsigned long long)pkbf(v[r][j].z, v[r][j].w) << 32);
#if MK_FP8_FFN1
                GAS unsigned* o4 = (GAS unsigned*)(F.ws + WS_XA8 + (size_t)m * DMODEL) + F.lane;
#pragma unroll
                for (int j = 0; j < 4; ++j) o4[64 * j] = pg8::cvt4_fp8(v[r][j].x, v[r][j].y, v[r][j].z, v[r][j].w);
#endif
            } }
            if (more) {
#pragma unroll
                for (int r = 0; r < 4; ++r)
#pragma unroll
                    for (int j = 0; j < 4; ++j) v[r][j] = nv[r][j]; }
        }
#undef P0_LOAD
    }
}

__device__ __forceinline__ void dt_proj(Frame& F) {
    const int gw = F.vcu * NWAVES + F.wave, NGW = F.G * NWAVES;
    const bf16* XB = (const bf16*)(F.ws + WS_XB); const bf16* Wdt = (const bf16*)(F.ws + WS_WDT); const float* ss1 = (const float*)(F.ws + ACC_SSX1); float* dtr = (float*)(F.ws + WS_DTRAW);
    const int fr = F.lane & 15, fq = F.lane >> 4;
    for (int it = gw; it < T / 16; it += NGW) {
        const int row0 = it * 16;
        f32x4 a0 = {0.f, 0.f, 0.f, 0.f}, a1 = {0.f, 0.f, 0.f, 0.f};
        const bf16* ap0 = XB + (size_t)(row0 + fr) * DMODEL + 8 * fq; const bf16* bp = Wdt + (size_t)fr * DMODEL + 8 * fq;
#pragma unroll 8
        for (int k = 0; k < DMODEL; k += 64) {
            const bf16x8 b0 = *(const GAS bf16x8*)(bp + k), x0 = *(const GAS bf16x8*)(ap0 + k), b1 = *(const GAS bf16x8*)(bp + k + 32), x1 = *(const GAS bf16x8*)(ap0 + k + 32);
            a0 = __builtin_amdgcn_mfma_f32_16x16x32_bf16(x0, b0, a0, 0, 0, 0);
            a1 = __builtin_amdgcn_mfma_f32_16x16x32_bf16(x1, b1, a1, 0, 0, 0);
        }
#pragma unroll
        for (int r = 0; r < 4; ++r) { const int t0 = row0 + 4 * fq + r; dtr[(size_t)t0 * 16 + fr] = (a0[r] + a1[r]) * rsqrtf(ss1[t0] * (1.0f / 1024.0f) + pg8::RMS_EPS); }
    }
}
__device__ __forceinline__ void glds16(const void* gsrc, LAS unsigned char* ldst) { __builtin_amdgcn_global_load_lds((const GAS unsigned*)gsrc, (LAS unsigned*)ldst, 16, 0, 0); }
template <class TT> __device__ __forceinline__ TT ldu(const void* ubase, unsigned voff) { return *(const GAS TT*)((const GAS char*)ubase + voff); }
#define LDS_BAR() asm volatile("s_waitcnt lgkmcnt(0)\n\ts_barrier" ::: "memory")
__device__ __forceinline__ void p4_conv(Frame& F, const int j0 = 0, const int j1 = 1 << 20) {
    const bf16* XBC = (const bf16*)(F.ws + WS_S); bf16* XT = (bf16*)(F.ws + WS_XT); bf16* BT = (bf16*)(F.ws + WS_BT); bf16* BC = (bf16*)((unsigned char*)F.out + DO_BC);
    const float* cw = inp(7); const float* cbias = inp(8);
    LAS bf16* U = (LAS bf16*)(F.lds + RING_OFF);
    LAS bf16* Vt = (LAS bf16*)(F.lds + RING_OFF + 34816);
    const int tid = F.tid;
    v4u pre[5];
#define P4_FETCH(uu) do { const int bc_ = (uu) / 24, cb_ = (uu) % 24, c_ = bc_ & 15, t0_ = bc_ * 256, ch0_ = cb_ * 64; \
        _Pragma("unroll") for (int k_ = 0; k_ < 5; ++k_) { const int i_ = tid + 512 * k_, rr_ = i_ >> 3, ck_ = i_ & 7; pre[k_] = (v4u){0u, 0u, 0u, 0u}; \
            if (i_ < 259 * 8 && !(c_ == 0 && rr_ < 3)) pre[k_] = *(const GAS v4u*)(XBC + (size_t)(t0_ - 3 + rr_) * DCONV + ch0_ + ck_ * 8); } } while (0)
    const int uend = (j1 >= (1 << 20)) ? 128 * 24 : min(128 * 24, F.vcu + j1 * (int)F.G);
    if (F.vcu + j0 * (int)F.G < uend) P4_FETCH(F.vcu + j0 * (int)F.G);
    for (int u = F.vcu + j0 * (int)F.G; u < uend; u += F.G) {
        const int bc = u / 24, cb = u % 24, t0 = bc * 256, ch0 = cb * 64;
#pragma unroll
        for (int k = 0; k < 5; ++k) { const int i = tid + 512 * k; if (i < 259 * 8) *(LAS v4u*)(U + (i >> 3) * 64 + (i & 7) * 8) = pre[k]; }
        const int ch_ = tid & 63, cg_ = ch0 + ch_;
        float w0 = cw[cg_], w1 = cw[DCONV + cg_], w2 = cw[2 * DCONV + cg_], w3 = cw[3 * DCONV + cg_], bb = cbias[cg_];
        asm volatile("" : "+v"(w0), "+v"(w1), "+v"(w2), "+v"(w3), "+v"(bb));
        LDS_BAR();
        if (u + F.G < uend) P4_FETCH(u + F.G);
        {   const int ch = tid & 63, tg = tid >> 6;
            float u0 = bf2f(U[(32 * tg) * 64 + ch]), u1 = bf2f(U[(32 * tg + 1) * 64 + ch]), u2 = bf2f(U[(32 * tg + 2) * 64 + ch]);
#pragma unroll 8
            for (int t = 32 * tg; t < 32 * tg + 32; ++t) {
                const float u3 = bf2f(U[(t + 3) * 64 + ch]);
                const float a = bb + w0 * u0 + w1 * u1 + w2 * u2 + w3 * u3;
                const float s = pg8::silu_f(a);
                Vt[t * 72 + ch] = (bf16)(pkbf(s, 0.f) & 0xffffu);
                u0 = u1; u1 = u2; u2 = u3;
            } }
        LDS_BAR();
        if (cb < 20) {
            bf16* dstT = cb < 16 ? XT + (size_t)((bc * 16 + cb) * 2) * 16 * 512 : BT + (size_t)(((bc * 2 + ((cb - 16) >> 1)) * 4 + ((cb - 16) & 1) * 2)) * 16 * 512;
#pragma unroll 1
            for (int j = 0; j < 4; ++j) { const int it = tid + 512 * j, r = it & 31, h = (it >> 5) & 1, kst = (it >> 6) & 15, pt = it >> 10, ch = 32 * pt + r;
                unsigned short e[8];
#pragma unroll
                for (int k = 0; k < 8; ++k) { const int tok = 16 * kst + perm16(8 * h + k); e[k] = Vt[tok * 72 + ch]; }
                v4u o; o.x = e[0] | ((unsigned)e[1] << 16); o.y = e[2] | ((unsigned)e[3] << 16); o.z = e[4] | ((unsigned)e[5] << 16); o.w = e[6] | ((unsigned)e[7] << 16);
                *(GAS v4u*)(dstT + ((size_t)(pt * 16 + kst) * 64 + h * 32 + r) * 8) = o; }
        }
        if (cb >= 16) {
            const int which = (cb - 16) >> 2, gg = ((cb - 16) >> 1) & 1, nh = (cb - 16) & 1;
            bf16* dstF = BC + (size_t)(((bc * 2 + gg) * 2 + which) * 64) * 512;
#pragma unroll 1
            for (int j = 0; j < 4; ++j) { const int it = tid + 512 * j, r = it & 31, h = (it >> 5) & 1, ksl = (it >> 6) & 3, tile = it >> 8;
                const v4u v = *(const LAS v4u*)(Vt + (32 * tile + r) * 72 + (2 * ksl + h) * 8);
                *(GAS v4u*)(dstF + ((size_t)(tile * 8 + 4 * nh + ksl) * 64 + h * 32 + r) * 8) = v; }
        }
        LDS_BAR();
    }
#undef P4_FETCH
}
__device__ __forceinline__ void p4_misc(Frame& F) {
    const int tid = F.tid; (void)tid;
    {   const int gw = F.vcu * NWAVES + F.wave, NGW = F.G * NWAVES;
        const float* dtr = (const float*)(F.ws + WS_DTRAW); float* dtH = (float*)(F.ws + WS_DTH); float* acsH = (float*)(F.ws + WS_ACSH);
        for (int it = gw; it < 128 * 16; it += NGW) {
            const int bc = it >> 4, hh = it & 15, b = bc >> 4, c = bc & 15;
            const float A = -__expf(inp(10)[hh]), bias = inp(9)[hh];
            f32x4 d, a; float run = 0.f;
            float xr_[4];
#pragma unroll
            for (int i = 0; i < 4; ++i) xr_[i] = ((const GAS float*)dtr)[(size_t)(bc * 256 + 4 * F.lane + i) * 16 + hh];
#pragma unroll
            for (int i = 0; i < 4; ++i) { const float x = xr_[i] + bias; const float sp = x > 20.f ? x : log1pf(__expf(x)); d[i] = sp; run += sp * A; a[i] = run; }
            float inc = run;
#pragma unroll
            for (int o = 1; o < 64; o <<= 1) { const float v = __shfl_up(inc, o); if (F.lane >= o) inc += v; }
            const float excl = inc - run;
#pragma unroll
            for (int i = 0; i < 4; ++i) a[i] += excl;
            const size_t off = (size_t)(b * 16 + hh) * SEQ + c * 256 + 4 * F.lane;
            *(GAS f32x4*)(dtH + off) = d; *(GAS f32x4*)(acsH + off) = a;
        }
#if MK_FP8
        ffn_weights8(F, inp(16), inp(17), inp(18), inp(15), gw, NGW, (LAS float*)(F.lds + RING_OFF + F.wave * 16384));
#else
        ffn_weights(F, inp(16), inp(17), inp(18), inp(15), gw, NGW, (LAS float*)(F.lds + RING_OFF + F.wave * 16384));
#endif
    }
}

__device__ __forceinline__ void ssd_states(Frame& F) {
    const bf16* XT = (const bf16*)(F.ws + WS_XT); const bf16* BT = (const bf16*)(F.ws + WS_BT); const float* dtH = (const float*)(F.ws + WS_DTH); const float* acsH = (const float*)(F.ws + WS_ACSH);
    float* ST = (float*)(F.ws + WS_ST);
    LAS unsigned char* L = F.lds + RING_OFF;
    const int lane = F.lane, w = F.wave, r32 = lane & 31, hi = lane >> 5;
    const unsigned o_f = (unsigned)lane * 16u;
    LAS float* dec = (LAS float*)(L + 65536 + w * 2048);
    for (int u = F.vcu; u < 256; u += F.G) {
        const int bc = u >> 1, g = u & 1, b = bc >> 4, c = bc & 15, hh = g * 8 + w;
        {   int ln0 = lane; asm volatile("" : "+v"(ln0));
            const bf16* BTu = BT + (size_t)((bc * 2 + g) * 4) * 16 * 512;
#pragma unroll
            for (int i = 0; i < 8; ++i) { const int f = w * 8 + i; glds16(BTu + (size_t)f * 512 + ln0 * 8, L + f * 1024); }
            const size_t o = (size_t)(b * 16 + hh) * SEQ + c * 256 + 4 * ln0;
            const f32x4 a4 = *(const GAS f32x4*)(acsH + o), d4 = *(const GAS f32x4*)(dtH + o);
            *(LAS f32x4*)(dec + 4 * ln0) = a4; *(LAS f32x4*)(dec + 256 + 4 * ln0) = d4;
            VM_WAIT(); LDS_WAIT(); __syncthreads(); }
        const float alast = dec[255];
        const bf16* xt = XT + (size_t)((bc * 16 + hh) * 2) * 16 * 512;
        f32x16 acc[2][4];
#pragma unroll
        for (int i = 0; i < 2; ++i)
#pragma unroll
            for (int j = 0; j < 4; ++j) acc[i][j] = f32x16{};
#pragma unroll 1
        for (int half = 0; half < 2; ++half) {
            bf16x8 xv[8][2];
#pragma unroll
            for (int k = 0; k < 8; ++k)
#pragma unroll
                for (int pt = 0; pt < 2; ++pt) xv[k][pt] = ldu<bf16x8>(xt + (size_t)(pt * 16 + 8 * half + k) * 512, o_f);
#pragma unroll
            for (int k = 0; k < 8; ++k) {
                const int ks = 8 * half + k;
                const f32x4 a0 = *(const LAS f32x4*)(dec + 16 * ks + 4 * hi), a1 = *(const LAS f32x4*)(dec + 16 * ks + 8 + 4 * hi);
                const f32x4 d0 = *(const LAS f32x4*)(dec + 256 + 16 * ks + 4 * hi), d1 = *(const LAS f32x4*)(dec + 256 + 16 * ks + 8 + 4 * hi);
                float wv[8];
#pragma unroll
                for (int j = 0; j < 4; ++j) { wv[j] = __expf(alast - a0[j]) * d0[j]; wv[4 + j] = __expf(alast - a1[j]) * d1[j]; }
                bf16x8 af[2];
#pragma unroll
                for (int pt = 0; pt < 2; ++pt) { const bf16x8 x = xv[k][pt];
                    v4u o; o.x = pkbf(bf2f(x[0]) * wv[0], bf2f(x[1]) * wv[1]); o.y = pkbf(bf2f(x[2]) * wv[2], bf2f(x[3]) * wv[3]); o.z = pkbf(bf2f(x[4]) * wv[4], bf2f(x[5]) * wv[5]); o.w = pkbf(bf2f(x[6]) * wv[6], bf2f(x[7]) * wv[7]);
                    af[pt] = __builtin_bit_cast(bf16x8, o); }
#pragma unroll
                for (int nt = 0; nt < 4; ++nt) { const bf16x8 bv = *(const LAS bf16x8*)(L + (nt * 16 + ks) * 1024 + lane * 16);
#pragma unroll
                    for (int pt = 0; pt < 2; ++pt) acc[pt][nt] = __builtin_amdgcn_mfma_f32_32x32x16_bf16(af[pt], bv, acc[pt][nt], 0, 0, 0); }
            }
        }
        GAS unsigned short* st = (GAS unsigned short*)ST + (size_t)(bc * 16 + hh) * 8192;
#pragma unroll
        for (int pt = 0; pt < 2; ++pt)
#pragma unroll
            for (int nt = 0; nt < 4; ++nt)
#pragma unroll
                for (int r = 0; r < 16; ++r) st[(32 * pt + crow(r, hi)) * 128 + 32 * nt + r32] = (unsigned short)(pkbf(acc[pt][nt][r], 0.f) & 0xffffu);
        __syncthreads();
    }
}

__device__ __forceinline__ void ssd_scan(Frame& F) {
    const float* ST = (const float*)(F.ws + WS_ST); bf16* SP = (bf16*)(F.ws + WS_SP); const float* acsH = (const float*)(F.ws + WS_ACSH);
    for (int gid = F.vcu * NWAVES * 64 + F.tid; gid < BATCH * 16 * 64 * 16; gid += F.G * NWAVES * 64) {
        const int n8 = gid & 15, p = (gid >> 4) & 63, hh = (gid >> 10) & 15, b = gid >> 14;
        float s[8];
#pragma unroll
        for (int j = 0; j < 8; ++j) s[j] = 0.f;
        const float* ap = acsH + (size_t)(b * 16 + hh) * SEQ + 255;
#pragma unroll 4
        for (int c = 0; c < NCHUNK; ++c) {
            const size_t off = (size_t)((b * 16 + c) * 16 + hh) * 8192 + p * 128 + n8 * 8;
            v4u o; o.x = pkbf(s[0], s[1]); o.y = pkbf(s[2], s[3]); o.z = pkbf(s[4], s[5]); o.w = pkbf(s[6], s[7]);
            *(GAS v4u*)(SP + ((size_t)(((b * 16 + c) * 16 + hh) * 2 + (p >> 5)) * 8 + (n8 >> 1)) * 512 + ((n8 & 1) * 32 + (p & 31)) * 8) = o;
            const float dec = __expf(ap[c * 256]);
            const v4u xs = *(const GAS v4u*)((const GAS unsigned short*)ST + off);
#pragma unroll
            for (int j = 0; j < 4; ++j) { s[2 * j] = dec * s[2 * j] + __uint_as_float(xs[j] << 16); s[2 * j + 1] = dec * s[2 * j + 1] + __uint_as_float(xs[j] & 0xffff0000u); }
        }
    }
}

__device__ __forceinline__ float reduce16x32(const float (&v)[16], int r32) {
    float a[8], b[4], c2[2];
    const bool b4 = r32 & 16, b3 = r32 & 8, b2 = r32 & 4, b1 = r32 & 2;
#pragma unroll
    for (int k = 0; k < 8; ++k) { const float keep = b4 ? v[8 + k] : v[k], send = b4 ? v[k] : v[8 + k]; a[k] = keep + shx(send, 16); }
#pragma unroll
    for (int k = 0; k < 4; ++k) { const float keep = b3 ? a[4 + k] : a[k], send = b3 ? a[k] : a[4 + k]; b[k] = keep + shx(send, 8); }
#pragma unroll
    for (int k = 0; k < 2; ++k) { const float keep = b2 ? b[2 + k] : b[k], send = b2 ? b[k] : b[2 + k]; c2[k] = keep + shx(send, 4); }
    const float keep = b1 ? c2[1] : c2[0], send = b1 ? c2[0] : c2[1];
    float d = keep + shx(send, 2);
    d += shx(d, 1);
    return d;
}
__device__ __forceinline__ float ssd_tile_out(const f32x16 (&y)[2], const u32x2v (&zq)[2][4], bf16* Ot, int r32_, int hi_) {
    int r32 = r32_, hi = hi_; asm volatile("" : "+v"(r32), "+v"(hi));
    const unsigned oo = (unsigned)(r32 * 1536 + 4 * hi) * 2u;
    float ssq = 0.f;
#pragma unroll
    for (int pt = 0; pt < 2; ++pt)
#pragma unroll
        for (int q = 0; q < 4; ++q) { const int p0 = 32 * pt + 8 * q;
            const u32x2v zz = zq[pt][q];
            const float v0 = y[pt][4 * q] * pg8::silu_f(__uint_as_float(zz.x << 16)), v1 = y[pt][4 * q + 1] * pg8::silu_f(__uint_as_float(zz.x & 0xffff0000u));
            const float v2 = y[pt][4 * q + 2] * pg8::silu_f(__uint_as_float(zz.y << 16)), v3 = y[pt][4 * q + 3] * pg8::silu_f(__uint_as_float(zz.y & 0xffff0000u));
            ssq += (v0 * v0 + v1 * v1) + (v2 * v2 + v3 * v3);
            u32x2v o; o.x = pkbf(v0, v1); o.y = pkbf(v2, v3);
            *(GAS u32x2v*)((GAS char*)(Ot + p0) + oo) = o; }
    return ssq;
}
#ifdef MK_STAMP
#define P7_STAMP(k) do { if (blockIdx.x == 0 && threadIdx.x == 0) __hip_atomic_store((unsigned long long*)(F.ws + 9 * MiB + 512 * 1024) + 32 + (k), rt(), __ATOMIC_RELAXED, __HIP_MEMORY_SCOPE_AGENT); } while (0)
#else
#define P7_STAMP(k) do {} while (0)
#endif
__device__ __forceinline__ void ssd_out(Frame& F, float* ssg) {
    const bf16* XT = (const bf16*)(F.ws + WS_XT); const bf16* BC = (const bf16*)((const unsigned char*)F.out + DO_BC); const bf16* SP = (const bf16*)(F.ws + WS_SP);
    const bf16* Z = (const bf16*)(F.ws + WS_Z); bf16* OY = (bf16*)((unsigned char*)F.out + DO_OY);
    const float* dtH = (const float*)(F.ws + WS_DTH); const float* acsH = (const float*)(F.ws + WS_ACSH);
    LAS unsigned char* L = F.lds + RING_OFF;
    const int lane = F.lane, w = F.wave, r32 = lane & 31, hi = lane >> 5;
    const unsigned o_f = (unsigned)lane * 16u, o_a = (unsigned)(4 * hi) * 4u, o_l = (unsigned)r32 * 4u;
    const int ltA = w, ltB = 7 - w;
    for (int u = F.vcu; u < 256; u += F.G) {
        const int bc = u >> 1, g = u & 1, b = bc >> 4, c = bc & 15, t0 = bc * 256;
        const bf16* BCu = BC + (size_t)(((bc * 2 + g) * 2) * 64) * 512;
        {
            int ln0 = lane; asm volatile("" : "+v"(ln0));
#pragma unroll
            for (int i = 0; i < 16; ++i) { const int f = w * 16 + i; glds16(BCu + (size_t)f * 512 + ln0 * 8, L + f * 1024); }
            P7_STAMP(0); VM_WAIT(); __syncthreads(); P7_STAMP(1); }
        unsigned cbp[9][8];
#pragma unroll
        for (int t = 0; t < 9; ++t) {
            const int lt = t <= w ? ltA : ltB, st = t <= w ? t : t - w - 1;
            f32x16 cb = f32x16{};
#pragma unroll
            for (int ks = 0; ks < 8; ++ks) { const bf16x8 bv = *(const LAS bf16x8*)(L + (st * 8 + ks) * 1024 + lane * 16), cv = *(const LAS bf16x8*)(L + 65536 + (lt * 8 + ks) * 1024 + lane * 16);
                cb = __builtin_amdgcn_mfma_f32_32x32x16_bf16(bv, cv, cb, 0, 0, 0); }
#pragma unroll
            for (int k = 0; k < 8; ++k) cbp[t][k] = pkbf(cb[2 * k], cb[2 * k + 1]);
        }
        P7_STAMP(2);
        __syncthreads();
        P7_STAMP(3);
        const bf16* xtg = XT + (size_t)((bc * 16 + 8 * g) * 2) * 16 * 512;
#define XT_ISSUE(it, slotp) do { int ln_ = lane; asm volatile("" : "+v"(ln_)); _Pragma("unroll") for (int i_ = 0; i_ < 8; ++i_) { const int f_ = w * 8 + i_, hl_ = (f_ < 32 ? 0 : 4) + (it); \
            glds16(xtg + ((size_t)hl_ * 32 + (f_ & 31)) * 512 + ln_ * 8, (slotp) + f_ * 1024); } } while (0)
        float ssA = 0.f, ssB = 0.f;
        LAS float* DEC = (LAS float*)(F.lds + TAB_OFF);
#pragma unroll 1
        for (int it = 0; it < 4; ++it) {
            if (it > 0) __syncthreads();
            XT_ISSUE(it, L);
            {   const int ps = F.tid >> 8, ix = F.tid & 255; const size_t o = (size_t)(b * 16 + 8 * g + 4 * ps + it) * SEQ + c * 256 + ix;
                DEC[ps * 512 + ix] = acsH[o]; DEC[ps * 512 + 256 + ix] = dtH[o]; }
            if (it == 0) P7_STAMP(4);
            VM_WAIT(); LDS_WAIT(); __syncthreads();
            if (it == 0) P7_STAMP(5);
            int dl_ = 4 * hi - r32; asm volatile("" : "+v"(dl_));
#pragma unroll
            for (int pass = 0; pass < 2; ++pass) {
                int wl = w; asm volatile("" : "+s"(wl));
                const int lt = pass ? 7 - wl : wl, hh = 8 * g + 4 * pass + it;
                const LAS unsigned char* slot = L + pass * 32768;
                const LAS float* ap = DEC + pass * 512; const LAS float* dp = ap + 256;
                const float Dh = inp(11)[hh];
                const bf16* sp = SP + (size_t)((bc * 16 + hh) * 2) * 8 * 512;
                f32x16 y[2];
                u32x2v zq[2][4];
                {   const bf16* Zt = Z + (size_t)(t0 + 32 * lt) * 1024 + hh * 64; const unsigned oz = (unsigned)(r32 * 1024 + 4 * hi) * 2u;
#pragma unroll
                    for (int pt = 0; pt < 2; ++pt)
#pragma unroll
                        for (int q = 0; q < 4; ++q) zq[pt][q] = ldu<u32x2v>(Zt + 32 * pt + 8 * q, oz); }
                {
                    bf16x8 sv[2][8];
#pragma unroll
                    for (int pt = 0; pt < 2; ++pt)
#pragma unroll
                        for (int k = 0; k < 8; ++k) sv[pt][k] = ldu<bf16x8>(sp + (size_t)(pt * 8 + k) * 512, o_f);
#pragma unroll
                    for (int pt = 0; pt < 2; ++pt) {
                        f32x16 a = f32x16{};
#pragma unroll
                        for (int k = 0; k < 8; ++k) { const bf16x8 ca = *(const LAS bf16x8*)(L + 65536 + (lt * 8 + k) * 1024 + lane * 16); a = __builtin_amdgcn_mfma_f32_32x32x16_bf16(sv[pt][k], ca, a, 0, 0, 0); }
                        y[pt] = a;
                    }
                    asm volatile("" ::: "memory");
                }
                const float al = ap[32 * lt + r32];
                { const float ea = __expf(al); y[0] = y[0] * ea; y[1] = y[1] * ea; }
#pragma unroll
                for (int t = 0; t < 9; ++t) {
                    const bool mine = pass ? (t > wl) : (t <= wl);
                    if (mine) {
                        const int st = pass ? t - wl - 1 : t;
                        const bool diag = (st == lt);
#pragma unroll
                        for (int s2 = 0; s2 < 2; ++s2) {
                            float mv[8];
#pragma unroll
                            for (int q2 = 0; q2 < 2; ++q2) { const int q = 2 * s2 + q2;
                                const f32x4 as = *(const LAS f32x4*)(ap + 32 * st + 8 * q + 4 * hi), ds = *(const LAS f32x4*)(dp + 32 * st + 8 * q + 4 * hi);
                                float cbv[4];
#pragma unroll
                                for (int j = 0; j < 2; ++j) { unsigned pw = cbp[t][2 * q + j]; asm volatile("" : "+v"(pw));
                                    cbv[2 * j] = __uint_as_float(pw << 16); cbv[2 * j + 1] = __uint_as_float(pw & 0xffff0000u); }
#pragma unroll
                                for (int i = 0; i < 4; ++i) {
                                    float m = cbv[i] * __expf(al - as[i]) * ds[i];
                                    if (diag) { m = (dl_ > -(8 * q + i)) ? 0.f : m; m = (dl_ == -(8 * q + i)) ? m + Dh : m; }
                                    mv[4 * q2 + i] = m; } }
                            v4u o; o.x = pkbf(mv[0], mv[1]); o.y = pkbf(mv[2], mv[3]); o.z = pkbf(mv[4], mv[5]); o.w = pkbf(mv[6], mv[7]);
                            const bf16x8 mf = __builtin_bit_cast(bf16x8, o);
#pragma unroll
                            for (int pt = 0; pt < 2; ++pt) { const bf16x8 xv = *(const LAS bf16x8*)(slot + (pt * 16 + 2 * st + s2) * 1024 + lane * 16);
                                y[pt] = __builtin_amdgcn_mfma_f32_32x32x16_bf16(xv, mf, y[pt], 0, 0, 0); }
                        }
                        asm volatile("" ::: "memory");
                    }
                }
                const float s_ = ssd_tile_out(y, zq, OY + (size_t)(t0 + 32 * lt) * 1536 + 512 + hh * 64, r32, hi);
                if (pass) ssB += s_; else ssA += s_;
                if (it == 0) P7_STAMP(6 + pass);
                asm volatile("" ::: "memory");
            }
        }
#undef XT_ISSUE
        P7_STAMP(8);
        ssA = sum32(ssA); ssB = sum32(ssB);
        if (hi == 0) { atomicAdd(ssg + (size_t)(t0 + 32 * ltA + r32) * 2 + g, ssA); atomicAdd(ssg + (size_t)(t0 + 32 * ltB + r32) * 2 + g, ssB); }
        __syncthreads();
    }
}

__device__ __forceinline__ void final_norm(Frame& F) {
    const int gw = F.vcu * NWAVES + F.wave, NGW = F.G * NWAVES;
    const float* ss3 = (const float*)(F.ws + ACC_SSX3); const float* gn = inp(19); const bf16* XB = (const bf16*)(F.ws + WS_XB);
    f32x4 gv[4];
#pragma unroll
    for (int j = 0; j < 4; ++j) gv[j] = *(const GAS f32x4*)(gn + 4 * F.lane + 256 * j);
    u32x2v w[4][4], nw[4][4]; float rs[4], nrs[4];
#define P11_LOAD(dw, drs, mm0) do { _Pragma("unroll") for (int r_ = 0; r_ < 4; ++r_) { const int m_ = (mm0) + r_ * NGW, mc_ = m_ < T ? m_ : 0; const GAS u32x2v* xb_ = (const GAS u32x2v*)(XB + (size_t)mc_ * DMODEL) + F.lane; \
        _Pragma("unroll") for (int j_ = 0; j_ < 4; ++j_) dw[r_][j_] = xb_[64 * j_]; drs[r_] = ss3[mc_]; } } while (0)
    if (gw < T) P11_LOAD(w, rs, gw);
    for (int m0 = gw; m0 < T; m0 += 4 * NGW) {
        const bool more = (m0 + 4 * NGW) < T;
        if (more) P11_LOAD(nw, nrs, m0 + 4 * NGW);
#pragma unroll
        for (int r = 0; r < 4; ++r) { const int m = m0 + r * NGW; if (m < T) { GAS f32x4* xr = (GAS f32x4*)(F.out + (size_t)m * DMODEL) + F.lane;
            const float rr = rsqrtf(rs[r] * (1.0f / 1024.0f) + pg8::RMS_EPS);
#pragma unroll
            for (int j = 0; j < 4; ++j) { const f32x4 v = {__uint_as_float(w[r][j].x << 16), __uint_as_float(w[r][j].x & 0xffff0000u), __uint_as_float(w[r][j].y << 16), __uint_as_float(w[r][j].y & 0xffff0000u)}; xr[64 * j] = v * gv[j] * rr; } } }
        if (more) {
#pragma unroll
            for (int r = 0; r < 4; ++r) { rs[r] = nrs[r];
#pragma unroll
                for (int j = 0; j < 4; ++j) w[r][j] = nw[r][j]; } }
    }
#undef P11_LOAD
}

__device__ __forceinline__ void final_norm_panel(Frame& F, int pm) {
    const float* ss3 = (const float*)(F.ws + ACC_SSX3); const float* gn = inp(19); const bf16* XB = (const bf16*)(F.ws + WS_XB);
    f32x4 gv[4];
#pragma unroll
    for (int j = 0; j < 4; ++j) gv[j] = *(const GAS f32x4*)(gn + 4 * F.lane + 256 * j);
#pragma unroll 1
    for (int t = 0; t < 8; ++t) {
        u32x2v w[4][4]; float rs[4];
#pragma unroll
        for (int r = 0; r < 4; ++r) { const int m = pm * 256 + F.wave + 8 * (4 * t + r); const GAS u32x2v* xb = (const GAS u32x2v*)(XB + (size_t)m * DMODEL) + F.lane;
#pragma unroll
            for (int j = 0; j < 4; ++j) w[r][j] = xb[64 * j];
            rs[r] = ((const GAS float*)ss3)[m]; }
#pragma unroll
        for (int r = 0; r < 4; ++r) { const int m = pm * 256 + F.wave + 8 * (4 * t + r); GAS f32x4* xr = (GAS f32x4*)(F.out + (size_t)m * DMODEL) + F.lane;
            const float rr = rsqrtf(rs[r] * (1.0f / 1024.0f) + pg8::RMS_EPS);
#pragma unroll
            for (int j = 0; j < 4; ++j) { const f32x4 v = {__uint_as_float(w[r][j].x << 16), __uint_as_float(w[r][j].x & 0xffff0000u), __uint_as_float(w[r][j].y << 16), __uint_as_float(w[r][j].y & 0xffff0000u)}; xr[64 * j] = v * gv[j] * rr; } }
    }
}
#ifndef MK_DUP
#define MK_DUP 0
#endif
constexpr size_t WS_DUMMY = 9 * MiB;
#define DUPN(k) (((MK_DUP >> (k)) & 1) ? 2 : 1)
__global__ void __launch_bounds__(NWAVES * 64, 2) mk_fwd(Args args) {
    extern __shared__ __attribute__((aligned(16))) unsigned char lds[];
    Frame F;
    F.lds = (LAS unsigned char*)lds;
    F.MISC = (volatile LAS unsigned*)(F.lds + MISC_OFF);
    F.tid = threadIdx.x; F.lane = F.tid & 63; F.wave = __builtin_amdgcn_readfirstlane(F.tid >> 6);
    F.G = gridDim.x; { const int bx = blockIdx.x; F.vcu = (F.G % 8 == 0) ? (bx % 8) * (F.G / 8) + bx / 8 : bx; }
    F.ws = args.ws; F.out = args.out; F.ctl = (gu32*)(args.ws + WS_CTL);
    for (int u = F.tid; u < (LDS_BYTES - LDSCTL_OFF) / 4; u += NWAVES * 64) ((LAS unsigned*)(F.lds + LDSCTL_OFF))[u] = 0u;
    __syncthreads();
#ifdef MK_STAMP
    const unsigned long long t_start_ = rt();
#endif
    XcdBarrier bar = xcd_barrier_post((unsigned*)(F.ctl + CW_BAR), F.MISC + 8);
#ifdef MK_STAMP
    int n_stamp_ = 0;
#define GRID_BAR() do { xcd_barrier(bar); if (blockIdx.x == 0 && threadIdx.x == 0) __hip_atomic_store((unsigned long long*)(args.ws + WS_DUMMY + 512 * 1024) + n_stamp_, rt(), __ATOMIC_RELAXED, __HIP_MEMORY_SCOPE_AGENT); ++n_stamp_; } while (0)
#else
#define GRID_BAR() xcd_barrier(bar)
#endif
#define PH_BEGIN() \
    { int t_ = threadIdx.x; asm volatile("" : "+v"(t_)); F.tid = t_; F.lane = t_ & 63; F.wave = __builtin_amdgcn_readfirstlane(t_ >> 6); } \
    int z_ = 0; asm volatile("" : "+s"(z_)); unsigned char* ws = args.ws + z_; F.ws = ws; F.out = args.out + z_; \
    bf16* XB = (bf16*)(ws + WS_XB); bf16* W13 = (bf16*)(ws + WS_W13); bf16* W2 = (bf16*)(ws + WS_W2); bf16* HB = (bf16*)(ws + WS_R); \
    float* ss0 = (float*)(ws + WS_SSX0); float* ss1 = (float*)(ws + ACC_SSX1); float* ss2 = (float*)(ws + ACC_SSX2); float* ss3 = (float*)(ws + ACC_SSX3); \
    float* ssa = (float*)(ws + ACC_SSA); float* ssg = (float*)(ws + ACC_SSG); float* km = (float*)(ws + ACC_KM); bf16* OY = (bf16*)((unsigned char*)F.out + DO_OY); \
    (void)XB; (void)W13; (void)W2; (void)HB; (void)ss0; (void)ss1; (void)ss2; (void)ss3; (void)ssa; (void)ssg; (void)km; (void)OY;
    const int bx = (int)blockIdx.x;

    for (int rep = 0; rep < DUPN(0); ++rep) { PH_BEGIN(); p0_prologue(F); GRID_BAR(); }
#if MK_FP8_FFN1
    {   PH_BEGIN();
#if MK_FP8_FFN1 == 3
        pg8::Gemm g{XB, W13, T, 2 * DFF, DMODEL}; pg8::StaticOrder S; S.init(T, 2 * DFF, F.G, bx);
        pg8::EpiSwigluT<true, 0> E{HB, ss0, DFF};
        pg8::gemm_phase<pg8::EpiSwigluT<true, 0>, pg8::StaticOrder, true, true, false>(F.lds + RING_OFF, g, S, E);
#elif MK_FP8_FFN1 == 2
        pg8::Gemm g{(bf16*)(ws + WS_XA8), W13, T, 2 * DFF, DMODEL / 2}; pg8::StaticOrder S; S.init(T, 2 * DFF, F.G, bx);
        pg8::EpiSwigluT<false, FP8_SB13> E{HB, ss0, DFF};
        pg8::gemm_phase<pg8::EpiSwigluT<false, FP8_SB13>, pg8::StaticOrder, true, true, true>(F.lds + RING_OFF, g, S, E);
#else
        pg8::Gemm g{(bf16*)(ws + WS_XA8), W13, T, 2 * DFF, DMODEL / 2}; pg8::StaticOrder S; S.init(T, 2 * DFF, F.G, bx);
        pg8::EpiSwigluT<true, FP8_SB13> E{HB, ss0, DFF};
        pg8::gemm_phase<pg8::EpiSwigluT<true, FP8_SB13>, pg8::StaticOrder, true, true, true>(F.lds + RING_OFF, g, S, E);
#endif
    }
    GRID_BAR();
    {   PH_BEGIN();
#if MK_FP8_FFN1 == 2
        pg8::Gemm g{HB, W2, T, DMODEL, DFF}; pg8::StaticOrder S; S.init(T, DMODEL, F.G, bx);
        pg8::EpiResid<false> E{XB, ss1, 0.5f, nullptr, nullptr, nullptr, nullptr};
        pg8::gemm_phase<pg8::EpiResid<false>, pg8::StaticOrder, true, true>(F.lds + RING_OFF, g, S, E);
#else
        pg8::Gemm g{HB, W2, T, DMODEL, DFF / 2}; pg8::StaticOrder S; S.init(T, DMODEL, F.G, bx);
        pg8::EpiResid<false, FP8_SB2> E{XB, ss1, 0.5f, nullptr, nullptr, nullptr, nullptr};
        pg8::gemm_phase<pg8::EpiResid<false, FP8_SB2>, pg8::StaticOrder, true, true, true>(F.lds + RING_OFF, g, S, E);
#endif
    }
    GRID_BAR();
#else
    {   PH_BEGIN(); pg8::Gemm g{XB, W13, T, 2 * DFF, DMODEL}; pg8::StaticOrder S; S.init(T, 2 * DFF, F.G, bx);
        pg8::EpiSwiglu E{HB, ss0, DFF};
        if ((MK_DUP >> 18) & 1) { pg8::EpiNull E0{(float*)(ws + WS_DUMMY)}; pg8::gemm_phase<pg8::EpiNull, pg8::StaticOrder, true, true>(F.lds + RING_OFF, g, S, E0); GRID_BAR(); }
        if ((MK_DUP >> 23) & 1) { pg8::EpiNull E0{(float*)(ws + WS_DUMMY)}; pg8::gemm_phase<pg8::EpiNull, pg8::StaticOrder, true, true, false, true>(F.lds + RING_OFF, g, S, E0); GRID_BAR(); }
        if ((MK_DUP >> 22) & 1) { pg8::EpiSwiglu E0{HB, ss0, DFF}; pg8::gemm_phase<pg8::EpiSwiglu, pg8::StaticOrder, true, true>(F.lds + RING_OFF, g, S, E0); GRID_BAR(); }
        for (int rep = 0; rep < DUPN(1); ++rep) { pg8::gemm_phase<pg8::EpiSwiglu, pg8::StaticOrder, true, true>(F.lds + RING_OFF, g, S, E); GRID_BAR(); } }
    {   PH_BEGIN(); pg8::Gemm g{HB, W2, T, DMODEL, DFF}; pg8::StaticOrder S; S.init(T, DMODEL, F.G, bx);
        for (int rep = 0; rep < DUPN(2); ++rep) { pg8::EpiResid<false> E{rep ? (bf16*)(ws + WS_S) : XB, rep ? (float*)(ws + WS_DUMMY) : ss1, 0.5f, nullptr, nullptr, nullptr, nullptr};
        pg8::gemm_phase<pg8::EpiResid<false>, pg8::StaticOrder, true, true>(F.lds + RING_OFF, g, S, E); GRID_BAR(); }
        if ((MK_DUP >> 14) & 1) { pg8::EpiSwiglu E2{(bf16*)(ws + WS_S), ss0, 512}; pg8::gemm_phase<pg8::EpiSwiglu, pg8::StaticOrder, true, true>(F.lds + RING_OFF, g, S, E2); GRID_BAR(); } }
#endif
    {   PH_BEGIN(); pg8::Gemm g{XB, (bf16*)(ws + WS_WIN), T, 4096, DMODEL}; pg8::StaticOrder S; S.init(T, 4096, F.G, bx);
        if ((MK_DUP >> 16) & 1) { pg8::EpiSwiglu E2{HB, ss0, DFF}; pg8::gemm_phase<pg8::EpiSwiglu, pg8::StaticOrder, true, true>(F.lds + RING_OFF, g, S, E2); GRID_BAR(); }
        if ((MK_DUP >> 20) & 1) { pg8::EpiProjT<MK_LITE> E2{(bf16*)(ws + WS_Q), (bf16*)(ws + WS_K), (bf16*)(ws + WS_V), (bf16*)(ws + WS_Z), (bf16*)(ws + WS_S), ss1, (const float*)(ws + WS_CS), (float*)(ws + WS_DUMMY), attn_body::C2}; pg8::gemm_phase<pg8::EpiProjT<MK_LITE>, pg8::StaticOrder, true, true>(F.lds + RING_OFF, g, S, E2); GRID_BAR(); }
        if ((MK_DUP >> 17) & 1) { pg8::EpiProjT<1> E2{(bf16*)(ws + WS_Q), (bf16*)(ws + WS_K), (bf16*)(ws + WS_V), (bf16*)(ws + WS_Z), (bf16*)(ws + WS_S), ss1, (const float*)(ws + WS_CS), (float*)(ws + WS_DUMMY), attn_body::C2}; pg8::gemm_phase<pg8::EpiProjT<1>, pg8::StaticOrder, true, true>(F.lds + RING_OFF, g, S, E2); GRID_BAR(); }
        for (int rep = 0; rep < DUPN(3); ++rep) { pg8::EpiProj E{(bf16*)(ws + WS_Q), (bf16*)(ws + WS_K), (bf16*)(ws + WS_V), (bf16*)(ws + WS_Z), (bf16*)(ws + WS_S), ss1, (const float*)(ws + WS_CS), rep ? (float*)(ws + WS_DUMMY) : km, attn_body::C2};
        pg8::gemm_phase<pg8::EpiProj, pg8::StaticOrder, true, true>(F.lds + RING_OFF, g, S, E);
        dt_proj(F); if ((MK_DUP >> 19) & 1) { dt_proj(F); dt_proj(F); dt_proj(F); dt_proj(F); } GRID_BAR(); } }
#if MK_MERGE45
#pragma unroll 1
    for (int seg = 0; seg < 4; ++seg) {   PH_BEGIN();
        const int pat = (F.vcu >> 5) & 1, ncu = (128 * 24 + (int)F.G - 1) / (int)F.G, nh = (ncu + 1) >> 1;
        if ((seg & 1) == pat) p4_conv(F, (seg >> 1) * nh, (seg >> 1) ? ncu : nh);
        else { const attn_body::AttnTensors AT{(const attn_body::bf16*)(ws + WS_Q), (const attn_body::bf16*)(ws + WS_K), (const attn_body::bf16*)(ws + WS_V), (attn_body::bf16*)OY, km, ssa};
            const attn_body::StaticOrder S((int)F.G, F.vcu);
            attn_body::attn_range<attn_body::StaticOrder>((char*)lds + RING_OFF, AT, S, (seg >> 1) * 2, (seg >> 1) * 2 + 2); }
        __syncthreads();
    }
    {   PH_BEGIN(); p4_misc(F); GRID_BAR(); }
    {   PH_BEGIN(); ssd_states(F); GRID_BAR(); }
#else
    for (int rep = 0; rep < DUPN(4); ++rep) { PH_BEGIN(); p4_conv(F);
#ifdef MK_SPLIT4
        GRID_BAR();
#endif
        p4_misc(F); GRID_BAR(); }
    for (int rep = 0; rep < DUPN(5); ++rep) {   PH_BEGIN();
        const bool last = (rep == DUPN(5) - 1);
        const attn_body::AttnTensors AT{(const attn_body::bf16*)(ws + WS_Q), (const attn_body::bf16*)(ws + WS_K), (const attn_body::bf16*)(ws + WS_V), (attn_body::bf16*)OY, km, last ? ssa : (float*)(ws + WS_DUMMY)};
        const attn_body::StaticOrder S((int)F.G, F.vcu);
        if (last) attn_body::attn_phase<attn_body::StaticOrder>((char*)lds + RING_OFF, AT, S);
        else if (!((MK_DUP >> 12) & 1)) { if ((MK_DUP >> 15) & 1) attn_body::attn_phase<attn_body::StaticOrder, false>((char*)lds + RING_OFF, AT, S); else attn_body::attn_phase<attn_body::StaticOrder>((char*)lds + RING_OFF, AT, S); }
#ifdef MK_SPLIT5
        GRID_BAR();
#endif
        if (!((MK_DUP >> 13) & 1) || last) ssd_states(F);
        GRID_BAR(); }
#endif
#ifdef MK_XBAR
    for (int xb_ = 0; xb_ < MK_XBAR; ++xb_) GRID_BAR();
#endif
    for (int rep = 0; rep < DUPN(6); ++rep) { PH_BEGIN(); ssd_scan(F); GRID_BAR(); }
    for (int rep = 0; rep < DUPN(7); ++rep) { PH_BEGIN(); ssd_out(F, rep ? (float*)(ws + WS_DUMMY) : ssg); GRID_BAR(); }
    {   PH_BEGIN(); pg8::Gemm g{OY, (bf16*)(ws + WS_WOUT), T, DMODEL, DMIX}; pg8::StaticOrder S; S.init(T, DMODEL, F.G, bx);
        if ((MK_DUP >> 21) & 1) { pg8::EpiSwiglu E2{HB, ss0, 512}; pg8::gemm_phase<pg8::EpiSwiglu, pg8::StaticOrder, true, true>(F.lds + RING_OFF, g, S, E2); GRID_BAR(); }
        if (DUPN(8) == 2) { pg8::EpiResid<true> E{HB, (float*)(ws + WS_DUMMY), 1.0f, ssa, ssg, (PG8_LAS float*)(F.lds + TAB_OFF), nullptr};
        pg8::gemm_phase<pg8::EpiResid<true>, pg8::StaticOrder, true, true>(F.lds + RING_OFF, g, S, E); GRID_BAR(); }
        pg8::EpiResid<true> E{XB, ss2, 1.0f, ssa, ssg, (PG8_LAS float*)(F.lds + TAB_OFF), MK_FP8 ? (unsigned char*)(ws + WS_XA8) : nullptr};
        pg8::gemm_phase<pg8::EpiResid<true>, pg8::StaticOrder, true, true>(F.lds + RING_OFF, g, S, E); }
    GRID_BAR();
#if MK_FP8
    {   PH_BEGIN(); pg8::Gemm g{(bf16*)(ws + WS_XA8), W13, T, 2 * DFF, DMODEL / 2}; pg8::StaticOrder S; S.init(T, 2 * DFF, F.G, bx);
        pg8::EpiSwigluT<true, FP8_SB13> E{HB, ss2, DFF};
        pg8::gemm_phase<pg8::EpiSwigluT<true, FP8_SB13>, pg8::StaticOrder, true, MK_SP2_FP8, true>(F.lds + RING_OFF, g, S, E); }
    GRID_BAR();
    {   PH_BEGIN(); pg8::Gemm g{HB, W2, T, DMODEL, DFF / 2}; pg8::StaticOrder S; S.init(T, DMODEL, F.G, bx);
        pg8::EpiResid<false, FP8_SB2> E{XB, ss3, 0.5f, nullptr, nullptr, nullptr, nullptr};
        pg8::gemm_phase<pg8::EpiResid<false, FP8_SB2>, pg8::StaticOrder, true, MK_SP2_FP8, true>(F.lds + RING_OFF, g, S, E);
#if MK_FUSE_FINAL
        { int t_ = threadIdx.x; asm volatile("" : "+v"(t_)); F.tid = t_; F.lane = t_ & 63; F.wave = __builtin_amdgcn_readfirstlane(t_ >> 6); }
        __threadfence();
        __syncthreads();
        if (F.tid == 0) { unsigned m_ = 0u; pg8::Unit u_;
            for (int i = 0; i < 2; ++i) if (S.next(i, u_)) { const unsigned old_ = __hip_atomic_fetch_add((unsigned*)(F.ctl + CW_PANEL) + 64 * u_.pm, 1u, __ATOMIC_RELAXED, __HIP_MEMORY_SCOPE_AGENT); if (old_ == 3u) m_ |= 1u << i; }
            F.MISC[16] = m_; }
        __syncthreads();
        const unsigned mine_ = F.MISC[16];
        if (mine_) { __threadfence();
            pg8::Unit u_;
            for (int i = 0; i < 2; ++i) if (((mine_ >> i) & 1u) && S.next(i, u_)) final_norm_panel(F, u_.pm); }
#endif
    }
#if !MK_FUSE_FINAL
    GRID_BAR();
#endif
#else
    {   PH_BEGIN(); pg8::Gemm g{XB, W13, T, 2 * DFF, DMODEL}; pg8::StaticOrder S; S.init(T, 2 * DFF, F.G, bx);
        pg8::EpiSwiglu E{HB, ss2, DFF};
        pg8::gemm_phase<pg8::EpiSwiglu, pg8::StaticOrder, true, true>(F.lds + RING_OFF, g, S, E); }
    GRID_BAR();
    {   PH_BEGIN(); pg8::Gemm g{HB, W2, T, DMODEL, DFF}; pg8::StaticOrder S; S.init(T, DMODEL, F.G, bx);
        pg8::EpiResid<false> E{XB, ss3, 0.5f, nullptr, nullptr, nullptr, nullptr};
        pg8::gemm_phase<pg8::EpiResid<false>, pg8::StaticOrder, true, true>(F.lds + RING_OFF, g, S, E); }
    GRID_BAR();
#endif
#if !(MK_FP8 && MK_FUSE_FINAL)
    { PH_BEGIN(); final_norm(F); }
#endif
#ifdef MK_STAMP
    GRID_BAR();
    if (blockIdx.x == 0 && threadIdx.x == 0) { asm volatile("s_waitcnt vmcnt(0)" ::: "memory"); const unsigned long long* st_ = (const unsigned long long*)(args.ws + WS_DUMMY + 512 * 1024);
#ifdef MK_SA
        const unsigned long long t1_ = __hip_atomic_load(st_ + MK_SA, __ATOMIC_RELAXED, __HIP_MEMORY_SCOPE_AGENT), t0_ = __hip_atomic_load(st_ + MK_SB, __ATOMIC_RELAXED, __HIP_MEMORY_SCOPE_AGENT);
#else
        const unsigned long long t1_ = __hip_atomic_load(st_ + MK_STAMP, __ATOMIC_RELAXED, __HIP_MEMORY_SCOPE_AGENT), t0_ = MK_STAMP > 0 ? __hip_atomic_load(st_ + MK_STAMP - 1, __ATOMIC_RELAXED, __HIP_MEMORY_SCOPE_AGENT) : t_start_;
#endif
        args.out[0] = 8.0f + (float)(t1_ - t0_) * (0.01f / MK_STAMP_DIV); }
#endif
#undef GRID_BAR
}

extern "C" void kernel_launch(void* const* d_in, const int* in_sizes, int n_in, void* d_out, int out_size, void* d_ws, size_t ws_size, hipStream_t stream) {
    static int grid = 0;
    if (grid == 0) {
        if (n_in != 20 || in_sizes[0] != T * DMODEL || out_size != T * DMODEL || ws_size < WS_END) { fprintf(stderr, "kernel_launch: unexpected shapes (n_in %d, in0 %d, out %d, ws %zu)\n", n_in, n_in > 0 ? in_sizes[0] : -1, out_size, ws_size); grid = -1; return; }
        int dev = 0, cus = 0, per_cu = 0;
        if (hipGetDevice(&dev) != hipSuccess || hipDeviceGetAttribute(&cus, hipDeviceAttributeMultiprocessorCount, dev) != hipSuccess) { grid = -1; return; }
        if (hipFuncSetAttribute((const void*)mk_fwd, hipFuncAttributeMaxDynamicSharedMemorySize, LDS_BYTES) != hipSuccess) { fprintf(stderr, "kernel_launch: hipFuncSetAttribute failed\n"); grid = -1; return; }
        if (hipOccupancyMaxActiveBlocksPerMultiprocessor(&per_cu, (const void*)mk_fwd, NWAVES * 64, LDS_BYTES) != hipSuccess || per_cu < 1) { fprintf(stderr, "kernel_launch: occupancy query says %d blocks per CU\n", per_cu); per_cu = 1; }
        (void)hipGetLastError();
        grid = cus;
        fprintf(stderr, "kernel_launch: grid %d (occupancy query %d per CU), ws %zu\n", grid, per_cu, ws_size);
    }
    if (grid < 0) return;
    if (hipMemsetAsync((char*)d_ws + WS_CTL, 0, CTL_ZERO_BYTES, stream) != hipSuccess) { fprintf(stderr, "kernel_launch: memset failed\n"); return; }
    Args a{};
    for (int i = 0; i < 20; ++i) a.in[i] = (const float*)d_in[i];
    a.out = (float*)d_out; a.ws = (unsigned char*)d_ws;
    hipLaunchKernelGGL(mk_fwd, dim3(grid), dim3(NWAVES * 64), LDS_BYTES, stream, a);
    const hipError_t le = hipPeekAtLastError();
    if (le != hipSuccess) fprintf(stderr, "kernel_launch: launch failed: %s\n", hipGetErrorName(le));
}
```

```cpp
#define MK_FP8_FFN1 1
#include <hip/hip_runtime.h>
#include <hip/hip_bf16.h>
#include <cstdio>
#include <cstdint>
#include <cmath>
__device__ __forceinline__ float shx(float v, int k) { int lid; asm volatile("v_mbcnt_lo_u32_b32 %0, -1, 0\n\tv_mbcnt_hi_u32_b32 %0, -1, %0" : "=v"(lid)); return __int_as_float(__builtin_amdgcn_ds_bpermute((lid ^ k) << 2, __float_as_int(v))); }
__device__ __forceinline__ float partner16(float v, int fq) { auto r = __builtin_amdgcn_permlane16_swap(__float_as_uint(v), __float_as_uint(v), false, false); return __uint_as_float((fq & 1) ? r[0] : r[1]); }
__device__ __forceinline__ float sum16(float v) { auto r = __builtin_amdgcn_permlane16_swap(__float_as_uint(v), __float_as_uint(v), false, false); return __uint_as_float(r[0]) + __uint_as_float(r[1]); }
__device__ __forceinline__ float sum32(float v) { auto r = __builtin_amdgcn_permlane32_swap(__float_as_uint(v), __float_as_uint(v), false, false); return __uint_as_float(r[0]) + __uint_as_float(r[1]); }
#ifndef T_NOLDS
#define T_NOLDS 0
#endif
#ifndef MK_FP8
#define MK_FP8 1
#endif
#ifndef MK_STAMP_DIV
#define MK_STAMP_DIV 4.0f
#endif
#ifndef MK_FP8_FFN1
#define MK_FP8_FFN1 0
#endif
#ifndef MK_FUSE_FINAL
#define MK_FUSE_FINAL 0
#endif
#ifndef MK_LITE
#define MK_LITE 0
#endif
#ifndef MK_WGM
#define MK_WGM 8
#endif
#ifndef MK_SP2_FP8
#define MK_SP2_FP8 true
#endif
#ifndef MK_ALIGN3
#define MK_ALIGN3 true
#endif
#ifndef MK_MERGE45
#define MK_MERGE45 1
#endif
#ifndef MK_NT
#define MK_NT 0
#endif
namespace pg8 {
#define PG8_LAS __attribute__((address_space(3)))
typedef unsigned short bf16_t;
typedef short bf16x8 __attribute__((ext_vector_type(8)));
typedef float f32x4 __attribute__((ext_vector_type(4)));
typedef unsigned u32x4 __attribute__((ext_vector_type(4)));
constexpr int BM = 256, BK = 64, HALF = 128, HTB = HALF * BK * 2  , STAGE_BYTES = 8 * HTB, NXCD = 8, WGM = MK_WGM;

__host__ __device__ __forceinline__ int lds_byte(int r, int c) { const int st = (r >> 4) * 2 + (c >> 5), rr = r & 15, cc = c & 31, ob = rr * 64 + cc * 2; return st * 1024 + (ob ^ (((ob >> 9) & 1) << 5)); }
__host__ __device__ __forceinline__ void stage_rc(int b, int& R, int& C) { const int st = b / 1024, sb = b % 1024, swz = sb ^ (((sb >> 9) & 1) << 5); R = (st >> 1) * 16 + swz / 64; C = (st & 1) * 32 + (swz % 64) / 2; }
__host__ __device__ __forceinline__ int perm32(int rho) { const int n = rho >> 4, i = rho & 15; return 8 * (i >> 2) + 4 * n + (i & 3); }

struct Unit { int pm, pn; };
struct Gemm { const bf16_t* A; const bf16_t* Bt; int M, N, K; };

struct StaticOrder {
    int nM, nN, nwg, G, c;
    __host__ __device__ void init(int M, int N, int G_, int c_) { nM = M / BM; nN = N / BM; nwg = nM * nN; G = G_; c = c_; }
    __host__ __device__ __forceinline__ bool next(int i, Unit& u) const {
        const long L = (long)i * G + c; if (L >= nwg) return false;
        int wgid = (int)L; { const int q = nwg / NXCD, r = nwg % NXCD, xcd = wgid % NXCD, off = wgid / NXCD; wgid = (xcd < r ? xcd * (q + 1) : r * (q + 1) + (xcd - r) * q) + off; }
        const int nig = WGM * nN, gid = wgid / nig, fm = gid * WGM, gsz = (nM - fm) < WGM ? (nM - fm) : WGM;
        u.pm = fm + ((wgid % nig) % gsz); u.pn = (wgid % nig) / gsz; return true;
    }
    __device__ __forceinline__ void a_ready(const Unit&) const {}
    __device__ __forceinline__ void done(const Unit&) const {}
};
typedef float f32x2_t __attribute__((ext_vector_type(2))); typedef __bf16 bf16x2_t __attribute__((ext_vector_type(2)));
typedef unsigned u32x2 __attribute__((ext_vector_type(2)));
__device__ __forceinline__ unsigned cvt_pk_bf16(float lo, float hi) { f32x2_t v = {lo, hi}; bf16x2_t b = __builtin_convertvector(v, bf16x2_t); return __builtin_bit_cast(unsigned, b); }
constexpr float RMS_EPS = 1e-6f;
__device__ __forceinline__ float silu_f(float x) { return x * __builtin_amdgcn_rcpf(1.0f + __builtin_amdgcn_exp2f(-1.4426950408889634f * x)); }

__device__ __forceinline__ unsigned cvt4_fp8(float a, float b, float c, float d) { int w = __builtin_amdgcn_cvt_pk_fp8_f32(a, b, 0, false); w = __builtin_amdgcn_cvt_pk_fp8_f32(c, d, w, true); return (unsigned)w; }
template <bool OUT8, int SB> struct EpiSwigluT {
    static constexpr bool PERM = true, AFTER_DRAIN = false, KHOOK = false; static constexpr int SCALE_B = SB;
    bf16_t* H; const float* ss; int ldh;
    PG8_LAS float* rt = nullptr;
    mutable int lastpm = -1;
    __device__ __forceinline__ void operator()(const f32x4 (&acc)[2][2][4][2], const Unit& u, int wr, int wc, int fr, int fq) const {
        const int row0 = u.pm * BM + wr * 64 + fr, col0 = u.pn * HALF + wc * 32 + 8 * fq;
        float ssv[2][4];
        PG8_LAS float* t = rt + (wr * 4 + wc) * 128 + fr;
        if (rt == nullptr || u.pm != lastpm) {
#pragma unroll
            for (int ai = 0; ai < 2; ++ai)
#pragma unroll
                for (int m = 0; m < 4; ++m) ssv[ai][m] = ss[row0 + ai * HALF + m * 16];
#pragma unroll
            for (int ai = 0; ai < 2; ++ai)
#pragma unroll
                for (int m = 0; m < 4; ++m) { ssv[ai][m] = rsqrtf(ssv[ai][m] * (1.0f / 1024.0f) + RMS_EPS); if (rt != nullptr) t[(ai * 4 + m) * 16] = ssv[ai][m]; }
            lastpm = u.pm;
        } else {
#pragma unroll
            for (int ai = 0; ai < 2; ++ai)
#pragma unroll
                for (int m = 0; m < 4; ++m) ssv[ai][m] = t[(ai * 4 + m) * 16];
        }
#pragma unroll
        for (int ai = 0; ai < 2; ++ai)
#pragma unroll
            for (int m = 0; m < 4; ++m) asm volatile("" : "+v"(ssv[ai][m]));
#pragma unroll
        for (int ai = 0; ai < 2; ++ai)
#pragma unroll
            for (int m = 0; m < 4; ++m) {
                const int row = row0 + ai * HALF + m * 16;
                const float rs = ssv[ai][m];
                float h[8];
#pragma unroll
                for (int n = 0; n < 2; ++n)
#pragma unroll
                    for (int i = 0; i < 4; ++i) h[4 * n + i] = silu_f(acc[ai][0][m][n][i] * rs) * (acc[ai][1][m][n][i] * rs);
                if constexpr (OUT8) { u32x2 w; w.x = cvt4_fp8(h[0], h[1], h[2], h[3]); w.y = cvt4_fp8(h[4], h[5], h[6], h[7]);
#if MK_NT
                    __builtin_nontemporal_store(w, (u32x2*)((unsigned char*)H + (size_t)row * ldh + col0));
#else
                    *(u32x2*)((unsigned char*)H + (size_t)row * ldh + col0) = w;
#endif
                }
                else { u32x4 w; w.x = cvt_pk_bf16(h[0], h[1]); w.y = cvt_pk_bf16(h[2], h[3]); w.z = cvt_pk_bf16(h[4], h[5]); w.w = cvt_pk_bf16(h[6], h[7]);
#if MK_NT
                __builtin_nontemporal_store(w, (u32x4*)(H + (size_t)row * ldh + col0));
#else
                *(u32x4*)(H + (size_t)row * ldh + col0) = w;
#endif
                }
            }
    }
};

template <bool KH, int SB = 0> struct EpiResid {
    static constexpr bool PERM = true, AFTER_DRAIN = false, KHOOK = KH; static constexpr int SCALE_B = SB;
    static constexpr int K1 = 8, K2 = 16;
    bf16_t* XB; float* ss; float alpha;
    const float* ssa; const float* ssg;
    PG8_LAS float* tab;
    unsigned char* X8;
    __device__ __forceinline__ void unit_begin(const Unit& u, int wid, int wr, int fr, int fq) const {
        if constexpr (KH) {
            PG8_LAS float* t = tab + wid * 384;
            if (fq == 0) {
                float sa[2][4]; f32x2_t sg[2][4];
#pragma unroll
                for (int ai = 0; ai < 2; ++ai)
#pragma unroll
                    for (int m = 0; m < 4; ++m) { const int row = u.pm * BM + ai * HALF + wr * 64 + m * 16 + fr;
                        sa[ai][m] = ((const __attribute__((address_space(1))) float*)ssa)[row]; sg[ai][m] = *(const __attribute__((address_space(1))) f32x2_t*)(ssg + 2 * row); }
#pragma unroll
                for (int ai = 0; ai < 2; ++ai)
#pragma unroll
                    for (int m = 0; m < 4; ++m) {
                        const float va = sa[ai][m] * (1.0f / 512.0f) + RMS_EPS, v0 = sg[ai][m].x * (1.0f / 512.0f) + RMS_EPS, v1 = sg[ai][m].y * (1.0f / 512.0f) + RMS_EPS;
                        const int e = (ai * 4 + m) * 16 + fr;
                        t[e] = sqrtf(v0 * __builtin_amdgcn_rcpf(va));
                        t[128 + e] = sqrtf(v1 * __builtin_amdgcn_rcpf(v0));
                        t[256 + e] = rsqrtf(v1);
                    }
            }
            asm volatile("s_waitcnt lgkmcnt(0)" ::: "memory");
        }
    }
    __device__ __forceinline__ void khook(f32x4 (&acc)[2][2][4][2], int t, int wid, int fr) const {
        if constexpr (KH) {
            const PG8_LAS float* tb = tab + wid * 384 + (t == K1 ? 0 : 128);
#pragma unroll
            for (int ai = 0; ai < 2; ++ai)
#pragma unroll
                for (int m = 0; m < 4; ++m) { const float f = tb[(ai * 4 + m) * 16 + fr];
#pragma unroll
                    for (int bj = 0; bj < 2; ++bj)
#pragma unroll
                        for (int n = 0; n < 2; ++n) acc[ai][bj][m][n] = acc[ai][bj][m][n] * f; }
        }
    }
    __device__ __forceinline__ void operator()(const f32x4 (&acc)[2][2][4][2], const Unit& u, int wr, int wc, int fr, int fq) const {
        const int row0 = u.pm * BM + wr * 64 + fr, col0 = u.pn * BM + wc * 32 + 8 * fq;
        const int wid = wr * 4 + wc;
        u32x4 rra[2][4][2];
        constexpr bool ALL = false;
        if constexpr (ALL) {
#pragma unroll
            for (int ai = 0; ai < 2; ++ai)
#pragma unroll
                for (int m = 0; m < 4; ++m)
#pragma unroll
                    for (int bj = 0; bj < 2; ++bj) rra[ai][m][bj] = *(const u32x4*)(XB + (size_t)(row0 + ai * HALF + m * 16) * 1024 + col0 + bj * HALF);
#pragma unroll
            for (int ai = 0; ai < 2; ++ai)
#pragma unroll
                for (int m = 0; m < 4; ++m)
#pragma unroll
                    for (int bj = 0; bj < 2; ++bj) asm volatile("" : "+v"(rra[ai][m][bj]));
        }
#pragma unroll
        for (int ai = 0; ai < 2; ++ai) {
            if constexpr (!ALL) {
#pragma unroll
                for (int m = 0; m < 4; ++m)
#pragma unroll
                    for (int bj = 0; bj < 2; ++bj) rra[ai][m][bj] = *(const u32x4*)(XB + (size_t)(row0 + ai * HALF + m * 16) * 1024 + col0 + bj * HALF);
#pragma unroll
                for (int m = 0; m < 4; ++m)
#pragma unroll
                    for (int bj = 0; bj < 2; ++bj) asm volatile("" : "+v"(rra[ai][m][bj]));
            }
#pragma unroll
            for (int m = 0; m < 4; ++m) {
                const int row = row0 + ai * HALF + m * 16;
                float f = alpha; if constexpr (KH) f *= tab[wid * 384 + 256 + (ai * 4 + m) * 16 + fr];
                float sq = 0.f;
#pragma unroll
                for (int bj = 0; bj < 2; ++bj) {
                    float v[8];
#pragma unroll
                    for (int n = 0; n < 2; ++n)
#pragma unroll
                        for (int i = 0; i < 2; ++i) { const unsigned w = rra[ai][m][bj][2 * n + i];
                            v[4 * n + 2 * i] = __uint_as_float(w << 16) + acc[ai][bj][m][n][2 * i] * f; v[4 * n + 2 * i + 1] = __uint_as_float(w & 0xffff0000u) + acc[ai][bj][m][n][2 * i + 1] * f; }
#pragma unroll
                    for (int j = 0; j < 8; ++j) sq += v[j] * v[j];
                    u32x4 w; w.x = cvt_pk_bf16(v[0], v[1]); w.y = cvt_pk_bf16(v[2], v[3]); w.z = cvt_pk_bf16(v[4], v[5]); w.w = cvt_pk_bf16(v[6], v[7]);
                    *(u32x4*)(XB + (size_t)row * 1024 + col0 + bj * HALF) = w;
                    if (X8) { u32x2 w8; w8.x = cvt4_fp8(v[0], v[1], v[2], v[3]); w8.y = cvt4_fp8(v[4], v[5], v[6], v[7]); *(u32x2*)(X8 + (size_t)row * 1024 + col0 + bj * HALF) = w8; }
                }
                sq = sum16(sq); sq = sum32(sq);
                if (fq == 0) atomicAdd(ss + row, sq);
            }
        }
    }
};

typedef EpiSwigluT<false, 0> EpiSwiglu;
template <int LITE> struct EpiProjT {
    static constexpr bool PERM = true, AFTER_DRAIN = false, KHOOK = false; static constexpr int SCALE_B = 0;
    bf16_t *Q, *Kb, *V, *Z, *XBC; const float* ss; const float* cs; float* kmsum; float qscale;
    __device__ __forceinline__ void operator()(const f32x4 (&acc)[2][2][4][2], const Unit& u, int wr, int wc, int fr, int fq) const {
        const int pn = u.pn;
        bf16_t* dst; int ld, cb;
        if (pn < 2) { dst = Q; ld = 512; cb = pn * 256; } else if (pn < 4) { dst = Kb; ld = 512; cb = (pn - 2) * 256; } else if (pn < 6) { dst = V; ld = 512; cb = (pn - 4) * 256; }
        else if (pn < 10) { dst = Z; ld = 1024; cb = (pn - 6) * 256; } else { dst = XBC; ld = 1536; cb = (pn - 10) * 256; }
        const bool rot = (LITE == 0) && (pn < 4) && ((wc & 1) == 0), isk = (LITE != 1) && (pn == 2 || pn == 3);
        const float sc = pn < 2 ? qscale : 1.0f;
        const int row0 = u.pm * BM + wr * 64 + fr, c0 = wc * 32 + 8 * fq;
        float csum[2][8];
#pragma unroll
        for (int bj = 0; bj < 2; ++bj)
#pragma unroll
            for (int j = 0; j < 8; ++j) csum[bj][j] = 0.f;
        f32x4 ncv[2], nsv[2];
        if (rot) { const float* cp = cs + (size_t)(row0 & 4095) * 16; ncv[0] = *(const f32x4*)cp; ncv[1] = *(const f32x4*)(cp + 4); nsv[0] = *(const f32x4*)(cp + 8); nsv[1] = *(const f32x4*)(cp + 12); }
        float ssv[2][4];
#pragma unroll
        for (int ai = 0; ai < 2; ++ai)
#pragma unroll
            for (int m = 0; m < 4; ++m) ssv[ai][m] = ss[row0 + ai * HALF + m * 16];
#pragma unroll
        for (int ai = 0; ai < 2; ++ai)
#pragma unroll
            for (int m = 0; m < 4; ++m) asm volatile("" : "+v"(ssv[ai][m]));
#pragma unroll
        for (int ai = 0; ai < 2; ++ai)
#pragma unroll
            for (int m = 0; m < 4; ++m) {
                const int row = row0 + ai * HALF + m * 16;
                const float rs = rsqrtf(ssv[ai][m] * (1.0f / 1024.0f) + RMS_EPS) * sc;
                f32x4 cv[2], sv[2];
                if (rot) {
                    cv[0] = ncv[0]; cv[1] = ncv[1]; sv[0] = nsv[0]; sv[1] = nsv[1];
                    if (ai * 4 + m < 7) {
                        constexpr float C16[8] = {-9.576594803e-01f, -9.992462593e-01f, 8.243765146e-01f, 9.932003012e-01f, 9.997440109e-01f, 9.999903729e-01f, 9.999996380e-01f, 9.999999864e-01f};
                        constexpr float S16[8] = {-2.879033167e-01f, 3.881898152e-02f, 5.660418378e-01f, 1.164180468e-01f, 2.262548617e-02f, 4.387956730e-03f, 8.509272408e-04f, 1.650141653e-04f};
                        constexpr float C80[8] = {-1.103872438e-01f, -9.812132344e-01f, -9.911539132e-01f, 8.345872775e-01f, 9.936068238e-01f, 9.997593311e-01f, 9.999909490e-01f, 9.999996596e-01f};
                        constexpr float S80[8] = {-9.938886539e-01f, 1.929263812e-01f, 1.327174458e-01f, 5.508757358e-01f, 1.128958803e-01f, 2.193809395e-02f, 4.254623881e-03f, 8.250707366e-04f};
#pragma unroll
                        for (int j = 0; j < 8; ++j) { const float cd = (m == 3) ? C80[j] : C16[j], sd = (m == 3) ? S80[j] : S16[j], c0_ = cv[j >> 2][j & 3], s0_ = sv[j >> 2][j & 3];
                            ncv[j >> 2][j & 3] = c0_ * cd - s0_ * sd; nsv[j >> 2][j & 3] = s0_ * cd + c0_ * sd; } } }
#pragma unroll
                for (int bj = 0; bj < 2; ++bj) {
                    float v[8];
#pragma unroll
                    for (int n = 0; n < 2; ++n)
#pragma unroll
                        for (int i = 0; i < 4; ++i) v[4 * n + i] = acc[ai][bj][m][n][i] * rs;
                    if (rot) {
#pragma unroll
                        for (int j = 0; j < 8; ++j) {
                            const float p = partner16(v[j], fq);
                            const float c = cv[j >> 2][j & 3], s = sv[j >> 2][j & 3];
                            const float r1 = v[j] * c - p * s, r2 = v[j] * c + p * s;
                            v[j] = fq == 0 ? r1 : (fq == 1 ? r2 : v[j]);
                        }
                    }
                    if (isk) {
#pragma unroll
                        for (int j = 0; j < 8; ++j) csum[bj][j] += v[j];
                    }
                    u32x4 w; w.x = cvt_pk_bf16(v[0], v[1]); w.y = cvt_pk_bf16(v[2], v[3]); w.z = cvt_pk_bf16(v[4], v[5]); w.w = cvt_pk_bf16(v[6], v[7]);
                    if (pn < 6) { const int col = cb + bj * HALF + c0;
                        *(u32x4*)(dst + ((size_t)((row >> 12) * 8 + (col >> 6)) * 4096 + (row & 4095)) * 64 + (col & 63)) = w; }
                    else *(u32x4*)(dst + (size_t)row * ld + cb + bj * HALF + c0) = w;
                }
            }
        if (isk) {
#pragma unroll
            for (int bj = 0; bj < 2; ++bj) {
                float mine = 0.f;
#pragma unroll
                for (int j = 0; j < 8; ++j) {
                    float s = csum[bj][j];
                    s += __builtin_bit_cast(float, __builtin_amdgcn_update_dpp(0, __builtin_bit_cast(int, s), 0x128, 0xf, 0xf, false));
                    s += __builtin_bit_cast(float, __builtin_amdgcn_update_dpp(0, __builtin_bit_cast(int, s), 0x124, 0xf, 0xf, false));
                    s += __builtin_bit_cast(float, __builtin_amdgcn_update_dpp(0, __builtin_bit_cast(int, s), 0x122, 0xf, 0xf, false));
                    s += __builtin_bit_cast(float, __builtin_amdgcn_update_dpp(0, __builtin_bit_cast(int, s), 0x121, 0xf, 0xf, false));
                    mine = ((fr & 7) == j) ? s : mine;
                }
                if (fr < 8) atomicAdd(kmsum + (size_t)u.pm * 512 + (pn - 2) * 256 + bj * HALF + c0 + fr, mine);
            }
        }
    }
};

typedef EpiProjT<0> EpiProj;
struct EpiNull {
    static constexpr bool PERM = true, AFTER_DRAIN = false, KHOOK = false; static constexpr int SCALE_B = 0;
    float* sink;
    __device__ __forceinline__ void operator()(const f32x4 (&acc)[2][2][4][2], const Unit& u, int wr, int wc, int fr, int fq) const {
        float s = 0.f;
#pragma unroll
        for (int ai = 0; ai < 2; ++ai)
#pragma unroll
            for (int bj = 0; bj < 2; ++bj)
#pragma unroll
                for (int m = 0; m < 4; ++m)
#pragma unroll
                    for (int n = 0; n < 2; ++n) s += (acc[ai][bj][m][n][0] + acc[ai][bj][m][n][1]) + (acc[ai][bj][m][n][2] + acc[ai][bj][m][n][3]);
        sink[(wr * 4 + wc) * 64 + fq * 16 + fr] = s;
    }
};
typedef float f32x16w __attribute__((ext_vector_type(16))); typedef int v8i32 __attribute__((ext_vector_type(8))); typedef int v4i32 __attribute__((ext_vector_type(4)));
__device__ __forceinline__ v8i32 cat8(bf16x8 a, bf16x8 b) { const v4i32 x = __builtin_bit_cast(v4i32, a), y = __builtin_bit_cast(v4i32, b); return __builtin_shufflevector(x, y, 0, 1, 2, 3, 4, 5, 6, 7); }
template <class Epi, class Sched, bool ALIGN_EPI = false, bool SP2 = false, bool FP8 = false, bool S32 = false>
__device__ __forceinline__ void gemm_phase(PG8_LAS unsigned char* lds, const Gemm g, const Sched& S, const Epi& E) {
    int tid_ = threadIdx.x; asm volatile("" : "+v"(tid_));
    const int tid = tid_, wid = __builtin_amdgcn_readfirstlane(tid >> 6), lane = tid & 63, wr = wid >> 2, wc = wid & 3, fr = lane & 15, fq = lane >> 4;
    const int K = g.K, nt = K / BK;
    unsigned voffA[2], voffB[2];
#pragma unroll
    for (int i = 0; i < 2; ++i) { int R, C; stage_rc(tid * 16 + i * 8192, R, C); const int Rb = Epi::PERM ? ((R & ~31) + perm32(R & 31)) : R;
        voffA[i] = (unsigned)(R * K + C) * 2u; voffB[i] = (unsigned)(Rb * K + C) * 2u; }
    const size_t p1step = (size_t)64 * K * 2;
    const size_t kstep = (size_t)(BK * 2);
    const size_t hstep = (size_t)HALF * K * 2;
    const size_t tstep = 2 * hstep;
    const unsigned ldsw = (unsigned)wid * 1024u;
    const int aoff = lds_byte(wr * 64 + fr, fq * 8), boff = lds_byte(wc * 32 + fr, fq * 8);
    constexpr int SCB = (127 - Epi::SCALE_B) | (127 << 8);
#define PG8_SA(b, h) (((b) * 2 + (h)) * HTB)
#define PG8_SB(b, h) ((4 + (b) * 2 + (h)) * HTB)
#define PG8_STAGE(bufoff, gbase, voff) do { _Pragma("unroll") for (int _i = 0; _i < 2; ++_i) \
        __builtin_amdgcn_global_load_lds((const unsigned*)((const char*)(gbase) + (size_t)_i * p1step + (voff)[0]), (PG8_LAS unsigned*)(lds + (bufoff) + ldsw + _i * 8192), 16, 0, 0); } while (0)
#define PG8_LDA(dst, b, h) do { if constexpr (FP8) { _Pragma("unroll") for (int m = 0; m < 4; ++m) { const v4i32 lo_ = *(const PG8_LAS v4i32*)(lds + PG8_SA(b, h) + aoff + m * 2048), hi_ = *(const PG8_LAS v4i32*)(lds + PG8_SA(b, h) + aoff + m * 2048 + 1024); dst##8[m] = __builtin_shufflevector(lo_, hi_, 0, 1, 2, 3, 4, 5, 6, 7); } } \
        else { _Pragma("unroll") for (int m = 0; m < 4; ++m) _Pragma("unroll") for (int k = 0; k < 2; ++k) dst[m][k] = *(const PG8_LAS bf16x8*)(lds + PG8_SA(b, h) + aoff + m * 2048 + k * 1024); } } while (0)
#define PG8_LDB(dst, b, h) do { if constexpr (FP8) { _Pragma("unroll") for (int n = 0; n < 2; ++n) { const v4i32 lo_ = *(const PG8_LAS v4i32*)(lds + PG8_SB(b, h) + boff + n * 2048), hi_ = *(const PG8_LAS v4i32*)(lds + PG8_SB(b, h) + boff + n * 2048 + 1024); dst##8[n] = __builtin_shufflevector(lo_, hi_, 0, 1, 2, 3, 4, 5, 6, 7); } } \
        else { _Pragma("unroll") for (int n = 0; n < 2; ++n) _Pragma("unroll") for (int k = 0; k < 2; ++k) dst[n][k] = *(const PG8_LAS bf16x8*)(lds + PG8_SB(b, h) + boff + n * 2048 + k * 1024); } } while (0)
#define PG8_MMA(ai, bj, At, Bt) do { __builtin_amdgcn_s_setprio(1); if constexpr (S32) { _Pragma("unroll") for (int t_ = 0; t_ < 2; ++t_) _Pragma("unroll") for (int ks_ = 0; ks_ < 4; ++ks_) \
        acc32[ai][bj][t_] = __builtin_amdgcn_mfma_f32_32x32x16_bf16(Bt[ks_ >> 1][ks_ & 1], At[t_ * 2 + (ks_ >> 1)][ks_ & 1], acc32[ai][bj][t_], 0, 0, 0); } else \
        _Pragma("unroll") for (int m = 0; m < 4; ++m) _Pragma("unroll") for (int n = 0; n < 2; ++n) { \
        if constexpr (FP8) { f32x16w& W_ = accw[ai][bj][m >> 1]; const int i_ = 4 * ((m & 1) * 2 + n); f32x4 c_ = {W_[i_], W_[i_ + 1], W_[i_ + 2], W_[i_ + 3]}; \
            c_ = __builtin_amdgcn_mfma_scale_f32_16x16x128_f8f6f4(Bt##8[n], At##8[m], c_, 0, 0, 0, SCB, 1, SCB); W_[i_] = c_[0]; W_[i_ + 1] = c_[1]; W_[i_ + 2] = c_[2]; W_[i_ + 3] = c_[3]; } \
        else { _Pragma("unroll") for (int k = 0; k < 2; ++k) acc[ai][bj][m][n] = __builtin_amdgcn_mfma_f32_16x16x32_bf16(Bt[n][k], At[m][k], acc[ai][bj][m][n], 0, 0, 0); } } __builtin_amdgcn_s_setprio(0); } while (0)
#define PG8_WAIT_V(n) asm volatile("s_waitcnt vmcnt(" #n ")" ::: "memory")
#define PG8_WAIT_L(n) asm volatile("s_waitcnt lgkmcnt(" #n ")" ::: "memory")
#define PG8_BAR __builtin_amdgcn_s_barrier()
#define PG8_SCHED __builtin_amdgcn_sched_barrier(0)
    Unit cur, nxt; int ui = 0;
    if (!S.next(0, cur)) return;
    f32x4 acc[2][2][4][2];
    f32x16w acc32[2][2][2];
    if constexpr (S32) { _Pragma("unroll") for (int a = 0; a < 2; ++a) _Pragma("unroll") for (int b = 0; b < 2; ++b) _Pragma("unroll") for (int q = 0; q < 2; ++q) acc32[a][b][q] = f32x16w{}; }
    f32x16w accw[2][2][2];
#define PG8_ZERO_W() do { if constexpr (FP8) { _Pragma("unroll") for (int a = 0; a < 2; ++a) _Pragma("unroll") for (int b = 0; b < 2; ++b) _Pragma("unroll") for (int q = 0; q < 2; ++q) accw[a][b][q] = f32x16w{}; } } while (0)
#define PG8_UNPACK_W() do { if constexpr (FP8) { _Pragma("unroll") for (int a = 0; a < 2; ++a) _Pragma("unroll") for (int b = 0; b < 2; ++b) _Pragma("unroll") for (int m = 0; m < 4; ++m) _Pragma("unroll") for (int n = 0; n < 2; ++n) { \
        const int i_ = 4 * ((m & 1) * 2 + n); acc[a][b][m][n] = (f32x4){accw[a][b][m >> 1][i_], accw[a][b][m >> 1][i_ + 1], accw[a][b][m >> 1][i_ + 2], accw[a][b][m >> 1][i_ + 3]}; } } } while (0)
    PG8_ZERO_W();
#pragma unroll
    for (int a = 0; a < 2; ++a)
#pragma unroll
        for (int b = 0; b < 2; ++b)
#pragma unroll
            for (int m = 0; m < 4; ++m)
#pragma unroll
                for (int n = 0; n < 2; ++n) acc[a][b][m][n] = (f32x4){0.f, 0.f, 0.f, 0.f};
    bf16x8 At[4][2], B0[2][2], B1[2][2]; v8i32 At8[4], B08[2], B18[2];
    const char* cA = (const char*)g.A + (size_t)cur.pm * tstep; const char* cB = (const char*)g.Bt + (size_t)cur.pn * tstep;
    S.a_ready(cur);
    if constexpr (SP2) {
        PG8_STAGE(PG8_SB(0, 0), cB, voffB); PG8_STAGE(PG8_SB(0, 1), cB + hstep, voffB); PG8_STAGE(PG8_SA(0, 0), cA, voffA); PG8_STAGE(PG8_SA(0, 1), cA + hstep, voffA);
        if (wr == 1) PG8_BAR;
        PG8_WAIT_V(2); PG8_BAR;
        PG8_STAGE(PG8_SB(1, 0), cB + kstep, voffB); PG8_STAGE(PG8_SA(1, 0), cA + kstep, voffA); PG8_STAGE(PG8_SB(1, 1), cB + hstep + kstep, voffB);
        PG8_WAIT_V(6); PG8_BAR;
    } else {
        PG8_STAGE(PG8_SB(0, 0), cB, voffB); PG8_STAGE(PG8_SA(0, 0), cA, voffA); PG8_STAGE(PG8_SB(0, 1), cB + hstep, voffB); PG8_STAGE(PG8_SA(0, 1), cA + hstep, voffA);
        if (wr == 1) PG8_BAR;
        PG8_WAIT_V(4); PG8_BAR;
        PG8_STAGE(PG8_SB(1, 0), cB + kstep, voffB); PG8_STAGE(PG8_SA(1, 0), cA + kstep, voffA); PG8_STAGE(PG8_SB(1, 1), cB + hstep + kstep, voffB);
        PG8_WAIT_V(6); PG8_BAR;
    }
    for (;;) {
        const bool has_next = S.next(ui + 1, nxt);
        if constexpr (Epi::KHOOK) E.unit_begin(cur, wid, wr, fr, fq);
        const char* nA = has_next ? (const char*)g.A + (size_t)nxt.pm * tstep : cA; const char* nB = has_next ? (const char*)g.Bt + (size_t)nxt.pn * tstep : cB;
#pragma unroll 1
        for (int t = 0; t < nt; t += 2) {
            const bool last = (t == nt - 2);
            if constexpr (Epi::KHOOK) { if (t == Epi::K1 || t == Epi::K2) { E.khook(acc, t, wid, fr); PG8_SCHED; } }
            const char* a1 = cA + (size_t)(t + 1) * kstep;
            const char* a2 = last ? nA : cA + (size_t)(t + 2) * kstep; const char* b2 = last ? nB : cB + (size_t)(t + 2) * kstep;
            const char* a3 = a2 + kstep; const char* b3 = b2 + kstep;
            if (last && has_next) S.a_ready(nxt);
            if constexpr (SP2) {
            PG8_LDB(B0, 0, 0); PG8_LDB(B1, 0, 1); PG8_SCHED; PG8_LDA(At, 0, 0); PG8_STAGE(PG8_SA(1, 1), a1 + hstep, voffA);
            PG8_WAIT_V(8); PG8_WAIT_L(0); PG8_BAR; PG8_MMA(0, 0, At, B0); PG8_MMA(0, 1, At, B1); PG8_BAR; PG8_SCHED;
            PG8_LDA(At, 0, 1); PG8_STAGE(PG8_SB(0, 0), b2, voffB); PG8_STAGE(PG8_SB(0, 1), b2 + hstep, voffB); PG8_STAGE(PG8_SA(0, 0), a2, voffA);
            PG8_WAIT_V(8); PG8_WAIT_L(0); PG8_BAR; PG8_MMA(1, 0, At, B0); PG8_MMA(1, 1, At, B1); PG8_BAR; PG8_SCHED;
            PG8_LDB(B0, 1, 0); PG8_LDB(B1, 1, 1); PG8_SCHED; PG8_LDA(At, 1, 0); PG8_STAGE(PG8_SA(0, 1), a2 + hstep, voffA);
            PG8_WAIT_V(8); PG8_WAIT_L(0); PG8_BAR; PG8_MMA(0, 0, At, B0); PG8_MMA(0, 1, At, B1); PG8_BAR; PG8_SCHED;
            PG8_LDA(At, 1, 1); PG8_STAGE(PG8_SB(1, 0), b3, voffB); PG8_STAGE(PG8_SB(1, 1), b3 + hstep, voffB); PG8_STAGE(PG8_SA(1, 0), a3, voffA);
            PG8_WAIT_V(8); PG8_WAIT_L(0); PG8_BAR; PG8_MMA(1, 0, At, B0); PG8_MMA(1, 1, At, B1); PG8_BAR; PG8_SCHED;
            } else {
            PG8_LDB(B0, 0, 0); PG8_SCHED; PG8_LDA(At, 0, 0); PG8_STAGE(PG8_SA(1, 1), a1 + hstep, voffA);
            PG8_WAIT_L(8); PG8_BAR; PG8_WAIT_L(0); PG8_MMA(0, 0, At, B0); PG8_BAR; PG8_SCHED;
            PG8_LDB(B1, 0, 1); PG8_STAGE(PG8_SB(0, 0), b2, voffB);
            PG8_BAR; PG8_WAIT_L(0); PG8_MMA(0, 1, At, B1); PG8_BAR;
            PG8_LDA(At, 0, 1); PG8_STAGE(PG8_SA(0, 0), a2, voffA);
            PG8_BAR; PG8_WAIT_L(0); PG8_MMA(1, 0, At, B0); PG8_BAR; PG8_SCHED;
            PG8_STAGE(PG8_SB(0, 1), b2 + hstep, voffB);
            PG8_WAIT_V(6); PG8_BAR; PG8_MMA(1, 1, At, B1); PG8_BAR;
            PG8_LDB(B0, 1, 0); PG8_SCHED; PG8_LDA(At, 1, 0); PG8_STAGE(PG8_SA(0, 1), a2 + hstep, voffA);
            PG8_WAIT_L(8); PG8_BAR; PG8_WAIT_L(0); PG8_MMA(0, 0, At, B0); PG8_BAR; PG8_SCHED;
            PG8_LDB(B1, 1, 1); PG8_STAGE(PG8_SB(1, 0), b3, voffB);
            PG8_BAR; PG8_WAIT_L(0); PG8_MMA(0, 1, At, B1); PG8_BAR;
            PG8_LDA(At, 1, 1); PG8_STAGE(PG8_SA(1, 0), a3, voffA);
            PG8_BAR; PG8_WAIT_L(0); PG8_MMA(1, 0, At, B0); PG8_BAR; PG8_SCHED;
            PG8_STAGE(PG8_SB(1, 1), b3 + hstep, voffB);
            PG8_WAIT_V(6); PG8_BAR; PG8_MMA(1, 1, At, B1); PG8_BAR;
            }
        }
        if constexpr (ALIGN_EPI) { if (wr == 0) PG8_BAR; }
        PG8_UNPACK_W();
        if constexpr (S32) { float s_ = 0.f; _Pragma("unroll") for (int a = 0; a < 2; ++a) _Pragma("unroll") for (int b = 0; b < 2; ++b) _Pragma("unroll") for (int q = 0; q < 2; ++q) { _Pragma("unroll") for (int e_ = 0; e_ < 16; ++e_) s_ += acc32[a][b][q][e_]; acc32[a][b][q] = f32x16w{}; } E.sink[(wr * 4 + wc) * 64 + fq * 16 + fr] = s_; }
        else if constexpr (!Epi::AFTER_DRAIN) { E(acc, cur, wr, wc, fr, fq); S.done(cur); }
        if (!has_next) break;
#pragma unroll
        for (int a = 0; a < 2; ++a)
#pragma unroll
            for (int b = 0; b < 2; ++b)
#pragma unroll
                for (int m = 0; m < 4; ++m)
#pragma unroll
                    for (int n = 0; n < 2; ++n) acc[a][b][m][n] = (f32x4){0.f, 0.f, 0.f, 0.f};
        PG8_ZERO_W();
        cur = nxt; cA = nA; cB = nB; ++ui;
        if constexpr (ALIGN_EPI) { if (wr == 1) PG8_BAR; }
    }
    PG8_WAIT_V(0);
    if constexpr (!ALIGN_EPI) { if (wr == 0) PG8_BAR; }
    PG8_BAR;
    if constexpr (Epi::AFTER_DRAIN) { E.fused(acc, cur, wr, wc, fr, fq, lds, wid, lane); S.done(cur); }
#undef PG8_ZERO_W
#undef PG8_UNPACK_W
#undef PG8_SA
#undef PG8_SB
#undef PG8_STAGE
#undef PG8_LDA
#undef PG8_LDB
#undef PG8_MMA
#undef PG8_WAIT_V
#undef PG8_WAIT_L
#undef PG8_BAR
#undef PG8_SCHED
}
}

#include <hip/hip_bf16.h>
#include <cmath>
namespace attn_body {
using bf16=__hip_bfloat16;
using bf16x8=__attribute__((ext_vector_type(8)))short;
using s16x4=__attribute__((ext_vector_type(4)))short;
using f32x16=__attribute__((ext_vector_type(16)))float;
using u32x4=__attribute__((ext_vector_type(4)))unsigned;
using f32x4v=__attribute__((ext_vector_type(4)))float;
constexpr int BATCH=8,NHEAD=8,SEQ=4096,D=64,DM=NHEAD*D,OPITCH=1536,HP=D;
constexpr int NW=8,QBLK=32,QB=QBLK*NW,KVBLK=64,NQB=SEQ/QB;
constexpr int ATTN_PITCH=DM, ATTN_UNIT_ROWS=QB;
__device__ __forceinline__ int crow(int r,int hi){return (r&3)+8*(r>>2)+4*hi;}
#define SBAR() __builtin_amdgcn_sched_barrier(0)
__device__ __forceinline__ void cmask(f32x16&p0,f32x16&p1,int jb,int qrel,int hi){
  const float NEG=-INFINITY; int kb=64*jb+4*hi;
  #pragma unroll
  for(int r=0;r<16;++r){int kv=kb+(r&3)+8*(r>>2); if(kv>qrel)p0[r]=NEG; if(kv+32>qrel)p1[r]=NEG;}
}

constexpr int NSLOT=3, SLOTB=8192;
constexpr int LDS_K=0, LDS_V=NSLOT*SLOTB, LDS_WS=2*NSLOT*SLOTB, LDS_OST=LDS_WS+NW*64*4, LDS_BYTES=LDS_OST+NW*4096;
constexpr float C2=0.125f*1.4426950408889634f;
__device__ __forceinline__ void glds16(const void*gsrc,unsigned lds_dst){unsigned keep;
  asm volatile("s_mov_b32 %0, m0\n\ts_mov_b32 m0, %2\n\ts_nop 0\n\tglobal_load_lds_dwordx4 %1, off\n\ts_mov_b32 m0, %0":"=&s"(keep):"v"(gsrc),"s"(lds_dst):"memory");}
__device__ __forceinline__ float max3f(float a,float b,float c){float r;asm("v_max3_f32 %0, %1, %2, %3":"=v"(r):"v"(a),"v"(b),"v"(c));return r;}
__device__ __forceinline__ float max2f(float a,float b){float r;asm("v_max_f32_e32 %0, %1, %2":"=v"(r):"v"(a),"v"(b));return r;}
__device__ __forceinline__ float fadd_s(float a,float b){float r;asm("v_add_f32_e32 %0, %1, %2":"=v"(r):"v"(a),"v"(b));return r;}
__device__ __forceinline__ float fsub_s(float a,float b){float r;asm("v_sub_f32_e32 %0, %1, %2":"=v"(r):"v"(a),"v"(b));return r;}
typedef float f32x2_t __attribute__((ext_vector_type(2))); typedef __bf16 bf16x2_t __attribute__((ext_vector_type(2)));
__device__ __forceinline__ unsigned cvtpk_s(float lo,float hi){f32x2_t v={lo,hi};bf16x2_t b=__builtin_convertvector(v,bf16x2_t);return __builtin_bit_cast(unsigned,b);}
#define WAIT_BAR(N) asm volatile("s_waitcnt vmcnt(" #N ") lgkmcnt(0)\n\ts_barrier":::"memory")

__device__ __forceinline__ void qkt(f32x16&p0,f32x16&p1,const char*Kslot,const bf16x8*qr,const f32x16&negm,int r32,int hi){
  const char*kb=Kslot+hi*1024+r32*16;
  #pragma unroll
  for(int d0=0;d0<4;++d0){
    const bf16x8 b0=*reinterpret_cast<const bf16x8*>(kb+d0*2048);
    const bf16x8 b1=*reinterpret_cast<const bf16x8*>(kb+d0*2048+512);
    if(d0==0){p0=__builtin_amdgcn_mfma_f32_32x32x16_bf16(b0,qr[0],negm,0,0,0);p1=__builtin_amdgcn_mfma_f32_32x32x16_bf16(b1,qr[0],negm,0,0,0);}
    else{p0=__builtin_amdgcn_mfma_f32_32x32x16_bf16(b0,qr[d0],p0,0,0,0);p1=__builtin_amdgcn_mfma_f32_32x32x16_bf16(b1,qr[d0],p1,0,0,0);}}
}
typedef __attribute__((address_space(3))) const char* lds_cptr;
typedef short v4i16_t __attribute__((ext_vector_type(4)));
__device__ __forceinline__ void kload8(bf16x8*kf,lds_cptr kp){
  kf[0]=*(const __attribute__((address_space(3))) bf16x8*)(kp);      kf[1]=*(const __attribute__((address_space(3))) bf16x8*)(kp+512);
  kf[2]=*(const __attribute__((address_space(3))) bf16x8*)(kp+2048); kf[3]=*(const __attribute__((address_space(3))) bf16x8*)(kp+2560);
  kf[4]=*(const __attribute__((address_space(3))) bf16x8*)(kp+4096); kf[5]=*(const __attribute__((address_space(3))) bf16x8*)(kp+4608);
  kf[6]=*(const __attribute__((address_space(3))) bf16x8*)(kp+6144); kf[7]=*(const __attribute__((address_space(3))) bf16x8*)(kp+6656);
}
__device__ __forceinline__ void kload2(bf16x8*kf,lds_cptr kp,int j){ kf[2*j]=*(const __attribute__((address_space(3))) bf16x8*)(kp+j*2048); kf[2*j+1]=*(const __attribute__((address_space(3))) bf16x8*)(kp+j*2048+512); }
__device__ __forceinline__ s16x4 vtr(lds_cptr p){ return __builtin_bit_cast(s16x4,__builtin_amdgcn_ds_read_tr16_b64_v4i16((__attribute__((address_space(3))) v4i16_t*)p)); }
__device__ __forceinline__ float rowmax(const f32x16&p0,const f32x16&p1){
  float a=max3f(p0[0],p0[1],p1[0]),b=max3f(p0[2],p0[3],p1[1]);a=max3f(a,p1[2],p1[3]);
  #pragma unroll
  for(int r=4;r<16;r+=4){a=max3f(a,p0[r],p0[r+1]);b=max3f(b,p0[r+2],p0[r+3]);a=max3f(a,p1[r],p1[r+1]);b=max3f(b,p1[r+2],p1[r+3]);}
  const float m=max2f(a,b);
  auto rr=__builtin_amdgcn_permlane32_swap(__float_as_uint(m),__float_as_uint(m),false,false);
  return max2f(__uint_as_float(rr[0]),__uint_as_float(rr[1]));
}
__device__ __forceinline__ void pv(f32x16*o,int vb,bf16x8 pa0,bf16x8 pa1,bf16x8 pa2,bf16x8 pa3){
  #pragma unroll
  for(int d0=0;d0<2;++d0){s16x4 lo[4],hi[4];
    #pragma unroll
    for(int ks=0;ks<4;++ks){
      asm volatile("ds_read_b64_tr_b16 %0,%1 offset:%c2":"=&v"(lo[ks]):"v"(vb),"i"(d0*4096+ks*1024):"memory");
      asm volatile("ds_read_b64_tr_b16 %0,%1 offset:%c2":"=&v"(hi[ks]):"v"(vb),"i"(d0*4096+ks*1024+512):"memory");}
    asm volatile("s_waitcnt lgkmcnt(0)":::"memory");SBAR();
    #define PK(k) (bf16x8){lo[k][0],lo[k][1],lo[k][2],lo[k][3],hi[k][0],hi[k][1],hi[k][2],hi[k][3]}
    o[d0]=__builtin_amdgcn_mfma_f32_32x32x16_bf16(pa0,PK(0),o[d0],0,0,0);
    o[d0]=__builtin_amdgcn_mfma_f32_32x32x16_bf16(pa1,PK(1),o[d0],0,0,0);
    o[d0]=__builtin_amdgcn_mfma_f32_32x32x16_bf16(pa2,PK(2),o[d0],0,0,0);
    o[d0]=__builtin_amdgcn_mfma_f32_32x32x16_bf16(pa3,PK(3),o[d0],0,0,0);
    #undef PK
  }
}

#ifndef ATTN_STORE16
#define ATTN_STORE16(p,v) (*(u32x4*)(p)=(v))
#endif
template<int THRL,bool MOBA> __device__ __forceinline__ void attn_unit(int b,int h,int qb,const bf16*Q,const bf16*__restrict__ K,const bf16*__restrict__ V,bf16*O,const float*kmsum,float*ssq,char*shm){
  int tid_=threadIdx.x; asm volatile("":"+v"(tid_)); const int tid=tid_,lane=tid&63,r32=lane&31,hi=lane>>5; const int wid=__builtin_amdgcn_readfirstlane(tid>>6);
  const long rowbase=(long)b*SEQ; const int q0=qb*QB;
  const long hbase=((long)(b*NHEAD+h)*SEQ)*HP;
  const bf16*Qw=Q+hbase+(long)(q0+wid*QBLK)*HP;
  const bf16*Kh=K+hbase,*Vh=V+hbase;
  const unsigned lds0=(unsigned)(uintptr_t)shm;
  float*wsf=(float*)(shm+LDS_WS)+wid*64;
  const bf16*ksrc=Kh+(long)lane*HP+wid*8;
  const bf16*vsrc=Vh+(long)(16*(wid&3)+(lane>>2))*HP+(wid>>2)*32+(lane&3)*8;
  const unsigned kdst=lds0+LDS_K+wid*1024, vdst=lds0+LDS_V+wid*1024;
  #define DMA_K(t,slot) glds16(ksrc+(long)(t)*KVBLK*HP,(unsigned)__builtin_amdgcn_readfirstlane(kdst+(slot)))
  #define DMA_V(t,slot) glds16(vsrc+(long)(t)*KVBLK*HP,(unsigned)__builtin_amdgcn_readfirstlane(vdst+(slot)))
  const int vb0=(int)(lds0+LDS_V)+((lane>>4)&1)*32+(lane&3)*8+(4*hi+((lane&15)>>2))*64;
  const char*Kbase=shm+LDS_K; bf16x8 kf[8];
  const lds_cptr shm3=(lds_cptr)shm; const lds_cptr kp0=shm3+LDS_K+hi*1024+r32*16; const lds_cptr vp0=shm3+LDS_V+((lane>>4)&1)*32+(lane&3)*8+(4*hi+((lane&15)>>2))*64;
  const int NT=(q0+QB)/KVBLK;
  DMA_K(0,0);DMA_V(0,0);DMA_K(1,SLOTB);
  bf16x8 qr[4];
  #pragma unroll
  for(int d0=0;d0<4;++d0)qr[d0]=*reinterpret_cast<const bf16x8*>(&Qw[(long)r32*HP+d0*16+hi*8]);
  if(MOBA){ const int n_=tid>>5, d_=(tid&31)*2; const float*src_=kmsum+((long)b*16+n_)*DM+h*D+d_; const float k0_=src_[0],k1_=src_[1];
    float*kml_=(float*)(shm+LDS_BYTES)+n_*64+d_; kml_[0]=k0_; kml_[1]=k1_; }
  unsigned selmask=0u;
  float mhat=0.f,l_reg=0.f;f32x16 o[2];o[0]=f32x16{};o[1]=f32x16{};
  const int qrel=wid*QBLK+r32;
  #define SELM(P0,P1,t) do{ const float bs_=(!MOBA||((selmask>>((t)>>2))&1u))?-mhat:-INFINITY; _Pragma("unroll") for(int r_=0;r_<16;++r_){P0[r_]+=bs_;P1[r_]+=bs_;} }while(0)
  #define CMASK(P0,P1,t) do{int jb_=(t)-(NT-4); if(jb_>=0){ const float bm_=-mhat; _Pragma("unroll") for(int r_=0;r_<16;++r_){P0[r_]+=bm_;P1[r_]+=bm_;} cmask(P0,P1,jb_,qrel,hi);} else SELM(P0,P1,t);}while(0)
  bool resc=false;
  #define START(P0,P1) do{ const float rm=rowmax(P0,P1); resc=false; \
    { const float dl=(rm>-1e30f)?rm:0.f; mhat=fadd_s(mhat,dl); \
      _Pragma("unroll") for(int r=0;r<16;++r){P0[r]=fsub_s(P0[r],dl);P1[r]=fsub_s(P1[r],dl);} \
      } \
    _Pragma("unroll") for(int r=0;r<16;++r)P0[r]=__builtin_amdgcn_exp2f(P0[r]); }while(0)
  #define RESC() do{ if(resc){ asm volatile("s_waitcnt lgkmcnt(0)":::"memory"); \
      _Pragma("unroll") for(int d_=0;d_<2;++d_) _Pragma("unroll") for(int r=0;r<16;++r)o[d_][r]*=wsf[crow(r,hi)]; } }while(0)
  f32x16 pA0,pA1,pB0,pB1;
  int sl_prev=0,sl_cur=0,sl_next=SLOTB;
  #define ROT() do{sl_prev=sl_cur;sl_cur=sl_next;sl_next=(sl_next==(NSLOT-1)*SLOTB)?0:sl_next+SLOTB;}while(0)
  DMA_K(2,2*SLOTB);
  if(MOBA) asm volatile("s_waitcnt lgkmcnt(0)\n\ts_barrier":::"memory");
  if(MOBA){ float g[16];
    #pragma unroll
    for(int n=0;n<16;++n)g[n]=-INFINITY;
    const float*kmb=(const float*)(shm+LDS_BYTES)+hi*8;
    #pragma unroll
    for(int n=0;n<15;++n){ if(n<qb){ float a=0.f;
        #pragma unroll
        for(int d0=0;d0<4;++d0){ const f32x4v k0=*reinterpret_cast<const f32x4v*>(kmb+n*64+d0*16), k1=*reinterpret_cast<const f32x4v*>(kmb+n*64+d0*16+4);
          #pragma unroll
          for(int j=0;j<4;++j){ a+=__uint_as_float(((unsigned)(unsigned short)qr[d0][j])<<16)*k0[j]; a+=__uint_as_float(((unsigned)(unsigned short)qr[d0][4+j])<<16)*k1[j]; } }
        a=sum32(a); g[n]=a; } }
    #pragma unroll
    for(int j=0;j<3;++j){ int best=-1; float bv=-INFINITY;
      #pragma unroll
      for(int n=0;n<15;++n) if(g[n]>bv){bv=g[n];best=n;}
      if(best>=0)selmask|=1u<<best;
      #pragma unroll
      for(int n=0;n<15;++n) if(n==best)g[n]=-INFINITY; } }
  WAIT_BAR(3);
  qkt(pA0,pA1,Kbase,qr,f32x16{},r32,hi);asm volatile("s_nop 15\n\ts_nop 7":"+v"(pA0),"+v"(pA1));CMASK(pA0,pA1,0);
  START(pA0,pA1);
  _Pragma("unroll") for(int r=0;r<16;++r)pA1[r]=__builtin_amdgcn_exp2f(pA1[r]);
  WAIT_BAR(0);
  DMA_K(3,0);DMA_V(1,SLOTB);
  ROT();
  kload8(kf,kp0+sl_cur);
  WAIT_BAR(2);
  s16x4 vlo[8],vhi[8]; u32x4 pw0,pw1,pw2,pw3;
  #define PKW(P,B) cvtpk_s(P[B],P[B+1])
  #define PAF(k) __builtin_bit_cast(bf16x8,pw##k)
  #define VFR(i) (bf16x8){vlo[i][0],vlo[i][1],vlo[i][2],vlo[i][3],vhi[i][0],vhi[i][1],vhi[i][2],vhi[i][3]}
  #define PIN(x) asm volatile("":"+v"(x))
  #define MX3(a,b,c) __builtin_fmaxf(__builtin_fmaxf((a),(b)),(c))
  #define GAPA(MF,A0,A1,A2,A3,W0,W1,PW) do{ MF; sacc+=A0; sacc+=A1; sacc+=A2; sacc+=A3; PIN(sacc); W0; W1; PIN(PW); SBAR(); }while(0)
  #define EX(v) __builtin_amdgcn_exp2f(v)
  #define GAPB(MF,X,B) do{ MF; X[B]=EX(X[B]); X[B+1]=EX(X[B+1]); X[B+2]=EX(X[B+2]); X[B+3]=EX(X[B+3]); PIN(X); SBAR(); }while(0)
  #define VRD(i) do{ vlo[i]=vtr(vp_+(((i)>>2)*4096+((i)&3)*1024)); vhi[i]=vtr(vp_+(((i)>>2)*4096+((i)&3)*1024+512)); }while(0)
  #define KRD(G,j) do{ if(G){ kload2(kf,kp0+sl_next,j); SBAR(); } }while(0)
  #define STEP(C0,C1,P0,P1,t,GK,GV,GL) do{ SBAR(); \
    const lds_cptr vp_=vp0+sl_prev; \
    VRD(0); SBAR(); float sacc=(P0[0]+P0[1]); \
    GAPA(C0=__builtin_amdgcn_mfma_f32_32x32x16_bf16(kf[0],qr[0],(f32x16{}),0,0,0), P0[2],P0[3],P0[4],P0[5],     pw0[0]=PKW(P0,0), pw0[1]=PKW(P0,2), pw0); \
    VRD(4); SBAR(); GAPA(C1=__builtin_amdgcn_mfma_f32_32x32x16_bf16(kf[1],qr[0],(f32x16{}),0,0,0), P0[6],P0[7],P0[8],P0[9],     pw0[2]=PKW(P0,4), pw0[3]=PKW(P0,6), pw0); \
    VRD(1); SBAR(); GAPA(C0=__builtin_amdgcn_mfma_f32_32x32x16_bf16(kf[2],qr[1],C0,0,0,0),   P0[10],P0[11],P0[12],P0[13], pw1[0]=PKW(P0,8), pw1[1]=PKW(P0,10), pw1); \
    VRD(5); SBAR(); GAPA(C1=__builtin_amdgcn_mfma_f32_32x32x16_bf16(kf[3],qr[1],C1,0,0,0),   P0[14],P0[15],P1[0],P1[1],   pw1[2]=PKW(P0,12),pw1[3]=PKW(P0,14), pw1); \
    VRD(2); SBAR(); GAPA(C0=__builtin_amdgcn_mfma_f32_32x32x16_bf16(kf[4],qr[2],C0,0,0,0),   P1[2],P1[3],P1[4],P1[5],     pw2[0]=PKW(P1,0), pw2[1]=PKW(P1,2), pw2); \
    VRD(6); SBAR(); GAPA(C1=__builtin_amdgcn_mfma_f32_32x32x16_bf16(kf[5],qr[2],C1,0,0,0),   P1[6],P1[7],P1[8],P1[9],     pw2[2]=PKW(P1,4), pw2[3]=PKW(P1,6), pw2); \
    VRD(3); SBAR(); GAPA(C0=__builtin_amdgcn_mfma_f32_32x32x16_bf16(kf[6],qr[3],C0,0,0,0),   P1[10],P1[11],P1[12],P1[13], pw3[0]=PKW(P1,8), pw3[1]=PKW(P1,10), pw3); \
    VRD(7); SBAR(); GAPA(C1=__builtin_amdgcn_mfma_f32_32x32x16_bf16(kf[7],qr[3],C1,0,0,0),   P1[14],P1[15],0.f,0.f,       pw3[2]=PKW(P1,12),pw3[3]=PKW(P1,14), pw3); \
    l_reg+=sacc; \
    if(GK){DMA_K((t)+3,sl_cur);} if(GV){DMA_V((t)+1,sl_next);} \
    CMASK(C0,C1,t); \
    { float a=MX3(C0[0],C0[1],C1[0]),b=MX3(C0[2],C0[3],C1[1]); a=MX3(a,C1[2],C1[3]); \
      _Pragma("unroll") for(int r=4;r<16;r+=4){a=MX3(a,C0[r],C0[r+1]);b=MX3(b,C0[r+2],C0[r+3]);a=MX3(a,C1[r],C1[r+1]);b=MX3(b,C1[r+2],C1[r+3]);} \
      float rm=__builtin_fmaxf(a,b); { auto rr=__builtin_amdgcn_permlane32_swap(__float_as_uint(rm),__float_as_uint(rm),false,false); rm=__builtin_fmaxf(__uint_as_float(rr[0]),__uint_as_float(rr[1])); } \
      resc=false; \
      if(__builtin_expect(__any(rm>(float)THRL),0)){ const float dl=__builtin_fmaxf(rm,0.f); mhat+=dl; \
        _Pragma("unroll") for(int r=0;r<16;++r){C0[r]-=dl;C1[r]-=dl;} \
        const float f=__builtin_amdgcn_exp2f(-dl); l_reg*=f; if(hi==0)wsf[r32]=f; resc=true; } } \
    SBAR(); \
    GAPB(o[0]=__builtin_amdgcn_mfma_f32_32x32x16_bf16(PAF(0),VFR(0),o[0],0,0,0), C0,0); \
    GAPB(o[1]=__builtin_amdgcn_mfma_f32_32x32x16_bf16(PAF(0),VFR(4),o[1],0,0,0), C0,4); \
    KRD(GL,0); GAPB(o[0]=__builtin_amdgcn_mfma_f32_32x32x16_bf16(PAF(1),VFR(1),o[0],0,0,0), C0,8); \
    KRD(GL,1); GAPB(o[1]=__builtin_amdgcn_mfma_f32_32x32x16_bf16(PAF(1),VFR(5),o[1],0,0,0), C0,12); \
    KRD(GL,2); GAPB(o[0]=__builtin_amdgcn_mfma_f32_32x32x16_bf16(PAF(2),VFR(2),o[0],0,0,0), C1,0); \
    KRD(GL,3); GAPB(o[1]=__builtin_amdgcn_mfma_f32_32x32x16_bf16(PAF(2),VFR(6),o[1],0,0,0), C1,4); \
    GAPB(o[0]=__builtin_amdgcn_mfma_f32_32x32x16_bf16(PAF(3),VFR(3),o[0],0,0,0), C1,8); \
    GAPB(o[1]=__builtin_amdgcn_mfma_f32_32x32x16_bf16(PAF(3),VFR(7),o[1],0,0,0), C1,12); \
    }while(0)
  int t=1;
  #undef CMASK
  #define CMASK(P0,P1,t) SELM(P0,P1,t)
  for(;t+5<NT;t+=2){
    STEP(pB0,pB1,pA0,pA1,t,true,true,true);     WAIT_BAR(2); RESC(); ROT();
    STEP(pA0,pA1,pB0,pB1,t+1,true,true,true);   WAIT_BAR(2); RESC(); ROT();
  }
  #undef CMASK
  #define CMASK(P0,P1,t) do{int jb_=(t)-(NT-4); if(jb_>=0){ const float bm_=-mhat; _Pragma("unroll") for(int r_=0;r_<16;++r_){P0[r_]+=bm_;P1[r_]+=bm_;} cmask(P0,P1,jb_,qrel,hi);} else SELM(P0,P1,t);}while(0)
  #define ENDW(tt) do{ if((tt)+3<NT){WAIT_BAR(2);} else if((tt)+2<NT){WAIT_BAR(1);} else {WAIT_BAR(0);} }while(0)
  for(;t+1<NT;t+=2){
    STEP(pB0,pB1,pA0,pA1,t,(t+3<NT),(t+1<NT),(t+1<NT));       ENDW(t);   RESC(); ROT();
    STEP(pA0,pA1,pB0,pB1,t+1,(t+4<NT),(t+2<NT),(t+2<NT));     ENDW(t+1); RESC(); ROT();
  }
  STEP(pB0,pB1,pA0,pA1,NT-1,false,false,false); RESC();
  { float sacc=pB0[0]+pB0[1]; _Pragma("unroll") for(int r=2;r<16;++r)sacc+=pB0[r]; _Pragma("unroll") for(int r=0;r<16;++r)sacc+=pB1[r]; l_reg+=sacc;
    pw0=(u32x4){PKW(pB0,0),PKW(pB0,2),PKW(pB0,4),PKW(pB0,6)};pw1=(u32x4){PKW(pB0,8),PKW(pB0,10),PKW(pB0,12),PKW(pB0,14)};pw2=(u32x4){PKW(pB1,0),PKW(pB1,2),PKW(pB1,4),PKW(pB1,6)};pw3=(u32x4){PKW(pB1,8),PKW(pB1,10),PKW(pB1,12),PKW(pB1,14)};
    SBAR(); pv(o,vb0+sl_cur,PAF(0),PAF(1),PAF(2),PAF(3)); }
  #undef PKW
  #undef PAF
  #undef VFR
  #undef PIN
  #undef MX3
  #undef GAPA
  #undef GAPB
  #undef EX
  #undef VRD
  #undef KRD
  #undef STEP
  #undef ENDW
  {auto rr=__builtin_amdgcn_permlane32_swap(__float_as_uint(l_reg),__float_as_uint(l_reg),false,false);l_reg=__uint_as_float(rr[0])+__uint_as_float(rr[1]);}
  if(hi==0)wsf[32+r32]=l_reg;asm volatile("s_waitcnt lgkmcnt(0)":::"memory");
  float rli[16];
  #pragma unroll
  for(int r=0;r<16;++r)rli[r]=__builtin_amdgcn_rcpf(wsf[32+crow(r,hi)]);
  bf16*Ow=O+(rowbase+q0+wid*QBLK)*OPITCH+h*D;
  { bf16*stg=(bf16*)(shm+LDS_OST)+wid*2048;
    #pragma unroll
    for(int r=0;r<16;++r){const int orow=crow(r,hi);
      #pragma unroll
      for(int d0=0;d0<2;++d0)stg[orow*64+d0*32+r32]=__float2bfloat16(o[d0][r]*rli[r]);}
    asm volatile("s_waitcnt lgkmcnt(0)":::"memory");
    #pragma unroll
    for(int i=0;i<4;++i){const int row=i*8+(lane>>3),ch=lane&7; const u32x4 v=*(const u32x4*)(stg+row*64+ch*8); ATTN_STORE16(Ow+(long)row*OPITCH+ch*8,v);
      float sq=0.f;
      #pragma unroll
      for(int e=0;e<4;++e){const float lo=__uint_as_float(v[e]<<16),hi_=__uint_as_float(v[e]&0xffff0000u); sq+=lo*lo+hi_*hi_;}
      sq+=shx(sq,1);sq+=shx(sq,2);sq+=shx(sq,4); if(ch==0)atomicAdd(ssq+rowbase+q0+wid*QBLK+row,sq);} }
  asm volatile("s_waitcnt lgkmcnt(0)\n\ts_barrier":::"memory");
  #undef DMA_K
  #undef DMA_V
  #undef CMASK
  #undef SELM
  #undef START
  #undef RESC
  #undef ROT
}
constexpr int ATTN_LDS_BYTES=LDS_BYTES;
struct AttnTensors { const bf16* Q; const bf16* K; const bf16* V; bf16* O; const float* kmsum; float* ssq; };
struct AttnUnit { int bh; int qb; };
struct StaticOrder {
  int vcu,G;
  __device__ __forceinline__ explicit StaticOrder(int grid,int vcu_):vcu(vcu_),G(grid){}
  __device__ __forceinline__ bool next(int i,AttnUnit&u)const{ const int k=vcu+i*G; if(k>=1024)return false; const int v=k&255,ii=k>>8,s=v&7; u.bh=(v>>3)+32*(ii>>1); u.qb=(ii&1)?s:15-s; return true; }
  __device__ __forceinline__ void a_ready(const AttnUnit&)const{}
  __device__ __forceinline__ void done(const AttnUnit&)const{}
};
template<class Sched,bool MOBA=true,int THRL=8> __device__ __forceinline__ void attn_phase(char*lds,const AttnTensors&T,const Sched&S){
  AttnUnit u;
  for(int i=0;S.next(i,u);++i){ S.a_ready(u); attn_unit<THRL,MOBA>(u.bh/NHEAD,u.bh%NHEAD,u.qb,T.Q,T.K,T.V,T.O,T.kmsum,T.ssq,lds); S.done(u); }
}
template<class Sched,bool MOBA=true,int THRL=8> __device__ __forceinline__ void attn_range(char*lds,const AttnTensors&T,const Sched&S,const int i0,const int i1){
  AttnUnit u;
  for(int i=i0;i<i1&&S.next(i,u);++i){ attn_unit<THRL,MOBA>(u.bh/NHEAD,u.bh%NHEAD,u.qb,T.Q,T.K,T.V,T.O,T.kmsum,T.ssq,lds); }
}
#undef SBAR
#undef WAIT_BAR
}

constexpr int NWAVES = 8;
constexpr int BATCH = 8, SEQ = 4096, T = BATCH * SEQ, DMODEL = 1024, DFF = 2816, NCHUNK = 16;
constexpr int DATTN = 512, DSSM = 1024, DCONV = 1536, NPROJ = 4112, DMIX = 1536, NHSSM = 16, DSTATE = 128;
constexpr size_t MiB = 1u << 20;
constexpr size_t WS_CTL = 0, WS_ACC = 1 * MiB, CTL_ZERO_BYTES = 2 * MiB;
constexpr size_t ACC_SSX1 = WS_ACC, ACC_SSX2 = WS_ACC + 128 * 1024, ACC_SSX3 = WS_ACC + 256 * 1024, ACC_SSA = WS_ACC + 384 * 1024, ACC_SSG = WS_ACC + 512 * 1024  , ACC_KM = WS_ACC + 768 * 1024  ;
constexpr size_t WS_SSX0 = 2 * MiB, WS_CS = 2 * MiB + 256 * 1024  , WS_DTRAW = 3 * MiB  , WS_DTH = 5 * MiB  , WS_ACSH = 7 * MiB;
constexpr size_t WS_W13 = 10 * MiB  , WS_W2 = 21 * MiB  , WS_WIN = 27 * MiB  , WS_WDT = 35 * MiB  , WS_WOUT = 36 * MiB  ;
constexpr size_t WS_XB = 48 * MiB;
constexpr size_t WS_XT = 112 * MiB;
constexpr size_t WS_R = 240 * MiB;
constexpr size_t WS_Q = WS_R, WS_K = WS_R + 32 * MiB, WS_V = WS_R + 64 * MiB, WS_Z = WS_R + 96 * MiB, WS_BT = WS_R + 160 * MiB;
constexpr size_t WS_S = 416 * MiB;
constexpr size_t WS_ST = WS_S, WS_SP = WS_S + 64 * MiB;
constexpr size_t WS_XA8 = 176 * MiB;
constexpr size_t WS_END = 512 * MiB;
constexpr size_t DO_OY = 0, DO_BC = 96 * MiB;
constexpr int CW_BAR = 4096;
constexpr int CW_PANEL = 16384;
constexpr int RING_OFF = 0, RING_BYTES = 131072, LDSCTL_OFF = RING_BYTES, MISC_OFF = LDSCTL_OFF + 320, TAB_OFF = LDSCTL_OFF + 1024  , LDS_BYTES = 147456;
static_assert(TAB_OFF + 8 * 384 * 4 <= LDS_BYTES, "LDS map");

#define GAS __attribute__((address_space(1)))
#define LAS __attribute__((address_space(3)))
typedef unsigned short bf16;
typedef unsigned v4u __attribute__((ext_vector_type(4)));
typedef float f32x4 __attribute__((ext_vector_type(4)));
typedef short bf16x8 __attribute__((ext_vector_type(8)));
typedef GAS unsigned gu32;
typedef GAS unsigned long long gu64;
#define RLX_AGENT __ATOMIC_RELAXED, __HIP_MEMORY_SCOPE_AGENT
#define LDS_WAIT() asm volatile("s_waitcnt lgkmcnt(0)" ::: "memory")
#define VM_WAIT() asm volatile("s_waitcnt vmcnt(0)" ::: "memory")
__device__ __forceinline__ unsigned long long rt() { return __builtin_amdgcn_s_memrealtime(); }
__device__ __forceinline__ unsigned f2bf(float f) { unsigned u = __builtin_bit_cast(unsigned, f); return (u + 0x7fffu + ((u >> 16) & 1u)) >> 16; }
__device__ __forceinline__ unsigned pk2(float lo, float hi) { return f2bf(lo) | (f2bf(hi) << 16); }

#define XB_TMO      128
#define XB_XCNT(j)  (256  + 64 * (j))
#define XB_XSUB(j)  (1280 + 64 * (j))
#define XB_XGEN(j)  (2304 + 64 * (j))
#define XB_TOP      3328
#define XB_TOPGEN   3392
#define XCD_BAR_WORDS 3456
#define XB_SPIN_CAP (1u << 18)

__device__ __forceinline__ unsigned xb_ld(unsigned* p)              { return __hip_atomic_load(p, __ATOMIC_RELAXED, __HIP_MEMORY_SCOPE_AGENT); }
__device__ __forceinline__ unsigned xb_add(unsigned* p, unsigned v) { return __hip_atomic_fetch_add(p, v, __ATOMIC_RELAXED, __HIP_MEMORY_SCOPE_AGENT); }
__device__ __forceinline__ unsigned xb_xcc_id() { return (unsigned)__builtin_amdgcn_s_getreg((3 << 11) | 20) & 0xFu; }
#define XB_SPIN(cond, bar) do { unsigned _sp = 0; while (cond) { __builtin_amdgcn_s_sleep(1); \
    if ((++_sp & 255u) == 0u) { if (xb_ld(&(bar)[XB_TMO])) break; if (_sp > XB_SPIN_CAP) { atomicAdd(&(bar)[XB_TMO], 1u); break; } } } } while (0)

struct XcdBarrier {
    unsigned* bar; unsigned x;
    volatile LAS unsigned* st;
};

__device__ __forceinline__ XcdBarrier xcd_barrier_post(unsigned* bar, volatile LAS unsigned* st) {
    XcdBarrier b; b.bar = bar; b.x = xb_xcc_id(); b.st = st;
    if (threadIdx.x == 0) (void)xb_add(&bar[XB_XCNT(b.x)], 1u);
    return b;
}
__device__ __forceinline__ void xcd_barrier_complete(unsigned* bar, unsigned x, unsigned& nloc, unsigned& nx) {
    const unsigned G = gridDim.x * gridDim.y * gridDim.z;
    unsigned sum, cnt, mine, sp = 0u;
    for (;;) {
        sum = 0u; cnt = 0u; mine = 0u;
#pragma unroll
        for (unsigned j = 0; j < 16; ++j) { const unsigned c = xb_ld(&bar[XB_XCNT(j)]); sum += c; cnt += (c > 0u) ? 1u : 0u; mine = (j == x) ? c : mine; }
        if (sum == G) break;
        __builtin_amdgcn_s_sleep(1);
        if ((++sp & 255u) == 0u) { if (xb_ld(&bar[XB_TMO])) break; if (sp > XB_SPIN_CAP) { atomicAdd(&bar[XB_TMO], 1u); break; } }
    }
    nloc = mine > 0u ? mine : 1u; nx = cnt > 0u ? cnt : 1u;
}

__device__ __forceinline__ void xcd_barrier(const XcdBarrier& b) {
    asm volatile("s_waitcnt vmcnt(0)" ::: "memory");
    __syncthreads();
    if (threadIdx.x == 0) {
        unsigned* bar = b.bar;
        __builtin_amdgcn_s_waitcnt(0);
        unsigned nloc = b.st[0], nx = b.st[1];
        if (nloc == 0u) { xcd_barrier_complete(bar, b.x, nloc, nx); b.st[0] = nloc; b.st[1] = nx; }
        const unsigned old = xb_add(&bar[XB_XSUB(b.x)], 1u);
        const unsigned gen = old / nloc;
        if (old + 1u == (gen + 1u) * nloc) {
            __builtin_amdgcn_fence(__ATOMIC_RELEASE, "agent");
            asm volatile("s_waitcnt vmcnt(0)" ::: "memory");
            const unsigned og = xb_add(&bar[XB_TOP], 1u);
            const unsigned tg = og / nx;
            if (og + 1u == (tg + 1u) * nx) xb_add(&bar[XB_TOPGEN], 1u);
            else XB_SPIN(xb_ld(&bar[XB_TOPGEN]) == tg, bar);
            __builtin_amdgcn_fence(__ATOMIC_ACQUIRE, "agent");
            xb_add(&bar[XB_XGEN(b.x)], 1u);
            asm volatile("s_waitcnt vmcnt(0)" ::: "memory");
        } else {
            XB_SPIN(xb_ld(&bar[XB_XGEN(b.x)]) == gen, bar);
            __builtin_amdgcn_fence(__ATOMIC_ACQUIRE, "agent");
            asm volatile("s_waitcnt vmcnt(0)" ::: "memory");
        }
    }
    __syncthreads();
}

typedef float f32x16 __attribute__((ext_vector_type(16)));
typedef unsigned u32x2v __attribute__((ext_vector_type(2)));
__device__ __forceinline__ float bf2f(unsigned short h) { return __uint_as_float(((unsigned)h) << 16); }
__device__ __forceinline__ unsigned pkbf(float lo, float hi) { return pg8::cvt_pk_bf16(lo, hi); }
__device__ __forceinline__ int crow(int r, int hi) { return (r & 3) + 8 * (r >> 2) + 4 * hi; }
__device__ __forceinline__ int perm16(int i) { return 8 * ((i & 7) >> 2) + 4 * (i >> 3) + (i & 3); }

struct Frame {
    LAS unsigned char* lds;
    volatile LAS unsigned* MISC;
    gu32* ctl;
    int tid, lane, wave, vcu, G;
    float* out; unsigned char* ws;
};
struct Args { const float* in[20]; float* out; unsigned char* ws; };
__device__ __forceinline__ const float* inp(int i) { const __attribute__((address_space(4))) Args* p = (const __attribute__((address_space(4))) Args*)__builtin_amdgcn_kernarg_segment_ptr(); asm volatile("" : "+s"(p)); return p->in[i]; }
__device__ __forceinline__ float wave_sum(float v) {
#pragma unroll
    for (int o = 1; o < 64; o <<= 1) v += shx(v, o);
    return v;
}

__device__ __forceinline__ void wconv_item(const float* W, int K, int N, int item, int mode, const float* gain, const float* gain2, bf16* dst, bf16* dst2, LAS float* scr, int lane) {
    const int nblk = (N + 31) / 32, kb = item / nblk, nb = item % nblk, k0 = 64 * kb, n0 = 32 * nb;
    const bool nok = (n0 + (lane & 31)) < N;
    float wv_[32];
#pragma unroll
    for (int i = 0; i < 32; ++i) { const int kk = 2 * i + (lane >> 5); wv_[i] = nok ? ((const GAS float*)W)[(size_t)(k0 + kk) * N + n0 + (lane & 31)] : 0.f; }
#pragma unroll
    for (int i = 0; i < 32; ++i) { const int kk = 2 * i + (lane >> 5); scr[kk * 33 + (lane & 31)] = wv_[i]; }
    if (false)
    for (int i = 0; i < 32; ++i) { const int kk = 2 * i + (lane >> 5); scr[kk * 33 + (lane & 31)] = nok ? ((const GAS float*)W)[(size_t)(k0 + kk) * N + n0 + (lane & 31)] : 0.f; }
    LDS_WAIT(); asm volatile("" ::: "memory");
    const int c = lane & 7;
    float gv[8];
#pragma unroll
    for (int e = 0; e < 8; ++e) gv[e] = 1.0f;
    if (gain) {
        const int kb8 = k0 + 8 * c; const GAS float* gp = (gain2 && kb8 >= 512) ? (const GAS float*)gain2 + (kb8 - 512) : (const GAS float*)gain + kb8;
        const f32x4 g0 = *(const GAS f32x4*)gp, g1 = *(const GAS f32x4*)(gp + 4);
        gv[0] = g0.x; gv[1] = g0.y; gv[2] = g0.z; gv[3] = g0.w; gv[4] = g1.x; gv[5] = g1.y; gv[6] = g1.z; gv[7] = g1.w; }
#pragma unroll
    for (int j = 0; j < 4; ++j) { const int nl = (lane >> 3) + 8 * j, n = n0 + nl; const LAS float* s = scr + (8 * c) * 33 + nl;
        v4u o; o.x = pkbf(s[0 * 33] * gv[0], s[1 * 33] * gv[1]); o.y = pkbf(s[2 * 33] * gv[2], s[3 * 33] * gv[3]); o.z = pkbf(s[4 * 33] * gv[4], s[5 * 33] * gv[5]); o.w = pkbf(s[6 * 33] * gv[6], s[7 * 33] * gv[7]);
        bf16* d = dst; int nr = n;
        if (mode == 1) nr = 256 * (n >> 7) + (n & 127); else if (mode == 2) nr = 256 * (n >> 7) + 128 + (n & 127); else if (mode == 3 && n >= 4096) { d = dst2; nr = n - 4096; }
        if (n < N) *(GAS v4u*)(d + (size_t)nr * K + k0 + 8 * c) = o; }
    LDS_WAIT(); asm volatile("" ::: "memory");
}
__device__ __forceinline__ void wconv_item8(const float* W, int K, int N, int item, int mode, const float* gain, float scale, unsigned char* dst, LAS float* scr, int lane) {
    const int nblk = N / 32, kb = item / nblk, nb = item % nblk, k0 = 64 * kb, n0 = 32 * nb;
    float wv_[32];
#pragma unroll
    for (int i = 0; i < 32; ++i) { const int kk = 2 * i + (lane >> 5); wv_[i] = ((const GAS float*)W)[(size_t)(k0 + kk) * N + n0 + (lane & 31)]; }
#pragma unroll
    for (int i = 0; i < 32; ++i) { const int kk = 2 * i + (lane >> 5); scr[kk * 33 + (lane & 31)] = wv_[i]; }
    LDS_WAIT(); asm volatile("" ::: "memory");
    const int c = lane & 7;
    float gv[8];
#pragma unroll
    for (int e = 0; e < 8; ++e) gv[e] = scale;
    if (gain) { const GAS float* gp = (const GAS float*)gain + k0 + 8 * c; const f32x4 g0 = *(const GAS f32x4*)gp, g1 = *(const GAS f32x4*)(gp + 4);
        gv[0] *= g0.x; gv[1] *= g0.y; gv[2] *= g0.z; gv[3] *= g0.w; gv[4] *= g1.x; gv[5] *= g1.y; gv[6] *= g1.z; gv[7] *= g1.w; }
#pragma unroll
    for (int j = 0; j < 4; ++j) { const int nl = (lane >> 3) + 8 * j, n = n0 + nl; const LAS float* s = scr + (8 * c) * 33 + nl;
        pg8::u32x2 o; o.x = pg8::cvt4_fp8(s[0 * 33] * gv[0], s[1 * 33] * gv[1], s[2 * 33] * gv[2], s[3 * 33] * gv[3]); o.y = pg8::cvt4_fp8(s[4 * 33] * gv[4], s[5 * 33] * gv[5], s[6 * 33] * gv[6], s[7 * 33] * gv[7]);
        int nr = n; if (mode == 1) nr = 256 * (n >> 7) + (n & 127); else if (mode == 2) nr = 256 * (n >> 7) + 128 + (n & 127);
        *(GAS pg8::u32x2*)(dst + (size_t)nr * K + k0 + 8 * c) = o; }
    LDS_WAIT(); asm volatile("" ::: "memory");
}
constexpr int FP8_SB13 = 5, FP8_SB2 = 6;
__device__ __forceinline__ void ffn_weights8(Frame& F, const float* w1, const float* w3, const float* w2, const float* gain, int gw, int NGW, LAS float* scr) {
    constexpr int I13 = (DMODEL / 64) * (DFF / 32), I2 = (DFF / 64) * (DMODEL / 32);
    unsigned char* W13 = F.ws + WS_W13; unsigned char* W2 = F.ws + WS_W2;
    for (int it = gw; it < 2 * I13 + I2; it += NGW) {
        int r = it;
        if (r < I13) { wconv_item8(w1, DMODEL, DFF, r, 1, gain, (float)(1 << FP8_SB13), W13, scr, F.lane); continue; } r -= I13;
        if (r < I13) { wconv_item8(w3, DMODEL, DFF, r, 2, gain, (float)(1 << FP8_SB13), W13, scr, F.lane); continue; } r -= I13;
        wconv_item8(w2, DFF, DMODEL, r, 0, nullptr, (float)(1 << FP8_SB2), W2, scr, F.lane);
    }
}
__device__ __forceinline__ void ffn_weights(Frame& F, const float* w1, const float* w3, const float* w2, const float* gain, int gw, int NGW, LAS float* scr) {
    constexpr int I13 = (DMODEL / 64) * (DFF / 32), I2 = (DFF / 64) * (DMODEL / 32);
    bf16* W13 = (bf16*)(F.ws + WS_W13); bf16* W2 = (bf16*)(F.ws + WS_W2);
    for (int it = gw; it < 2 * I13 + I2; it += NGW) {
        int r = it;
        if (r < I13) { wconv_item(w1, DMODEL, DFF, r, 1, gain, nullptr, W13, nullptr, scr, F.lane); continue; } r -= I13;
        if (r < I13) { wconv_item(w3, DMODEL, DFF, r, 2, gain, nullptr, W13, nullptr, scr, F.lane); continue; } r -= I13;
        wconv_item(w2, DFF, DMODEL, r, 0, nullptr, nullptr, W2, nullptr, scr, F.lane);
    }
}

__device__ __forceinline__ void ffn_weights_sel(Frame& F, const float* w1, const float* w3, const float* w2, const float* gain, int gw, int NGW, LAS float* scr, bool up8, bool dn8) {
    constexpr int I13 = (DMODEL / 64) * (DFF / 32), I2 = (DFF / 64) * (DMODEL / 32);
    for (int it = gw; it < 2 * I13 + I2; it += NGW) {
        int r = it;
        if (r < 2 * I13) { const bool third = r >= I13; const int rr = third ? r - I13 : r; const float* w = third ? w3 : w1;
            if (up8) wconv_item8(w, DMODEL, DFF, rr, third ? 2 : 1, gain, (float)(1 << FP8_SB13), F.ws + WS_W13, scr, F.lane);
            else wconv_item(w, DMODEL, DFF, rr, third ? 2 : 1, gain, nullptr, (bf16*)(F.ws + WS_W13), nullptr, scr, F.lane);
            continue; }
        r -= 2 * I13;
        if (dn8) wconv_item8(w2, DFF, DMODEL, r, 0, nullptr, (float)(1 << FP8_SB2), F.ws + WS_W2, scr, F.lane);
        else wconv_item(w2, DFF, DMODEL, r, 0, nullptr, nullptr, (bf16*)(F.ws + WS_W2), nullptr, scr, F.lane);
    }
}
__device__ __forceinline__ void p0_prologue(Frame& F) {
    LAS float* scr = (LAS float*)(F.lds + RING_OFF + F.wave * 16384);
    const int gw = F.vcu * NWAVES + F.wave, NGW = F.G * NWAVES;
    ffn_weights_sel(F, inp(2), inp(3), inp(4), inp(1), gw, NGW, scr, MK_FP8_FFN1 == 1 || MK_FP8_FFN1 == 2, MK_FP8_FFN1 == 1 || MK_FP8_FFN1 == 3);
    {
        constexpr int IIN = (DMODEL / 64) * ((NPROJ + 31) / 32), IOUT = (DMIX / 64) * (DMODEL / 32);
        for (int it = gw; it < IIN + IOUT; it += NGW) {
            if (it < IIN) wconv_item(inp(6), DMODEL, NPROJ, it, 3, inp(5), nullptr, (bf16*)(F.ws + WS_WIN), (bf16*)(F.ws + WS_WDT), scr, F.lane);
            else wconv_item(inp(14), DMIX, DMODEL, it - IIN, 0, inp(12), inp(13), (bf16*)(F.ws + WS_WOUT), nullptr, scr, F.lane);
        }
    }
    {
        float* cs = (float*)(F.ws + WS_CS);
        for (int i = (F.vcu * NWAVES * 64) + F.tid; i < SEQ * 8; i += F.G * NWAVES * 64) {
            const int pos = i >> 3, k = i & 7;
            const float inv = powf(500000.0f, -(float)k * 0.125f), ang = (float)pos * inv;
            cs[pos * 16 + k] = cosf(ang); cs[pos * 16 + 8 + k] = sinf(ang);
        }
    }
    {
        const float* x = inp(0); bf16* XB = (bf16*)(F.ws + WS_XB); float* ss0 = (float*)(F.ws + WS_SSX0);
        f32x4 v[4][4], nv[4][4];
#define P0_LOAD(dst, mm0) do { _Pragma("unroll") for (int r_ = 0; r_ < 4; ++r_) { const int m_ = (mm0) + r_ * NGW; const GAS f32x4* xr_ = (const GAS f32x4*)(x + (size_t)(m_ < T ? m_ : 0) * DMODEL) + F.lane; \
            _Pragma("unroll") for (int j_ = 0; j_ < 4; ++j_) dst[r_][j_] = xr_[64 * j_]; } } while (0)
        if (gw < T) P0_LOAD(v, gw);
        for (int m0 = gw; m0 < T; m0 += 4 * NGW) {
            const bool more = (m0 + 4 * NGW) < T;
            if (more) P0_LOAD(nv, m0 + 4 * NGW);
#pragma unroll
            for (int r = 0; r < 4; ++r) { const int m = m0 + r * NGW; if (m < T) { float s = 0.f;
#pragma unroll
                for (int j = 0; j < 4; ++j) s += (v[r][j].x * v[r][j].x + v[r][j].y * v[r][j].y) + (v[r][j].z * v[r][j].z + v[r][j].w * v[r][j].w);
                s = wave_sum(s);
                if (F.lane == 0) ss0[m] = s;
                GAS unsigned long long* o8 = (GAS unsigned long long*)(XB + (size_t)m * DMODEL) + F.lane;
#pragma unroll
                for (int j = 0; j < 4; ++j) o8[64 * j] = (unsigned long long)pkbf(v[r][j].x, v[r][j].y) | ((unsigned long long)pkbf(v[r][j].z, v[r][j].w) << 32);
#if MK_FP8_FFN1
                GAS unsigned* o4 = (GAS unsigned*)(F.ws + WS_XA8 + (size_t)m * DMODEL) + F.lane;
#pragma unroll
                for (int j = 0; j < 4; ++j) o4[64 * j] = pg8::cvt4_fp8(v[r][j].x, v[r][j].y, v[r][j].z, v[r][j].w);
#endif
            } }
            if (more) {
#pragma unroll
                for (int r = 0; r < 4; ++r)
#pragma unroll
                    for (int j = 0; j < 4; ++j) v[r][j] = nv[r][j]; }
        }
#undef P0_LOAD
    }
}

__device__ __forceinline__ void dt_proj(Frame& F) {
    const int gw = F.vcu * NWAVES + F.wave, NGW = F.G * NWAVES;
    const bf16* XB = (const bf16*)(F.ws + WS_XB); const bf16* Wdt = (const bf16*)(F.ws + WS_WDT); const float* ss1 = (const float*)(F.ws + ACC_SSX1); float* dtr = (float*)(F.ws + WS_DTRAW);
    const int fr = F.lane & 15, fq = F.lane >> 4;
    for (int it = gw; it < T / 16; it += NGW) {
        const int row0 = it * 16;
        f32x4 a0 = {0.f, 0.f, 0.f, 0.f}, a1 = {0.f, 0.f, 0.f, 0.f};
        const bf16* ap0 = XB + (size_t)(row0 + fr) * DMODEL + 8 * fq; const bf16* bp = Wdt + (size_t)fr * DMODEL + 8 * fq;
#pragma unroll 8
        for (int k = 0; k < DMODEL; k += 64) {
            const bf16x8 b0 = *(const GAS bf16x8*)(bp + k), x0 = *(const GAS bf16x8*)(ap0 + k), b1 = *(const GAS bf16x8*)(bp + k + 32), x1 = *(const GAS bf16x8*)(ap0 + k + 32);
            a0 = __builtin_amdgcn_mfma_f32_16x16x32_bf16(x0, b0, a0, 0, 0, 0);
            a1 = __builtin_amdgcn_mfma_f32_16x16x32_bf16(x1, b1, a1, 0, 0, 0);
        }
#pragma unroll
        for (int r = 0; r < 4; ++r) { const int t0 = row0 + 4 * fq + r; dtr[(size_t)t0 * 16 + fr] = (a0[r] + a1[r]) * rsqrtf(ss1[t0] * (1.0f / 1024.0f) + pg8::RMS_EPS); }
    }
}
__device__ __forceinline__ void glds16(const void* gsrc, LAS unsigned char* ldst) { __builtin_amdgcn_global_load_lds((const GAS unsigned*)gsrc, (LAS unsigned*)ldst, 16, 0, 0); }
template <class TT> __device__ __forceinline__ TT ldu(const void* ubase, unsigned voff) { return *(const GAS TT*)((const GAS char*)ubase + voff); }
#define LDS_BAR() asm volatile("s_waitcnt lgkmcnt(0)\n\ts_barrier" ::: "memory")
__device__ __forceinline__ void p4_conv(Frame& F, const int j0 = 0, const int j1 = 1 << 20) {
    const bf16* XBC = (const bf16*)(F.ws + WS_S); bf16* XT = (bf16*)(F.ws + WS_XT); bf16* BT = (bf16*)(F.ws + WS_BT); bf16* BC = (bf16*)((unsigned char*)F.out + DO_BC);
    const float* cw = inp(7); const float* cbias = inp(8);
    LAS bf16* U = (LAS bf16*)(F.lds + RING_OFF);
    LAS bf16* Vt = (LAS bf16*)(F.lds + RING_OFF + 34816);
    const int tid = F.tid;
    v4u pre[5];
#define P4_FETCH(uu) do { const int bc_ = (uu) / 24, cb_ = (uu) % 24, c_ = bc_ & 15, t0_ = bc_ * 256, ch0_ = cb_ * 64; \
        _Pragma("unroll") for (int k_ = 0; k_ < 5; ++k_) { const int i_ = tid + 512 * k_, rr_ = i_ >> 3, ck_ = i_ & 7; pre[k_] = (v4u){0u, 0u, 0u, 0u}; \
            if (i_ < 259 * 8 && !(c_ == 0 && rr_ < 3)) pre[k_] = *(const GAS v4u*)(XBC + (size_t)(t0_ - 3 + rr_) * DCONV + ch0_ + ck_ * 8); } } while (0)
    const int uend = (j1 >= (1 << 20)) ? 128 * 24 : min(128 * 24, F.vcu + j1 * (int)F.G);
    if (F.vcu + j0 * (int)F.G < uend) P4_FETCH(F.vcu + j0 * (int)F.G);
    for (int u = F.vcu + j0 * (int)F.G; u < uend; u += F.G) {
        const int bc = u / 24, cb = u % 24, t0 = bc * 256, ch0 = cb * 64;
#pragma unroll
        for (int k = 0; k < 5; ++k) { const int i = tid + 512 * k; if (i < 259 * 8) *(LAS v4u*)(U + (i >> 3) * 64 + (i & 7) * 8) = pre[k]; }
        const int ch_ = tid & 63, cg_ = ch0 + ch_;
        float w0 = cw[cg_], w1 = cw[DCONV + cg_], w2 = cw[2 * DCONV + cg_], w3 = cw[3 * DCONV + cg_], bb = cbias[cg_];
        asm volatile("" : "+v"(w0), "+v"(w1), "+v"(w2), "+v"(w3), "+v"(bb));
        LDS_BAR();
        if (u + F.G < uend) P4_FETCH(u + F.G);
        {   const int ch = tid & 63, tg = tid >> 6;
            float u0 = bf2f(U[(32 * tg) * 64 + ch]), u1 = bf2f(U[(32 * tg + 1) * 64 + ch]), u2 = bf2f(U[(32 * tg + 2) * 64 + ch]);
#pragma unroll 8
            for (int t = 32 * tg; t < 32 * tg + 32; ++t) {
                const float u3 = bf2f(U[(t + 3) * 64 + ch]);
                const float a = bb + w0 * u0 + w1 * u1 + w2 * u2 + w3 * u3;
                const float s = pg8::silu_f(a);
                Vt[t * 72 + ch] = (bf16)(pkbf(s, 0.f) & 0xffffu);
                u0 = u1; u1 = u2; u2 = u3;
            } }
        LDS_BAR();
        if (cb < 20) {
            bf16* dstT = cb < 16 ? XT + (size_t)((bc * 16 + cb) * 2) * 16 * 512 : BT + (size_t)(((bc * 2 + ((cb - 16) >> 1)) * 4 + ((cb - 16) & 1) * 2)) * 16 * 512;
#pragma unroll 1
            for (int j = 0; j < 4; ++j) { const int it = tid + 512 * j, r = it & 31, h = (it >> 5) & 1, kst = (it >> 6) & 15, pt = it >> 10, ch = 32 * pt + r;
                unsigned short e[8];
#pragma unroll
                for (int k = 0; k < 8; ++k) { const int tok = 16 * kst + perm16(8 * h + k); e[k] = Vt[tok * 72 + ch]; }
                v4u o; o.x = e[0] | ((unsigned)e[1] << 16); o.y = e[2] | ((unsigned)e[3] << 16); o.z = e[4] | ((unsigned)e[5] << 16); o.w = e[6] | ((unsigned)e[7] << 16);
                *(GAS v4u*)(dstT + ((size_t)(pt * 16 + kst) * 64 + h * 32 + r) * 8) = o; }
        }
        if (cb >= 16) {
            const int which = (cb - 16) >> 2, gg = ((cb - 16) >> 1) & 1, nh = (cb - 16) & 1;
            bf16* dstF = BC + (size_t)(((bc * 2 + gg) * 2 + which) * 64) * 512;
#pragma unroll 1
            for (int j = 0; j < 4; ++j) { const int it = tid + 512 * j, r = it & 31, h = (it >> 5) & 1, ksl = (it >> 6) & 3, tile = it >> 8;
                const v4u v = *(const LAS v4u*)(Vt + (32 * tile + r) * 72 + (2 * ksl + h) * 8);
                *(GAS v4u*)(dstF + ((size_t)(tile * 8 + 4 * nh + ksl) * 64 + h * 32 + r) * 8) = v; }
        }
        LDS_BAR();
    }
#undef P4_FETCH
}
__device__ __forceinline__ void p4_misc(Frame& F) {
    const int tid = F.tid; (void)tid;
    {   const int gw = F.vcu * NWAVES + F.wave, NGW = F.G * NWAVES;
        const float* dtr = (const float*)(F.ws + WS_DTRAW); float* dtH = (float*)(F.ws + WS_DTH); float* acsH = (float*)(F.ws + WS_ACSH);
        for (int it = gw; it < 128 * 16; it += NGW) {
            const int bc = it >> 4, hh = it & 15, b = bc >> 4, c = bc & 15;
            const float A = -__expf(inp(10)[hh]), bias = inp(9)[hh];
            f32x4 d, a; float run = 0.f;
            float xr_[4];
#pragma unroll
            for (int i = 0; i < 4; ++i) xr_[i] = ((const GAS float*)dtr)[(size_t)(bc * 256 + 4 * F.lane + i) * 16 + hh];
#pragma unroll
            for (int i = 0; i < 4; ++i) { const float x = xr_[i] + bias; const float sp = x > 20.f ? x : log1pf(__expf(x)); d[i] = sp; run += sp * A; a[i] = run; }
            float inc = run;
#pragma unroll
            for (int o = 1; o < 64; o <<= 1) { const float v = __shfl_up(inc, o); if (F.lane >= o) inc += v; }
            const float excl = inc - run;
#pragma unroll
            for (int i = 0; i < 4; ++i) a[i] += excl;
            const size_t off = (size_t)(b * 16 + hh) * SEQ + c * 256 + 4 * F.lane;
            *(GAS f32x4*)(dtH + off) = d; *(GAS f32x4*)(acsH + off) = a;
        }
#if MK_FP8
        ffn_weights8(F, inp(16), inp(17), inp(18), inp(15), gw, NGW, (LAS float*)(F.lds + RING_OFF + F.wave * 16384));
#else
        ffn_weights(F, inp(16), inp(17), inp(18), inp(15), gw, NGW, (LAS float*)(F.lds + RING_OFF + F.wave * 16384));
#endif
    }
}

__device__ __forceinline__ void ssd_states(Frame& F) {
    const bf16* XT = (const bf16*)(F.ws + WS_XT); const bf16* BT = (const bf16*)(F.ws + WS_BT); const float* dtH = (const float*)(F.ws + WS_DTH); const float* acsH = (const float*)(F.ws + WS_ACSH);
    float* ST = (float*)(F.ws + WS_ST);
    LAS unsigned char* L = F.lds + RING_OFF;
    const int lane = F.lane, w = F.wave, r32 = lane & 31, hi = lane >> 5;
    const unsigned o_f = (unsigned)lane * 16u;
    LAS float* dec = (LAS float*)(L + 65536 + w * 2048);
    for (int u = F.vcu; u < 256; u += F.G) {
        const int bc = u >> 1, g = u & 1, b = bc >> 4, c = bc & 15, hh = g * 8 + w;
        {   int ln0 = lane; asm volatile("" : "+v"(ln0));
            const bf16* BTu = BT + (size_t)((bc * 2 + g) * 4) * 16 * 512;
#pragma unroll
            for (int i = 0; i < 8; ++i) { const int f = w * 8 + i; glds16(BTu + (size_t)f * 512 + ln0 * 8, L + f * 1024); }
            const size_t o = (size_t)(b * 16 + hh) * SEQ + c * 256 + 4 * ln0;
            const f32x4 a4 = *(const GAS f32x4*)(acsH + o), d4 = *(const GAS f32x4*)(dtH + o);
            *(LAS f32x4*)(dec + 4 * ln0) = a4; *(LAS f32x4*)(dec + 256 + 4 * ln0) = d4;
            VM_WAIT(); LDS_WAIT(); __syncthreads(); }
        const float alast = dec[255];
        const bf16* xt = XT + (size_t)((bc * 16 + hh) * 2) * 16 * 512;
        f32x16 acc[2][4];
#pragma unroll
        for (int i = 0; i < 2; ++i)
#pragma unroll
            for (int j = 0; j < 4; ++j) acc[i][j] = f32x16{};
#pragma unroll 1
        for (int half = 0; half < 2; ++half) {
            bf16x8 xv[8][2];
#pragma unroll
            for (int k = 0; k < 8; ++k)
#pragma unroll
                for (int pt = 0; pt < 2; ++pt) xv[k][pt] = ldu<bf16x8>(xt + (size_t)(pt * 16 + 8 * half + k) * 512, o_f);
#pragma unroll
            for (int k = 0; k < 8; ++k) {
                const int ks = 8 * half + k;
                const f32x4 a0 = *(const LAS f32x4*)(dec + 16 * ks + 4 * hi), a1 = *(const LAS f32x4*)(dec + 16 * ks + 8 + 4 * hi);
                const f32x4 d0 = *(const LAS f32x4*)(dec + 256 + 16 * ks + 4 * hi), d1 = *(const LAS f32x4*)(dec + 256 + 16 * ks + 8 + 4 * hi);
                float wv[8];
#pragma unroll
                for (int j = 0; j < 4; ++j) { wv[j] = __expf(alast - a0[j]) * d0[j]; wv[4 + j] = __expf(alast - a1[j]) * d1[j]; }
                bf16x8 af[2];
#pragma unroll
                for (int pt = 0; pt < 2; ++pt) { const bf16x8 x = xv[k][pt];
                    v4u o; o.x = pkbf(bf2f(x[0]) * wv[0], bf2f(x[1]) * wv[1]); o.y = pkbf(bf2f(x[2]) * wv[2], bf2f(x[3]) * wv[3]); o.z = pkbf(bf2f(x[4]) * wv[4], bf2f(x[5]) * wv[5]); o.w = pkbf(bf2f(x[6]) * wv[6], bf2f(x[7]) * wv[7]);
                    af[pt] = __builtin_bit_cast(bf16x8, o); }
#pragma unroll
                for (int nt = 0; nt < 4; ++nt) { const bf16x8 bv = *(const LAS bf16x8*)(L + (nt * 16 + ks) * 1024 + lane * 16);
#pragma unroll
                    for (int pt = 0; pt < 2; ++pt) acc[pt][nt] = __builtin_amdgcn_mfma_f32_32x32x16_bf16(af[pt], bv, acc[pt][nt], 0, 0, 0); }
            }
        }
        GAS unsigned short* st = (GAS unsigned short*)ST + (size_t)(bc * 16 + hh) * 8192;
#pragma unroll
        for (int pt = 0; pt < 2; ++pt)
#pragma unroll
            for (int nt = 0; nt < 4; ++nt)
#pragma unroll
                for (int r = 0; r < 16; ++r) st[(32 * pt + crow(r, hi)) * 128 + 32 * nt + r32] = (unsigned short)(pkbf(acc[pt][nt][r], 0.f) & 0xffffu);
        __syncthreads();
    }
}

__device__ __forceinline__ void ssd_scan(Frame& F) {
    const float* ST = (const float*)(F.ws + WS_ST); bf16* SP = (bf16*)(F.ws + WS_SP); const float* acsH = (const float*)(F.ws + WS_ACSH);
    for (int gid = F.vcu * NWAVES * 64 + F.tid; gid < BATCH * 16 * 64 * 16; gid += F.G * NWAVES * 64) {
        const int n8 = gid & 15, p = (gid >> 4) & 63, hh = (gid >> 10) & 15, b = gid >> 14;
        float s[8];
#pragma unroll
        for (int j = 0; j < 8; ++j) s[j] = 0.f;
        const float* ap = acsH + (size_t)(b * 16 + hh) * SEQ + 255;
#pragma unroll 4
        for (int c = 0; c < NCHUNK; ++c) {
            const size_t off = (size_t)((b * 16 + c) * 16 + hh) * 8192 + p * 128 + n8 * 8;
            v4u o; o.x = pkbf(s[0], s[1]); o.y = pkbf(s[2], s[3]); o.z = pkbf(s[4], s[5]); o.w = pkbf(s[6], s[7]);
            *(GAS v4u*)(SP + ((size_t)(((b * 16 + c) * 16 + hh) * 2 + (p >> 5)) * 8 + (n8 >> 1)) * 512 + ((n8 & 1) * 32 + (p & 31)) * 8) = o;
            const float dec = __expf(ap[c * 256]);
            const v4u xs = *(const GAS v4u*)((const GAS unsigned short*)ST + off);
#pragma unroll
            for (int j = 0; j < 4; ++j) { s[2 * j] = dec * s[2 * j] + __uint_as_float(xs[j] << 16); s[2 * j + 1] = dec * s[2 * j + 1] + __uint_as_float(xs[j] & 0xffff0000u); }
        }
    }
}

__device__ __forceinline__ float reduce16x32(const float (&v)[16], int r32) {
    float a[8], b[4], c2[2];
    const bool b4 = r32 & 16, b3 = r32 & 8, b2 = r32 & 4, b1 = r32 & 2;
#pragma unroll
    for (int k = 0; k < 8; ++k) { const float keep = b4 ? v[8 + k] : v[k], send = b4 ? v[k] : v[8 + k]; a[k] = keep + shx(send, 16); }
#pragma unroll
    for (int k = 0; k < 4; ++k) { const float keep = b3 ? a[4 + k] : a[k], send = b3 ? a[k] : a[4 + k]; b[k] = keep + shx(send, 8); }
#pragma unroll
    for (int k = 0; k < 2; ++k) { const float keep = b2 ? b[2 + k] : b[k], send = b2 ? b[k] : b[2 + k]; c2[k] = keep + shx(send, 4); }
    const float keep = b1 ? c2[1] : c2[0], send = b1 ? c2[0] : c2[1];
    float d = keep + shx(send, 2);
    d += shx(d, 1);
    return d;
}
__device__ __forceinline__ float ssd_tile_out(const f32x16 (&y)[2], const u32x2v (&zq)[2][4], bf16* Ot, int r32_, int hi_) {
    int r32 = r32_, hi = hi_; asm volatile("" : "+v"(r32), "+v"(hi));
    const unsigned oo = (unsigned)(r32 * 1536 + 4 * hi) * 2u;
    float ssq = 0.f;
#pragma unroll
    for (int pt = 0; pt < 2; ++pt)
#pragma unroll
        for (int q = 0; q < 4; ++q) { const int p0 = 32 * pt + 8 * q;
            const u32x2v zz = zq[pt][q];
            const float v0 = y[pt][4 * q] * pg8::silu_f(__uint_as_float(zz.x << 16)), v1 = y[pt][4 * q + 1] * pg8::silu_f(__uint_as_float(zz.x & 0xffff0000u));
            const float v2 = y[pt][4 * q + 2] * pg8::silu_f(__uint_as_float(zz.y << 16)), v3 = y[pt][4 * q + 3] * pg8::silu_f(__uint_as_float(zz.y & 0xffff0000u));
            ssq += (v0 * v0 + v1 * v1) + (v2 * v2 + v3 * v3);
            u32x2v o; o.x = pkbf(v0, v1); o.y = pkbf(v2, v3);
            *(GAS u32x2v*)((GAS char*)(Ot + p0) + oo) = o; }
    return ssq;
}
#ifdef MK_STAMP
#define P7_STAMP(k) do { if (blockIdx.x == 0 && threadIdx.x == 0) __hip_atomic_store((unsigned long long*)(F.ws + 9 * MiB + 512 * 1024) + 32 + (k), rt(), __ATOMIC_RELAXED, __HIP_MEMORY_SCOPE_AGENT); } while (0)
#else
#define P7_STAMP(k) do {} while (0)
#endif
__device__ __forceinline__ void ssd_out(Frame& F, float* ssg) {
    const bf16* XT = (const bf16*)(F.ws + WS_XT); const bf16* BC = (const bf16*)((const unsigned char*)F.out + DO_BC); const bf16* SP = (const bf16*)(F.ws + WS_SP);
    const bf16* Z = (const bf16*)(F.ws + WS_Z); bf16* OY = (bf16*)((unsigned char*)F.out + DO_OY);
    const float* dtH = (const float*)(F.ws + WS_DTH); const float* acsH = (const float*)(F.ws + WS_ACSH);
    LAS unsigned char* L = F.lds + RING_OFF;
    const int lane = F.lane, w = F.wave, r32 = lane & 31, hi = lane >> 5;
    const unsigned o_f = (unsigned)lane * 16u, o_a = (unsigned)(4 * hi) * 4u, o_l = (unsigned)r32 * 4u;
    const int ltA = w, ltB = 7 - w;
    for (int u = F.vcu; u < 256; u += F.G) {
        const int bc = u >> 1, g = u & 1, b = bc >> 4, c = bc & 15, t0 = bc * 256;
        const bf16* BCu = BC + (size_t)(((bc * 2 + g) * 2) * 64) * 512;
        {
            int ln0 = lane; asm volatile("" : "+v"(ln0));
#pragma unroll
            for (int i = 0; i < 16; ++i) { const int f = w * 16 + i; glds16(BCu + (size_t)f * 512 + ln0 * 8, L + f * 1024); }
            P7_STAMP(0); VM_WAIT(); __syncthreads(); P7_STAMP(1); }
        unsigned cbp[9][8];
#pragma unroll
        for (int t = 0; t < 9; ++t) {
            const int lt = t <= w ? ltA : ltB, st = t <= w ? t : t - w - 1;
            f32x16 cb = f32x16{};
#pragma unroll
            for (int ks = 0; ks < 8; ++ks) { const bf16x8 bv = *(const LAS bf16x8*)(L + (st * 8 + ks) * 1024 + lane * 16), cv = *(const LAS bf16x8*)(L + 65536 + (lt * 8 + ks) * 1024 + lane * 16);
                cb = __builtin_amdgcn_mfma_f32_32x32x16_bf16(bv, cv, cb, 0, 0, 0); }
#pragma unroll
            for (int k = 0; k < 8; ++k) cbp[t][k] = pkbf(cb[2 * k], cb[2 * k + 1]);
        }
        P7_STAMP(2);
        __syncthreads();
        P7_STAMP(3);
        const bf16* xtg = XT + (size_t)((bc * 16 + 8 * g) * 2) * 16 * 512;
#define XT_ISSUE(it, slotp) do { int ln_ = lane; asm volatile("" : "+v"(ln_)); _Pragma("unroll") for (int i_ = 0; i_ < 8; ++i_) { const int f_ = w * 8 + i_, hl_ = (f_ < 32 ? 0 : 4) + (it); \
            glds16(xtg + ((size_t)hl_ * 32 + (f_ & 31)) * 512 + ln_ * 8, (slotp) + f_ * 1024); } } while (0)
        float ssA = 0.f, ssB = 0.f;
        LAS float* DEC = (LAS float*)(F.lds + TAB_OFF);
#pragma unroll 1
        for (int it = 0; it < 4; ++it) {
            if (it > 0) __syncthreads();
            XT_ISSUE(it, L);
            {   const int ps = F.tid >> 8, ix = F.tid & 255; const size_t o = (size_t)(b * 16 + 8 * g + 4 * ps + it) * SEQ + c * 256 + ix;
                DEC[ps * 512 + ix] = acsH[o]; DEC[ps * 512 + 256 + ix] = dtH[o]; }
            if (it == 0) P7_STAMP(4);
            VM_WAIT(); LDS_WAIT(); __syncthreads();
            if (it == 0) P7_STAMP(5);
            int dl_ = 4 * hi - r32; asm volatile("" : "+v"(dl_));
#pragma unroll
            for (int pass = 0; pass < 2; ++pass) {
                int wl = w; asm volatile("" : "+s"(wl));
                const int lt = pass ? 7 - wl : wl, hh = 8 * g + 4 * pass + it;
                const LAS unsigned char* slot = L + pass * 32768;
                const LAS float* ap = DEC + pass * 512; const LAS float* dp = ap + 256;
                const float Dh = inp(11)[hh];
                const bf16* sp = SP + (size_t)((bc * 16 + hh) * 2) * 8 * 512;
                f32x16 y[2];
                u32x2v zq[2][4];
                {   const bf16* Zt = Z + (size_t)(t0 + 32 * lt) * 1024 + hh * 64; const unsigned oz = (unsigned)(r32 * 1024 + 4 * hi) * 2u;
#pragma unroll
                    for (int pt = 0; pt < 2; ++pt)
#pragma unroll
                        for (int q = 0; q < 4; ++q) zq[pt][q] = ldu<u32x2v>(Zt + 32 * pt + 8 * q, oz); }
                {
                    bf16x8 sv[2][8];
#pragma unroll
                    for (int pt = 0; pt < 2; ++pt)
#pragma unroll
                        for (int k = 0; k < 8; ++k) sv[pt][k] = ldu<bf16x8>(sp + (size_t)(pt * 8 + k) * 512, o_f);
#pragma unroll
                    for (int pt = 0; pt < 2; ++pt) {
                        f32x16 a = f32x16{};
#pragma unroll
                        for (int k = 0; k < 8; ++k) { const bf16x8 ca = *(const LAS bf16x8*)(L + 65536 + (lt * 8 + k) * 1024 + lane * 16); a = __builtin_amdgcn_mfma_f32_32x32x16_bf16(sv[pt][k], ca, a, 0, 0, 0); }
                        y[pt] = a;
                    }
                    asm volatile("" ::: "memory");
                }
                const float al = ap[32 * lt + r32];
                { const float ea = __expf(al); y[0] = y[0] * ea; y[1] = y[1] * ea; }
#pragma unroll
                for (int t = 0; t < 9; ++t) {
                    const bool mine = pass ? (t > wl) : (t <= wl);
                    if (mine) {
                        const int st = pass ? t - wl - 1 : t;
                        const bool diag = (st == lt);
#pragma unroll
                        for (int s2 = 0; s2 < 2; ++s2) {
                            float mv[8];
#pragma unroll
                            for (int q2 = 0; q2 < 2; ++q2) { const int q = 2 * s2 + q2;
                                const f32x4 as = *(const LAS f32x4*)(ap + 32 * st + 8 * q + 4 * hi), ds = *(const LAS f32x4*)(dp + 32 * st + 8 * q + 4 * hi);
                                float cbv[4];
#pragma unroll
                                for (int j = 0; j < 2; ++j) { unsigned pw = cbp[t][2 * q + j]; asm volatile("" : "+v"(pw));
                                    cbv[2 * j] = __uint_as_float(pw << 16); cbv[2 * j + 1] = __uint_as_float(pw & 0xffff0000u); }
#pragma unroll
                                for (int i = 0; i < 4; ++i) {
                                    float m = cbv[i] * __expf(al - as[i]) * ds[i];
                                    if (diag) { m = (dl_ > -(8 * q + i)) ? 0.f : m; m = (dl_ == -(8 * q + i)) ? m + Dh : m; }
                                    mv[4 * q2 + i] = m; } }
                            v4u o; o.x = pkbf(mv[0], mv[1]); o.y = pkbf(mv[2], mv[3]); o.z = pkbf(mv[4], mv[5]); o.w = pkbf(mv[6], mv[7]);
                            const bf16x8 mf = __builtin_bit_cast(bf16x8, o);
#pragma unroll
                            for (int pt = 0; pt < 2; ++pt) { const bf16x8 xv = *(const LAS bf16x8*)(slot + (pt * 16 + 2 * st + s2) * 1024 + lane * 16);
                                y[pt] = __builtin_amdgcn_mfma_f32_32x32x16_bf16(xv, mf, y[pt], 0, 0, 0); }
                        }
                        asm volatile("" ::: "memory");
                    }
                }
                const float s_ = ssd_tile_out(y, zq, OY + (size_t)(t0 + 32 * lt) * 1536 + 512 + hh * 64, r32, hi);
                if (pass) ssB += s_; else ssA += s_;
                if (it == 0) P7_STAMP(6 + pass);
                asm volatile("" ::: "memory");
            }
        }
#undef XT_ISSUE
        P7_STAMP(8);
        ssA = sum32(ssA); ssB = sum32(ssB);
        if (hi == 0) { atomicAdd(ssg + (size_t)(t0 + 32 * ltA + r32) * 2 + g, ssA); atomicAdd(ssg + (size_t)(t0 + 32 * ltB + r32) * 2 + g, ssB); }
        __syncthreads();
    }
}

__device__ __forceinline__ void final_norm(Frame& F) {
    const int gw = F.vcu * NWAVES + F.wave, NGW = F.G * NWAVES;
    const float* ss3 = (const float*)(F.ws + ACC_SSX3); const float* gn = inp(19); const bf16* XB = (const bf16*)(F.ws + WS_XB);
    f32x4 gv[4];
#pragma unroll
    for (int j = 0; j < 4; ++j) gv[j] = *(const GAS f32x4*)(gn + 4 * F.lane + 256 * j);
    u32x2v w[4][4], nw[4][4]; float rs[4], nrs[4];
#define P11_LOAD(dw, drs, mm0) do { _Pragma("unroll") for (int r_ = 0; r_ < 4; ++r_) { const int m_ = (mm0) + r_ * NGW, mc_ = m_ < T ? m_ : 0; const GAS u32x2v* xb_ = (const GAS u32x2v*)(XB + (size_t)mc_ * DMODEL) + F.lane; \
        _Pragma("unroll") for (int j_ = 0; j_ < 4; ++j_) dw[r_][j_] = xb_[64 * j_]; drs[r_] = ss3[mc_]; } } while (0)
    if (gw < T) P11_LOAD(w, rs, gw);
    for (int m0 = gw; m0 < T; m0 += 4 * NGW) {
        const bool more = (m0 + 4 * NGW) < T;
        if (more) P11_LOAD(nw, nrs, m0 + 4 * NGW);
#pragma unroll
        for (int r = 0; r < 4; ++r) { const int m = m0 + r * NGW; if (m < T) { GAS f32x4* xr = (GAS f32x4*)(F.out + (size_t)m * DMODEL) + F.lane;
            const float rr = rsqrtf(rs[r] * (1.0f / 1024.0f) + pg8::RMS_EPS);
#pragma unroll
            for (int j = 0; j < 4; ++j) { const f32x4 v = {__uint_as_float(w[r][j].x << 16), __uint_as_float(w[r][j].x & 0xffff0000u), __uint_as_float(w[r][j].y << 16), __uint_as_float(w[r][j].y & 0xffff0000u)}; xr[64 * j] = v * gv[j] * rr; } } }
        if (more) {
#pragma unroll
            for (int r = 0; r < 4; ++r) { rs[r] = nrs[r];
#pragma unroll
                for (int j = 0; j < 4; ++j) w[r][j] = nw[r][j]; } }
    }
#undef P11_LOAD
}

__device__ __forceinline__ void final_norm_panel(Frame& F, int pm) {
    const float* ss3 = (const float*)(F.ws + ACC_SSX3); const float* gn = inp(19); const bf16* XB = (const bf16*)(F.ws + WS_XB);
    f32x4 gv[4];
#pragma unroll
    for (int j = 0; j < 4; ++j) gv[j] = *(const GAS f32x4*)(gn + 4 * F.lane + 256 * j);
#pragma unroll 1
    for (int t = 0; t < 8; ++t) {
        u32x2v w[4][4]; float rs[4];
#pragma unroll
        for (int r = 0; r < 4; ++r) { const int m = pm * 256 + F.wave + 8 * (4 * t + r); const GAS u32x2v* xb = (const GAS u32x2v*)(XB + (size_t)m * DMODEL) + F.lane;
#pragma unroll
            for (int j = 0; j < 4; ++j) w[r][j] = xb[64 * j];
            rs[r] = ((const GAS float*)ss3)[m]; }
#pragma unroll
        for (int r = 0; r < 4; ++r) { const int m = pm * 256 + F.wave + 8 * (4 * t + r); GAS f32x4* xr = (GAS f32x4*)(F.out + (size_t)m * DMODEL) + F.lane;
            const float rr = rsqrtf(rs[r] * (1.0f / 1024.0f) + pg8::RMS_EPS);
#pragma unroll
            for (int j = 0; j < 4; ++j) { const f32x4 v = {__uint_as_float(w[r][j].x << 16), __uint_as_float(w[r][j].x & 0xffff0000u), __uint_as_float(w[r][j].y << 16), __uint_as_float(w[r][j].y & 0xffff0000u)}; xr[64 * j] = v * gv[j] * rr; } }
    }
}
#ifndef MK_DUP
#define MK_DUP 0
#endif
constexpr size_t WS_DUMMY = 9 * MiB;
#define DUPN(k) (((MK_DUP >> (k)) & 1) ? 2 : 1)
__global__ void __launch_bounds__(NWAVES * 64, 2) mk_fwd(Args args) {
    extern __shared__ __attribute__((aligned(16))) unsigned char lds[];
    Frame F;
    F.lds = (LAS unsigned char*)lds;
    F.MISC = (volatile LAS unsigned*)(F.lds + MISC_OFF);
    F.tid = threadIdx.x; F.lane = F.tid & 63; F.wave = __builtin_amdgcn_readfirstlane(F.tid >> 6);
    F.G = gridDim.x; { const int bx = blockIdx.x; F.vcu = (F.G % 8 == 0) ? (bx % 8) * (F.G / 8) + bx / 8 : bx; }
    F.ws = args.ws; F.out = args.out; F.ctl = (gu32*)(args.ws + WS_CTL);
    for (int u = F.tid; u < (LDS_BYTES - LDSCTL_OFF) / 4; u += NWAVES * 64) ((LAS unsigned*)(F.lds + LDSCTL_OFF))[u] = 0u;
    __syncthreads();
#ifdef MK_STAMP
    const unsigned long long t_start_ = rt();
#endif
    XcdBarrier bar = xcd_barrier_post((unsigned*)(F.ctl + CW_BAR), F.MISC + 8);
#ifdef MK_STAMP
    int n_stamp_ = 0;
#define GRID_BAR() do { xcd_barrier(bar); if (blockIdx.x == 0 && threadIdx.x == 0) __hip_atomic_store((unsigned long long*)(args.ws + WS_DUMMY + 512 * 1024) + n_stamp_, rt(), __ATOMIC_RELAXED, __HIP_MEMORY_SCOPE_AGENT); ++n_stamp_; } while (0)
#else
#define GRID_BAR() xcd_barrier(bar)
#endif
#define PH_BEGIN() \
    { int t_ = threadIdx.x; asm volatile("" : "+v"(t_)); F.tid = t_; F.lane = t_ & 63; F.wave = __builtin_amdgcn_readfirstlane(t_ >> 6); } \
    int z_ = 0; asm volatile("" : "+s"(z_)); unsigned char* ws = args.ws + z_; F.ws = ws; F.out = args.out + z_; \
    bf16* XB = (bf16*)(ws + WS_XB); bf16* W13 = (bf16*)(ws + WS_W13); bf16* W2 = (bf16*)(ws + WS_W2); bf16* HB = (bf16*)(ws + WS_R); \
    float* ss0 = (float*)(ws + WS_SSX0); float* ss1 = (float*)(ws + ACC_SSX1); float* ss2 = (float*)(ws + ACC_SSX2); float* ss3 = (float*)(ws + ACC_SSX3); \
    float* ssa = (float*)(ws + ACC_SSA); float* ssg = (float*)(ws + ACC_SSG); float* km = (float*)(ws + ACC_KM); bf16* OY = (bf16*)((unsigned char*)F.out + DO_OY); \
    (void)XB; (void)W13; (void)W2; (void)HB; (void)ss0; (void)ss1; (void)ss2; (void)ss3; (void)ssa; (void)ssg; (void)km; (void)OY;
    const int bx = (int)blockIdx.x;

    for (int rep = 0; rep < DUPN(0); ++rep) { PH_BEGIN(); p0_prologue(F); GRID_BAR(); }
#if MK_FP8_FFN1
    {   PH_BEGIN();
#if MK_FP8_FFN1 == 3
        pg8::Gemm g{XB, W13, T, 2 * DFF, DMODEL}; pg8::StaticOrder S; S.init(T, 2 * DFF, F.G, bx);
        pg8::EpiSwigluT<true, 0> E{HB, ss0, DFF};
        pg8::gemm_phase<pg8::EpiSwigluT<true, 0>, pg8::StaticOrder, true, true, false>(F.lds + RING_OFF, g, S, E);
#elif MK_FP8_FFN1 == 2
        pg8::Gemm g{(bf16*)(ws + WS_XA8), W13, T, 2 * DFF, DMODEL / 2}; pg8::StaticOrder S; S.init(T, 2 * DFF, F.G, bx);
        pg8::EpiSwigluT<false, FP8_SB13> E{HB, ss0, DFF};
        pg8::gemm_phase<pg8::EpiSwigluT<false, FP8_SB13>, pg8::StaticOrder, true, true, true>(F.lds + RING_OFF, g, S, E);
#else
        pg8::Gemm g{(bf16*)(ws + WS_XA8), W13, T, 2 * DFF, DMODEL / 2}; pg8::StaticOrder S; S.init(T, 2 * DFF, F.G, bx);
        pg8::EpiSwigluT<true, FP8_SB13> E{HB, ss0, DFF}; E.rt = (PG8_LAS float*)(F.lds + TAB_OFF);
        pg8::gemm_phase<pg8::EpiSwigluT<true, FP8_SB13>, pg8::StaticOrder, true, true, true>(F.lds + RING_OFF, g, S, E);
#endif
    }
    GRID_BAR();
    {   PH_BEGIN();
#if MK_FP8_FFN1 == 2
        pg8::Gemm g{HB, W2, T, DMODEL, DFF}; pg8::StaticOrder S; S.init(T, DMODEL, F.G, bx);
        pg8::EpiResid<false> E{XB, ss1, 0.5f, nullptr, nullptr, nullptr, nullptr};
        pg8::gemm_phase<pg8::EpiResid<false>, pg8::StaticOrder, true, true>(F.lds + RING_OFF, g, S, E);
#else
        pg8::Gemm g{HB, W2, T, DMODEL, DFF / 2}; pg8::StaticOrder S; S.init(T, DMODEL, F.G, bx);
        pg8::EpiResid<false, FP8_SB2> E{XB, ss1, 0.5f, nullptr, nullptr, nullptr, nullptr};
        pg8::gemm_phase<pg8::EpiResid<false, FP8_SB2>, pg8::StaticOrder, true, true, true>(F.lds + RING_OFF, g, S, E);
#endif
    }
    GRID_BAR();
#else
    {   PH_BEGIN(); pg8::Gemm g{XB, W13, T, 2 * DFF, DMODEL}; pg8::StaticOrder S; S.init(T, 2 * DFF, F.G, bx);
        pg8::EpiSwiglu E{HB, ss0, DFF}; E.rt = (PG8_LAS float*)(F.lds + TAB_OFF);
        if ((MK_DUP >> 18) & 1) { pg8::EpiNull E0{(float*)(ws + WS_DUMMY)}; pg8::gemm_phase<pg8::EpiNull, pg8::StaticOrder, true, true>(F.lds + RING_OFF, g, S, E0); GRID_BAR(); }
        if ((MK_DUP >> 23) & 1) { pg8::EpiNull E0{(float*)(ws + WS_DUMMY)}; pg8::gemm_phase<pg8::EpiNull, pg8::StaticOrder, true, true, false, true>(F.lds + RING_OFF, g, S, E0); GRID_BAR(); }
        if ((MK_DUP >> 22) & 1) { pg8::EpiSwiglu E0{HB, ss0, DFF}; pg8::gemm_phase<pg8::EpiSwiglu, pg8::StaticOrder, true, true>(F.lds + RING_OFF, g, S, E0); GRID_BAR(); }
        for (int rep = 0; rep < DUPN(1); ++rep) { pg8::gemm_phase<pg8::EpiSwiglu, pg8::StaticOrder, true, true>(F.lds + RING_OFF, g, S, E); GRID_BAR(); } }
    {   PH_BEGIN(); pg8::Gemm g{HB, W2, T, DMODEL, DFF}; pg8::StaticOrder S; S.init(T, DMODEL, F.G, bx);
        for (int rep = 0; rep < DUPN(2); ++rep) { pg8::EpiResid<false> E{rep ? (bf16*)(ws + WS_S) : XB, rep ? (float*)(ws + WS_DUMMY) : ss1, 0.5f, nullptr, nullptr, nullptr, nullptr};
        pg8::gemm_phase<pg8::EpiResid<false>, pg8::StaticOrder, true, true>(F.lds + RING_OFF, g, S, E); GRID_BAR(); }
        if ((MK_DUP >> 14) & 1) { pg8::EpiSwiglu E2{(bf16*)(ws + WS_S), ss0, 512}; pg8::gemm_phase<pg8::EpiSwiglu, pg8::StaticOrder, true, true>(F.lds + RING_OFF, g, S, E2); GRID_BAR(); } }
#endif
    {   PH_BEGIN(); pg8::Gemm g{XB, (bf16*)(ws + WS_WIN), T, 4096, DMODEL}; pg8::StaticOrder S; S.init(T, 4096, F.G, bx);
        if ((MK_DUP >> 16) & 1) { pg8::EpiSwiglu E2{HB, ss0, DFF}; pg8::gemm_phase<pg8::EpiSwiglu, pg8::StaticOrder, true, true>(F.lds + RING_OFF, g, S, E2); GRID_BAR(); }
        if ((MK_DUP >> 20) & 1) { pg8::EpiProjT<MK_LITE> E2{(bf16*)(ws + WS_Q), (bf16*)(ws + WS_K), (bf16*)(ws + WS_V), (bf16*)(ws + WS_Z), (bf16*)(ws + WS_S), ss1, (const float*)(ws + WS_CS), (float*)(ws + WS_DUMMY), attn_body::C2}; pg8::gemm_phase<pg8::EpiProjT<MK_LITE>, pg8::StaticOrder, true, true>(F.lds + RING_OFF, g, S, E2); GRID_BAR(); }
        if ((MK_DUP >> 17) & 1) { pg8::EpiProjT<1> E2{(bf16*)(ws + WS_Q), (bf16*)(ws + WS_K), (bf16*)(ws + WS_V), (bf16*)(ws + WS_Z), (bf16*)(ws + WS_S), ss1, (const float*)(ws + WS_CS), (float*)(ws + WS_DUMMY), attn_body::C2}; pg8::gemm_phase<pg8::EpiProjT<1>, pg8::StaticOrder, true, true>(F.lds + RING_OFF, g, S, E2); GRID_BAR(); }
        for (int rep = 0; rep < DUPN(3); ++rep) { pg8::EpiProj E{(bf16*)(ws + WS_Q), (bf16*)(ws + WS_K), (bf16*)(ws + WS_V), (bf16*)(ws + WS_Z), (bf16*)(ws + WS_S), ss1, (const float*)(ws + WS_CS), rep ? (float*)(ws + WS_DUMMY) : km, attn_body::C2};
        pg8::gemm_phase<pg8::EpiProj, pg8::StaticOrder, true, true>(F.lds + RING_OFF, g, S, E);
        dt_proj(F); if ((MK_DUP >> 19) & 1) { dt_proj(F); dt_proj(F); dt_proj(F); dt_proj(F); } GRID_BAR(); } }
#if MK_MERGE45
#pragma unroll 1
    for (int seg = 0; seg < 4; ++seg) {   PH_BEGIN();
        const int pat = (F.vcu >> 5) & 1, ncu = (128 * 24 + (int)F.G - 1) / (int)F.G, nh = (ncu + 1) >> 1;
        if ((seg & 1) == pat) p4_conv(F, (seg >> 1) * nh, (seg >> 1) ? ncu : nh);
        else { const attn_body::AttnTensors AT{(const attn_body::bf16*)(ws + WS_Q), (const attn_body::bf16*)(ws + WS_K), (const attn_body::bf16*)(ws + WS_V), (attn_body::bf16*)OY, km, ssa};
            const attn_body::StaticOrder S((int)F.G, F.vcu);
            attn_body::attn_range<attn_body::StaticOrder>((char*)lds + RING_OFF, AT, S, (seg >> 1) * 2, (seg >> 1) * 2 + 2); }
        __syncthreads();
    }
    {   PH_BEGIN(); p4_misc(F); GRID_BAR(); }
    {   PH_BEGIN(); ssd_states(F); GRID_BAR(); }
#else
    for (int rep = 0; rep < DUPN(4); ++rep) { PH_BEGIN(); p4_conv(F);
#ifdef MK_SPLIT4
        GRID_BAR();
#endif
        p4_misc(F); GRID_BAR(); }
    for (int rep = 0; rep < DUPN(5); ++rep) {   PH_BEGIN();
        const bool last = (rep == DUPN(5) - 1);
        const attn_body::AttnTensors AT{(const attn_body::bf16*)(ws + WS_Q), (const attn_body::bf16*)(ws + WS_K), (const attn_body::bf16*)(ws + WS_V), (attn_body::bf16*)OY, km, last ? ssa : (float*)(ws + WS_DUMMY)};
        const attn_body::StaticOrder S((int)F.G, F.vcu);
        if (last) attn_body::attn_phase<attn_body::StaticOrder>((char*)lds + RING_OFF, AT, S);
        else if (!((MK_DUP >> 12) & 1)) { if ((MK_DUP >> 15) & 1) attn_body::attn_phase<attn_body::StaticOrder, false>((char*)lds + RING_OFF, AT, S); else attn_body::attn_phase<attn_body::StaticOrder>((char*)lds + RING_OFF, AT, S); }
#ifdef MK_SPLIT5
        GRID_BAR();
#endif
        if (!((MK_DUP >> 13) & 1) || last) ssd_states(F);
        GRID_BAR(); }
#endif
#ifdef MK_XBAR
    for (int xb_ = 0; xb_ < MK_XBAR; ++xb_) GRID_BAR();
#endif
    for (int rep = 0; rep < DUPN(6); ++rep) { PH_BEGIN(); ssd_scan(F); GRID_BAR(); }
    for (int rep = 0; rep < DUPN(7); ++rep) { PH_BEGIN(); ssd_out(F, rep ? (float*)(ws + WS_DUMMY) : ssg); GRID_BAR(); }
    {   PH_BEGIN(); pg8::Gemm g{OY, (bf16*)(ws + WS_WOUT), T, DMODEL, DMIX}; pg8::StaticOrder S; S.init(T, DMODEL, F.G, bx);
        if ((MK_DUP >> 21) & 1) { pg8::EpiSwiglu E2{HB, ss0, 512}; pg8::gemm_phase<pg8::EpiSwiglu, pg8::StaticOrder, true, true>(F.lds + RING_OFF, g, S, E2); GRID_BAR(); }
        if (DUPN(8) == 2) { pg8::EpiResid<true> E{HB, (float*)(ws + WS_DUMMY), 1.0f, ssa, ssg, (PG8_LAS float*)(F.lds + TAB_OFF), nullptr};
        pg8::gemm_phase<pg8::EpiResid<true>, pg8::StaticOrder, true, true>(F.lds + RING_OFF, g, S, E); GRID_BAR(); }
        pg8::EpiResid<true> E{XB, ss2, 1.0f, ssa, ssg, (PG8_LAS float*)(F.lds + TAB_OFF), MK_FP8 ? (unsigned char*)(ws + WS_XA8) : nullptr};
        pg8::gemm_phase<pg8::EpiResid<true>, pg8::StaticOrder, true, true>(F.lds + RING_OFF, g, S, E); }
    GRID_BAR();
#if MK_FP8
    {   PH_BEGIN(); pg8::Gemm g{(bf16*)(ws + WS_XA8), W13, T, 2 * DFF, DMODEL / 2}; pg8::StaticOrder S; S.init(T, 2 * DFF, F.G, bx);
        pg8::EpiSwigluT<true, FP8_SB13> E{HB, ss2, DFF}; E.rt = (PG8_LAS float*)(F.lds + TAB_OFF);
        pg8::gemm_phase<pg8::EpiSwigluT<true, FP8_SB13>, pg8::StaticOrder, true, MK_SP2_FP8, true>(F.lds + RING_OFF, g, S, E); }
    GRID_BAR();
    {   PH_BEGIN(); pg8::Gemm g{HB, W2, T, DMODEL, DFF / 2}; pg8::StaticOrder S; S.init(T, DMODEL, F.G, bx);
        pg8::EpiResid<false, FP8_SB2> E{XB, ss3, 0.5f, nullptr, nullptr, nullptr, nullptr};
        pg8::gemm_phase<pg8::EpiResid<false, FP8_SB2>, pg8::StaticOrder, true, MK_SP2_FP8, true>(F.lds + RING_OFF, g, S, E);
#if MK_FUSE_FINAL
        { int t_ = threadIdx.x; asm volatile("" : "+v"(t_)); F.tid = t_; F.lane = t_ & 63; F.wave = __builtin_amdgcn_readfirstlane(t_ >> 6); }
        __threadfence();
        __syncthreads();
        if (F.tid == 0) { unsigned m_ = 0u; pg8::Unit u_;
            for (int i = 0; i < 2; ++i) if (S.next(i, u_)) { const unsigned old_ = __hip_atomic_fetch_add((unsigned*)(F.ctl + CW_PANEL) + 64 * u_.pm, 1u, __ATOMIC_RELAXED, __HIP_MEMORY_SCOPE_AGENT); if (old_ == 3u) m_ |= 1u << i; }
            F.MISC[16] = m_; }
        __syncthreads();
        const unsigned mine_ = F.MISC[16];
        if (mine_) { __threadfence();
            pg8::Unit u_;
            for (int i = 0; i < 2; ++i) if (((mine_ >> i) & 1u) && S.next(i, u_)) final_norm_panel(F, u_.pm); }
#endif
    }
#if !MK_FUSE_FINAL
    GRID_BAR();
#endif
#else
    {   PH_BEGIN(); pg8::Gemm g{XB, W13, T, 2 * DFF, DMODEL}; pg8::StaticOrder S; S.init(T, 2 * DFF, F.G, bx);
        pg8::EpiSwiglu E{HB, ss2, DFF};
        pg8::gemm_phase<pg8::EpiSwiglu, pg8::StaticOrder, true, true>(F.lds + RING_OFF, g, S, E); }
    GRID_BAR();
    {   PH_BEGIN(); pg8::Gemm g{HB, W2, T, DMODEL, DFF}; pg8::StaticOrder S; S.init(T, DMODEL, F.G, bx);
        pg8::EpiResid<false> E{XB, ss3, 0.5f, nullptr, nullptr, nullptr, nullptr};
        pg8::gemm_phase<pg8::EpiResid<false>, pg8::StaticOrder, true, true>(F.lds + RING_OFF, g, S, E); }
    GRID_BAR();
#endif
#if !(MK_FP8 && MK_FUSE_FINAL)
    { PH_BEGIN(); final_norm(F); }
#endif
#ifdef MK_STAMP
    GRID_BAR();
    if (blockIdx.x == 0 && threadIdx.x == 0) { asm volatile("s_waitcnt vmcnt(0)" ::: "memory"); const unsigned long long* st_ = (const unsigned long long*)(args.ws + WS_DUMMY + 512 * 1024);
#ifdef MK_SA
        const unsigned long long t1_ = __hip_atomic_load(st_ + MK_SA, __ATOMIC_RELAXED, __HIP_MEMORY_SCOPE_AGENT), t0_ = __hip_atomic_load(st_ + MK_SB, __ATOMIC_RELAXED, __HIP_MEMORY_SCOPE_AGENT);
#else
        const unsigned long long t1_ = __hip_atomic_load(st_ + MK_STAMP, __ATOMIC_RELAXED, __HIP_MEMORY_SCOPE_AGENT), t0_ = MK_STAMP > 0 ? __hip_atomic_load(st_ + MK_STAMP - 1, __ATOMIC_RELAXED, __HIP_MEMORY_SCOPE_AGENT) : t_start_;
#endif
        args.out[0] = 8.0f + (float)(t1_ - t0_) * (0.01f / MK_STAMP_DIV); }
#endif
#undef GRID_BAR
}

extern "C" void kernel_launch(void* const* d_in, const int* in_sizes, int n_in, void* d_out, int out_size, void* d_ws, size_t ws_size, hipStream_t stream) {
    static int grid = 0;
    if (grid == 0) {
        if (n_in != 20 || in_sizes[0] != T * DMODEL || out_size != T * DMODEL || ws_size < WS_END) { fprintf(stderr, "kernel_launch: unexpected shapes (n_in %d, in0 %d, out %d, ws %zu)\n", n_in, n_in > 0 ? in_sizes[0] : -1, out_size, ws_size); grid = -1; return; }
        int dev = 0, cus = 0, per_cu = 0;
        if (hipGetDevice(&dev) != hipSuccess || hipDeviceGetAttribute(&cus, hipDeviceAttributeMultiprocessorCount, dev) != hipSuccess) { grid = -1; return; }
        if (hipFuncSetAttribute((const void*)mk_fwd, hipFuncAttributeMaxDynamicSharedMemorySize, LDS_BYTES) != hipSuccess) { fprintf(stderr, "kernel_launch: hipFuncSetAttribute failed\n"); grid = -1; return; }
        if (hipOccupancyMaxActiveBlocksPerMultiprocessor(&per_cu, (const void*)mk_fwd, NWAVES * 64, LDS_BYTES) != hipSuccess || per_cu < 1) { fprintf(stderr, "kernel_launch: occupancy query says %d blocks per CU\n", per_cu); per_cu = 1; }
        (void)hipGetLastError();
        grid = cus;
        fprintf(stderr, "kernel_launch: grid %d (occupancy query %d per CU), ws %zu\n", grid, per_cu, ws_size);
    }
    if (grid < 0) return;
    if (hipMemsetAsync((char*)d_ws + WS_CTL, 0, CTL_ZERO_BYTES, stream) != hipSuccess) { fprintf(stderr, "kernel_launch: memset failed\n"); return; }
    Args a{};
    for (int i = 0; i < 20; ++i) a.in[i] = (const float*)d_in[i];
    a.out = (float*)d_out; a.ws = (unsigned char*)d_ws;
    hipLaunchKernelGGL(mk_fwd, dim3(grid), dim3(NWAVES * 64), LDS_BYTES, stream, a);
    const hipError_t le = hipPeekAtLastError();
    if (le != hipSuccess) fprintf(stderr, "kernel_launch: launch failed: %s\n", hipGetErrorName(le));
}
```

```cpp
#define MK_FP8_FFN1 1
#include <hip/hip_runtime.h>
#include <hip/hip_bf16.h>
#include <cstdio>
#include <cstdint>
#include <cmath>
__device__ __forceinline__ float shx(float v, int k) { int lid; asm volatile("v_mbcnt_lo_u32_b32 %0, -1, 0\n\tv_mbcnt_hi_u32_b32 %0, -1, %0" : "=v"(lid)); return __int_as_float(__builtin_amdgcn_ds_bpermute((lid ^ k) << 2, __float_as_int(v))); }
__device__ __forceinline__ float partner16(float v, int fq) { auto r = __builtin_amdgcn_permlane16_swap(__float_as_uint(v), __float_as_uint(v), false, false); return __uint_as_float((fq & 1) ? r[0] : r[1]); }
__device__ __forceinline__ float sum16(float v) { auto r = __builtin_amdgcn_permlane16_swap(__float_as_uint(v), __float_as_uint(v), false, false); return __uint_as_float(r[0]) + __uint_as_float(r[1]); }
__device__ __forceinline__ float sum32(float v) { auto r = __builtin_amdgcn_permlane32_swap(__float_as_uint(v), __float_as_uint(v), false, false); return __uint_as_float(r[0]) + __uint_as_float(r[1]); }
#ifndef T_NOLDS
#define T_NOLDS 0
#endif
#ifndef MK_FP8
#define MK_FP8 1
#endif
#ifndef MK_STAMP_DIV
#define MK_STAMP_DIV 4.0f
#endif
#ifndef MK_FP8_FFN1
#define MK_FP8_FFN1 0
#endif
#ifndef MK_FUSE_FINAL
#define MK_FUSE_FINAL 0
#endif
#ifndef MK_LITE
#define MK_LITE 0
#endif
#ifndef MK_WGM
#define MK_WGM 8
#endif
#ifndef MK_SP2_FP8
#define MK_SP2_FP8 true
#endif
#ifndef MK_ALIGN3
#define MK_ALIGN3 true
#endif
#ifndef MK_MERGE45
#define MK_MERGE45 1
#endif
#ifndef MK_NT
#define MK_NT 0
#endif
namespace pg8 {
#define PG8_LAS __attribute__((address_space(3)))
typedef unsigned short bf16_t;
typedef short bf16x8 __attribute__((ext_vector_type(8)));
typedef float f32x4 __attribute__((ext_vector_type(4)));
typedef unsigned u32x4 __attribute__((ext_vector_type(4)));
constexpr int BM = 256, BK = 64, HALF = 128, HTB = HALF * BK * 2  , STAGE_BYTES = 8 * HTB, NXCD = 8, WGM = MK_WGM;

__host__ __device__ __forceinline__ int lds_byte(int r, int c) { const int st = (r >> 4) * 2 + (c >> 5), rr = r & 15, cc = c & 31, ob = rr * 64 + cc * 2; return st * 1024 + (ob ^ (((ob >> 9) & 1) << 5)); }
__host__ __device__ __forceinline__ void stage_rc(int b, int& R, int& C) { const int st = b / 1024, sb = b % 1024, swz = sb ^ (((sb >> 9) & 1) << 5); R = (st >> 1) * 16 + swz / 64; C = (st & 1) * 32 + (swz % 64) / 2; }
__host__ __device__ __forceinline__ int perm32(int rho) { const int n = rho >> 4, i = rho & 15; return 8 * (i >> 2) + 4 * n + (i & 3); }

struct Unit { int pm, pn; };
struct Gemm { const bf16_t* A; const bf16_t* Bt; int M, N, K; };

struct StaticOrder {
    int nM, nN, nwg, G, c;
    __host__ __device__ void init(int M, int N, int G_, int c_) { nM = M / BM; nN = N / BM; nwg = nM * nN; G = G_; c = c_; }
    __host__ __device__ __forceinline__ bool next(int i, Unit& u) const {
        const long L = (long)i * G + c; if (L >= nwg) return false;
        int wgid = (int)L; { const int q = nwg / NXCD, r = nwg % NXCD, xcd = wgid % NXCD, off = wgid / NXCD; wgid = (xcd < r ? xcd * (q + 1) : r * (q + 1) + (xcd - r) * q) + off; }
        const int nig = WGM * nN, gid = wgid / nig, fm = gid * WGM, gsz = (nM - fm) < WGM ? (nM - fm) : WGM;
        u.pm = fm + ((wgid % nig) % gsz); u.pn = (wgid % nig) / gsz; return true;
    }
    __device__ __forceinline__ void a_ready(const Unit&) const {}
    __device__ __forceinline__ void done(const Unit&) const {}
};
typedef float f32x2_t __attribute__((ext_vector_type(2))); typedef __bf16 bf16x2_t __attribute__((ext_vector_type(2)));
typedef unsigned u32x2 __attribute__((ext_vector_type(2)));
__device__ __forceinline__ unsigned cvt_pk_bf16(float lo, float hi) { f32x2_t v = {lo, hi}; bf16x2_t b = __builtin_convertvector(v, bf16x2_t); return __builtin_bit_cast(unsigned, b); }
constexpr float RMS_EPS = 1e-6f;
__device__ __forceinline__ float silu_f(float x) { return x * __builtin_amdgcn_rcpf(1.0f + __builtin_amdgcn_exp2f(-1.4426950408889634f * x)); }

__device__ __forceinline__ unsigned cvt4_fp8(float a, float b, float c, float d) { int w = __builtin_amdgcn_cvt_pk_fp8_f32(a, b, 0, false); w = __builtin_amdgcn_cvt_pk_fp8_f32(c, d, w, true); return (unsigned)w; }
template <bool OUT8, int SB> struct EpiSwigluT {
    static constexpr bool PERM = true, WIDE = false, AFTER_DRAIN = false, KHOOK = false; static constexpr int SCALE_B = SB;
    bf16_t* H; const float* ss; int ldh;
    PG8_LAS float* rt = nullptr;
    mutable int lastpm = -1;
    __device__ __forceinline__ void operator()(const f32x4 (&acc)[2][2][4][2], const Unit& u, int wr, int wc, int fr, int fq) const {
        const int row0 = u.pm * BM + wr * 64 + fr, col0 = u.pn * HALF + wc * 32 + 8 * fq;
        float ssv[2][4];
        PG8_LAS float* t = rt + (wr * 4 + wc) * 128 + fr;
        if (rt == nullptr || u.pm != lastpm) {
#pragma unroll
            for (int ai = 0; ai < 2; ++ai)
#pragma unroll
                for (int m = 0; m < 4; ++m) ssv[ai][m] = ss[row0 + ai * HALF + m * 16];
#pragma unroll
            for (int ai = 0; ai < 2; ++ai)
#pragma unroll
                for (int m = 0; m < 4; ++m) { ssv[ai][m] = rsqrtf(ssv[ai][m] * (1.0f / 1024.0f) + RMS_EPS); if (rt != nullptr) t[(ai * 4 + m) * 16] = ssv[ai][m]; }
            lastpm = u.pm;
        } else {
#pragma unroll
            for (int ai = 0; ai < 2; ++ai)
#pragma unroll
                for (int m = 0; m < 4; ++m) ssv[ai][m] = t[(ai * 4 + m) * 16];
        }
#pragma unroll
        for (int ai = 0; ai < 2; ++ai)
#pragma unroll
            for (int m = 0; m < 4; ++m) asm volatile("" : "+v"(ssv[ai][m]));
#pragma unroll
        for (int ai = 0; ai < 2; ++ai)
#pragma unroll
            for (int m = 0; m < 4; ++m) {
                const int row = row0 + ai * HALF + m * 16;
                const float rs = ssv[ai][m];
                float h[8];
#pragma unroll
                for (int n = 0; n < 2; ++n)
#pragma unroll
                    for (int i = 0; i < 4; ++i) h[4 * n + i] = silu_f(acc[ai][0][m][n][i] * rs) * (acc[ai][1][m][n][i] * rs);
                if constexpr (OUT8) { u32x2 w; w.x = cvt4_fp8(h[0], h[1], h[2], h[3]); w.y = cvt4_fp8(h[4], h[5], h[6], h[7]);
#if MK_NT
                    __builtin_nontemporal_store(w, (u32x2*)((unsigned char*)H + (size_t)row * ldh + col0));
#else
                    *(u32x2*)((unsigned char*)H + (size_t)row * ldh + col0) = w;
#endif
                }
                else { u32x4 w; w.x = cvt_pk_bf16(h[0], h[1]); w.y = cvt_pk_bf16(h[2], h[3]); w.z = cvt_pk_bf16(h[4], h[5]); w.w = cvt_pk_bf16(h[6], h[7]);
#if MK_NT
                __builtin_nontemporal_store(w, (u32x4*)(H + (size_t)row * ldh + col0));
#else
                *(u32x4*)(H + (size_t)row * ldh + col0) = w;
#endif
                }
            }
    }
};

template <bool KH, int SB = 0> struct EpiResid {
    static constexpr bool PERM = true, WIDE = true, AFTER_DRAIN = false, KHOOK = KH; static constexpr int SCALE_B = SB;
    static constexpr int K1 = 8, K2 = 16;
    bf16_t* XB; float* ss; float alpha;
    const float* ssa; const float* ssg;
    PG8_LAS float* tab;
    unsigned char* X8;
    __device__ __forceinline__ void unit_begin(const Unit& u, int wid, int wr, int fr, int fq) const {
        if constexpr (KH) {
            PG8_LAS float* t = tab + wid * 384;
            if (fq == 0) {
                float sa[2][4]; f32x2_t sg[2][4];
#pragma unroll
                for (int ai = 0; ai < 2; ++ai)
#pragma unroll
                    for (int m = 0; m < 4; ++m) { const int row = u.pm * BM + ai * HALF + wr * 64 + m * 16 + fr;
                        sa[ai][m] = ((const __attribute__((address_space(1))) float*)ssa)[row]; sg[ai][m] = *(const __attribute__((address_space(1))) f32x2_t*)(ssg + 2 * row); }
#pragma unroll
                for (int ai = 0; ai < 2; ++ai)
#pragma unroll
                    for (int m = 0; m < 4; ++m) {
                        const float va = sa[ai][m] * (1.0f / 512.0f) + RMS_EPS, v0 = sg[ai][m].x * (1.0f / 512.0f) + RMS_EPS, v1 = sg[ai][m].y * (1.0f / 512.0f) + RMS_EPS;
                        const int e = (ai * 4 + m) * 16 + fr;
                        t[e] = sqrtf(v0 * __builtin_amdgcn_rcpf(va));
                        t[128 + e] = sqrtf(v1 * __builtin_amdgcn_rcpf(v0));
                        t[256 + e] = rsqrtf(v1);
                    }
            }
            asm volatile("s_waitcnt lgkmcnt(0)" ::: "memory");
        }
    }
    __device__ __forceinline__ void khook(f32x4 (&acc)[2][2][4][2], int t, int wid, int fr) const {
        if constexpr (KH) {
            const PG8_LAS float* tb = tab + wid * 384 + (t == K1 ? 0 : 128);
#pragma unroll
            for (int ai = 0; ai < 2; ++ai)
#pragma unroll
                for (int m = 0; m < 4; ++m) { const float f = tb[(ai * 4 + m) * 16 + fr];
#pragma unroll
                    for (int bj = 0; bj < 2; ++bj)
#pragma unroll
                        for (int n = 0; n < 2; ++n) acc[ai][bj][m][n] = acc[ai][bj][m][n] * f; }
        }
    }
    __device__ __forceinline__ void operator()(const f32x4 (&acc)[2][2][4][2], const Unit& u, int wr, int wc, int fr, int fq) const {
        const int row0 = u.pm * BM + wr * 64 + fr, col0 = u.pn * BM + wc * 64 + 16 * fq;
        const int wid = wr * 4 + wc;
        u32x4 rra[2][4][2];
        constexpr bool ALL = false;
        if constexpr (ALL) {
#pragma unroll
            for (int ai = 0; ai < 2; ++ai)
#pragma unroll
                for (int m = 0; m < 4; ++m)
#pragma unroll
                    for (int bj = 0; bj < 2; ++bj) rra[ai][m][bj] = *(const u32x4*)(XB + (size_t)(row0 + ai * HALF + m * 16) * 1024 + col0 + bj * 8);
#pragma unroll
            for (int ai = 0; ai < 2; ++ai)
#pragma unroll
                for (int m = 0; m < 4; ++m)
#pragma unroll
                    for (int bj = 0; bj < 2; ++bj) asm volatile("" : "+v"(rra[ai][m][bj]));
        }
#pragma unroll
        for (int ai = 0; ai < 2; ++ai) {
            if constexpr (!ALL) {
#pragma unroll
                for (int m = 0; m < 4; ++m)
#pragma unroll
                    for (int bj = 0; bj < 2; ++bj) rra[ai][m][bj] = *(const u32x4*)(XB + (size_t)(row0 + ai * HALF + m * 16) * 1024 + col0 + bj * 8);
#pragma unroll
                for (int m = 0; m < 4; ++m)
#pragma unroll
                    for (int bj = 0; bj < 2; ++bj) asm volatile("" : "+v"(rra[ai][m][bj]));
            }
#pragma unroll
            for (int m = 0; m < 4; ++m) {
                const int row = row0 + ai * HALF + m * 16;
                float f = alpha; if constexpr (KH) f *= tab[wid * 384 + 256 + (ai * 4 + m) * 16 + fr];
                float sq = 0.f; u32x4 w8 = {0u, 0u, 0u, 0u};
#pragma unroll
                for (int bj = 0; bj < 2; ++bj) {
                    float v[8];
#pragma unroll
                    for (int n = 0; n < 2; ++n)
#pragma unroll
                        for (int i = 0; i < 2; ++i) { const unsigned w = rra[ai][m][bj][2 * n + i];
                            v[4 * n + 2 * i] = __uint_as_float(w << 16) + acc[ai][bj][m][n][2 * i] * f; v[4 * n + 2 * i + 1] = __uint_as_float(w & 0xffff0000u) + acc[ai][bj][m][n][2 * i + 1] * f; }
#pragma unroll
                    for (int j = 0; j < 8; ++j) sq += v[j] * v[j];
                    u32x4 w; w.x = cvt_pk_bf16(v[0], v[1]); w.y = cvt_pk_bf16(v[2], v[3]); w.z = cvt_pk_bf16(v[4], v[5]); w.w = cvt_pk_bf16(v[6], v[7]);
                    *(u32x4*)(XB + (size_t)row * 1024 + col0 + bj * 8) = w;
                    if (X8) { w8[2 * bj] = cvt4_fp8(v[0], v[1], v[2], v[3]); w8[2 * bj + 1] = cvt4_fp8(v[4], v[5], v[6], v[7]); }
                }
                if (X8) *(u32x4*)(X8 + (size_t)row * 1024 + col0) = w8;
                sq = sum16(sq); sq = sum32(sq);
                if (fq == 0) atomicAdd(ss + row, sq);
            }
        }
    }
};

typedef EpiSwigluT<false, 0> EpiSwiglu;
template <int LITE> struct EpiProjT {
    static constexpr bool PERM = true, WIDE = false, AFTER_DRAIN = false, KHOOK = false; static constexpr int SCALE_B = 0;
    bf16_t *Q, *Kb, *V, *Z, *XBC; const float* ss; const float* cs; float* kmsum; float qscale;
    __device__ __forceinline__ void operator()(const f32x4 (&acc)[2][2][4][2], const Unit& u, int wr, int wc, int fr, int fq) const {
        const int pn = u.pn;
        bf16_t* dst; int ld, cb;
        if (pn < 2) { dst = Q; ld = 512; cb = pn * 256; } else if (pn < 4) { dst = Kb; ld = 512; cb = (pn - 2) * 256; } else if (pn < 6) { dst = V; ld = 512; cb = (pn - 4) * 256; }
        else if (pn < 10) { dst = Z; ld = 1024; cb = (pn - 6) * 256; } else { dst = XBC; ld = 1536; cb = (pn - 10) * 256; }
        const bool rot = (LITE == 0) && (pn < 4) && ((wc & 1) == 0), isk = (LITE != 1) && (pn == 2 || pn == 3);
        const float sc = pn < 2 ? qscale : 1.0f;
        const int row0 = u.pm * BM + wr * 64 + fr, c0 = wc * 32 + 8 * fq;
        float csum[2][8];
#pragma unroll
        for (int bj = 0; bj < 2; ++bj)
#pragma unroll
            for (int j = 0; j < 8; ++j) csum[bj][j] = 0.f;
        f32x4 ncv[2], nsv[2];
        if (rot) { const float* cp = cs + (size_t)(row0 & 4095) * 16; ncv[0] = *(const f32x4*)cp; ncv[1] = *(const f32x4*)(cp + 4); nsv[0] = *(const f32x4*)(cp + 8); nsv[1] = *(const f32x4*)(cp + 12); }
        float ssv[2][4];
#pragma unroll
        for (int ai = 0; ai < 2; ++ai)
#pragma unroll
            for (int m = 0; m < 4; ++m) ssv[ai][m] = ss[row0 + ai * HALF + m * 16];
#pragma unroll
        for (int ai = 0; ai < 2; ++ai)
#pragma unroll
            for (int m = 0; m < 4; ++m) asm volatile("" : "+v"(ssv[ai][m]));
#pragma unroll
        for (int ai = 0; ai < 2; ++ai)
#pragma unroll
            for (int m = 0; m < 4; ++m) {
                const int row = row0 + ai * HALF + m * 16;
                const float rs = rsqrtf(ssv[ai][m] * (1.0f / 1024.0f) + RMS_EPS) * sc;
                f32x4 cv[2], sv[2];
                if (rot) {
                    cv[0] = ncv[0]; cv[1] = ncv[1]; sv[0] = nsv[0]; sv[1] = nsv[1];
                    if (ai * 4 + m < 7) {
                        constexpr float C16[8] = {-9.576594803e-01f, -9.992462593e-01f, 8.243765146e-01f, 9.932003012e-01f, 9.997440109e-01f, 9.999903729e-01f, 9.999996380e-01f, 9.999999864e-01f};
                        constexpr float S16[8] = {-2.879033167e-01f, 3.881898152e-02f, 5.660418378e-01f, 1.164180468e-01f, 2.262548617e-02f, 4.387956730e-03f, 8.509272408e-04f, 1.650141653e-04f};
                        constexpr float C80[8] = {-1.103872438e-01f, -9.812132344e-01f, -9.911539132e-01f, 8.345872775e-01f, 9.936068238e-01f, 9.997593311e-01f, 9.999909490e-01f, 9.999996596e-01f};
                        constexpr float S80[8] = {-9.938886539e-01f, 1.929263812e-01f, 1.327174458e-01f, 5.508757358e-01f, 1.128958803e-01f, 2.193809395e-02f, 4.254623881e-03f, 8.250707366e-04f};
#pragma unroll
                        for (int j = 0; j < 8; ++j) { const float cd = (m == 3) ? C80[j] : C16[j], sd = (m == 3) ? S80[j] : S16[j], c0_ = cv[j >> 2][j & 3], s0_ = sv[j >> 2][j & 3];
                            ncv[j >> 2][j & 3] = c0_ * cd - s0_ * sd; nsv[j >> 2][j & 3] = s0_ * cd + c0_ * sd; } } }
#pragma unroll
                for (int bj = 0; bj < 2; ++bj) {
                    float v[8];
#pragma unroll
                    for (int n = 0; n < 2; ++n)
#pragma unroll
                        for (int i = 0; i < 4; ++i) v[4 * n + i] = acc[ai][bj][m][n][i] * rs;
                    if (rot) {
#pragma unroll
                        for (int j = 0; j < 8; ++j) {
                            const float p = partner16(v[j], fq);
                            const float c = cv[j >> 2][j & 3], s = sv[j >> 2][j & 3];
                            const float r1 = v[j] * c - p * s, r2 = v[j] * c + p * s;
                            v[j] = fq == 0 ? r1 : (fq == 1 ? r2 : v[j]);
                        }
                    }
                    if (isk) {
#pragma unroll
                        for (int j = 0; j < 8; ++j) csum[bj][j] += v[j];
                    }
                    u32x4 w; w.x = cvt_pk_bf16(v[0], v[1]); w.y = cvt_pk_bf16(v[2], v[3]); w.z = cvt_pk_bf16(v[4], v[5]); w.w = cvt_pk_bf16(v[6], v[7]);
                    if (pn < 6) { const int col = cb + bj * HALF + c0;
                        *(u32x4*)(dst + ((size_t)((row >> 12) * 8 + (col >> 6)) * 4096 + (row & 4095)) * 64 + (col & 63)) = w; }
                    else *(u32x4*)(dst + (size_t)row * ld + cb + bj * HALF + c0) = w;
                }
            }
        if (isk) {
#pragma unroll
            for (int bj = 0; bj < 2; ++bj) {
                float mine = 0.f;
#pragma unroll
                for (int j = 0; j < 8; ++j) {
                    float s = csum[bj][j];
                    s += __builtin_bit_cast(float, __builtin_amdgcn_update_dpp(0, __builtin_bit_cast(int, s), 0x128, 0xf, 0xf, false));
                    s += __builtin_bit_cast(float, __builtin_amdgcn_update_dpp(0, __builtin_bit_cast(int, s), 0x124, 0xf, 0xf, false));
                    s += __builtin_bit_cast(float, __builtin_amdgcn_update_dpp(0, __builtin_bit_cast(int, s), 0x122, 0xf, 0xf, false));
                    s += __builtin_bit_cast(float, __builtin_amdgcn_update_dpp(0, __builtin_bit_cast(int, s), 0x121, 0xf, 0xf, false));
                    mine = ((fr & 7) == j) ? s : mine;
                }
                if (fr < 8) atomicAdd(kmsum + (size_t)u.pm * 512 + (pn - 2) * 256 + bj * HALF + c0 + fr, mine);
            }
        }
    }
};

typedef EpiProjT<0> EpiProj;
struct EpiNull {
    static constexpr bool PERM = true, WIDE = false, AFTER_DRAIN = false, KHOOK = false; static constexpr int SCALE_B = 0;
    float* sink;
    __device__ __forceinline__ void operator()(const f32x4 (&acc)[2][2][4][2], const Unit& u, int wr, int wc, int fr, int fq) const {
        float s = 0.f;
#pragma unroll
        for (int ai = 0; ai < 2; ++ai)
#pragma unroll
            for (int bj = 0; bj < 2; ++bj)
#pragma unroll
                for (int m = 0; m < 4; ++m)
#pragma unroll
                    for (int n = 0; n < 2; ++n) s += (acc[ai][bj][m][n][0] + acc[ai][bj][m][n][1]) + (acc[ai][bj][m][n][2] + acc[ai][bj][m][n][3]);
        sink[(wr * 4 + wc) * 64 + fq * 16 + fr] = s;
    }
};
typedef float f32x16w __attribute__((ext_vector_type(16))); typedef int v8i32 __attribute__((ext_vector_type(8))); typedef int v4i32 __attribute__((ext_vector_type(4)));
__device__ __forceinline__ v8i32 cat8(bf16x8 a, bf16x8 b) { const v4i32 x = __builtin_bit_cast(v4i32, a), y = __builtin_bit_cast(v4i32, b); return __builtin_shufflevector(x, y, 0, 1, 2, 3, 4, 5, 6, 7); }
template <class Epi, class Sched, bool ALIGN_EPI = false, bool SP2 = false, bool FP8 = false, bool S32 = false>
__device__ __forceinline__ void gemm_phase(PG8_LAS unsigned char* lds, const Gemm g, const Sched& S, const Epi& E) {
    int tid_ = threadIdx.x; asm volatile("" : "+v"(tid_));
    const int tid = tid_, wid = __builtin_amdgcn_readfirstlane(tid >> 6), lane = tid & 63, wr = wid >> 2, wc = wid & 3, fr = lane & 15, fq = lane >> 4;
    const int K = g.K, nt = K / BK;
    unsigned voffA[2], voffB[2];
#pragma unroll
    for (int i = 0; i < 2; ++i) { int R, C; stage_rc(tid * 16 + i * 8192, R, C); const int Rb = Epi::WIDE ? (64 * (R >> 5) + 16 * ((R & 15) >> 2) + 4 * ((R >> 4) & 1) + (R & 3)) : Epi::PERM ? ((R & ~31) + perm32(R & 31)) : R;
        voffA[i] = (unsigned)(R * K + C) * 2u; voffB[i] = (unsigned)(Rb * K + C) * 2u; }
    const size_t p1step = (size_t)64 * K * 2;
    const size_t kstep = (size_t)(BK * 2);
    const size_t hstep = (size_t)HALF * K * 2;
    const size_t hstepB = Epi::WIDE ? (size_t)8 * K * 2 : hstep, p1stepB = Epi::WIDE ? (size_t)128 * K * 2 : p1step;
    const size_t tstep = 2 * hstep;
    const unsigned ldsw = (unsigned)wid * 1024u;
    const int aoff = lds_byte(wr * 64 + fr, fq * 8), boff = lds_byte(wc * 32 + fr, fq * 8);
    constexpr int SCB = (127 - Epi::SCALE_B) | (127 << 8);
#define PG8_SA(b, h) (((b) * 2 + (h)) * HTB)
#define PG8_SB(b, h) ((4 + (b) * 2 + (h)) * HTB)
#define PG8_STAGE(bufoff, gbase, voff) do { _Pragma("unroll") for (int _i = 0; _i < 2; ++_i) \
        __builtin_amdgcn_global_load_lds((const unsigned*)((const char*)(gbase) + (size_t)_i * ((voff) == voffB ? p1stepB : p1step) + (voff)[0]), (PG8_LAS unsigned*)(lds + (bufoff) + ldsw + _i * 8192), 16, 0, 0); } while (0)
#define PG8_LDA(dst, b, h) do { if constexpr (FP8) { _Pragma("unroll") for (int m = 0; m < 4; ++m) { const v4i32 lo_ = *(const PG8_LAS v4i32*)(lds + PG8_SA(b, h) + aoff + m * 2048), hi_ = *(const PG8_LAS v4i32*)(lds + PG8_SA(b, h) + aoff + m * 2048 + 1024); dst##8[m] = __builtin_shufflevector(lo_, hi_, 0, 1, 2, 3, 4, 5, 6, 7); } } \
        else { _Pragma("unroll") for (int m = 0; m < 4; ++m) _Pragma("unroll") for (int k = 0; k < 2; ++k) dst[m][k] = *(const PG8_LAS bf16x8*)(lds + PG8_SA(b, h) + aoff + m * 2048 + k * 1024); } } while (0)
#define PG8_LDB(dst, b, h) do { if constexpr (FP8) { _Pragma("unroll") for (int n = 0; n < 2; ++n) { const v4i32 lo_ = *(const PG8_LAS v4i32*)(lds + PG8_SB(b, h) + boff + n * 2048), hi_ = *(const PG8_LAS v4i32*)(lds + PG8_SB(b, h) + boff + n * 2048 + 1024); dst##8[n] = __builtin_shufflevector(lo_, hi_, 0, 1, 2, 3, 4, 5, 6, 7); } } \
        else { _Pragma("unroll") for (int n = 0; n < 2; ++n) _Pragma("unroll") for (int k = 0; k < 2; ++k) dst[n][k] = *(const PG8_LAS bf16x8*)(lds + PG8_SB(b, h) + boff + n * 2048 + k * 1024); } } while (0)
#define PG8_MMA(ai, bj, At, Bt) do { __builtin_amdgcn_s_setprio(1); if constexpr (S32) { _Pragma("unroll") for (int t_ = 0; t_ < 2; ++t_) _Pragma("unroll") for (int ks_ = 0; ks_ < 4; ++ks_) \
        acc32[ai][bj][t_] = __builtin_amdgcn_mfma_f32_32x32x16_bf16(Bt[ks_ >> 1][ks_ & 1], At[t_ * 2 + (ks_ >> 1)][ks_ & 1], acc32[ai][bj][t_], 0, 0, 0); } else \
        _Pragma("unroll") for (int m = 0; m < 4; ++m) _Pragma("unroll") for (int n = 0; n < 2; ++n) { \
        if constexpr (FP8) { f32x16w& W_ = accw[ai][bj][m >> 1]; const int i_ = 4 * ((m & 1) * 2 + n); f32x4 c_ = {W_[i_], W_[i_ + 1], W_[i_ + 2], W_[i_ + 3]}; \
            c_ = __builtin_amdgcn_mfma_scale_f32_16x16x128_f8f6f4(Bt##8[n], At##8[m], c_, 0, 0, 0, SCB, 1, SCB); W_[i_] = c_[0]; W_[i_ + 1] = c_[1]; W_[i_ + 2] = c_[2]; W_[i_ + 3] = c_[3]; } \
        else { _Pragma("unroll") for (int k = 0; k < 2; ++k) acc[ai][bj][m][n] = __builtin_amdgcn_mfma_f32_16x16x32_bf16(Bt[n][k], At[m][k], acc[ai][bj][m][n], 0, 0, 0); } } __builtin_amdgcn_s_setprio(0); } while (0)
#define PG8_WAIT_V(n) asm volatile("s_waitcnt vmcnt(" #n ")" ::: "memory")
#define PG8_WAIT_L(n) asm volatile("s_waitcnt lgkmcnt(" #n ")" ::: "memory")
#define PG8_BAR __builtin_amdgcn_s_barrier()
#define PG8_SCHED __builtin_amdgcn_sched_barrier(0)
    Unit cur, nxt; int ui = 0;
    if (!S.next(0, cur)) return;
    f32x4 acc[2][2][4][2];
    f32x16w acc32[2][2][2];
    if constexpr (S32) { _Pragma("unroll") for (int a = 0; a < 2; ++a) _Pragma("unroll") for (int b = 0; b < 2; ++b) _Pragma("unroll") for (int q = 0; q < 2; ++q) acc32[a][b][q] = f32x16w{}; }
    f32x16w accw[2][2][2];
#define PG8_ZERO_W() do { if constexpr (FP8) { _Pragma("unroll") for (int a = 0; a < 2; ++a) _Pragma("unroll") for (int b = 0; b < 2; ++b) _Pragma("unroll") for (int q = 0; q < 2; ++q) accw[a][b][q] = f32x16w{}; } } while (0)
#define PG8_UNPACK_W() do { if constexpr (FP8) { _Pragma("unroll") for (int a = 0; a < 2; ++a) _Pragma("unroll") for (int b = 0; b < 2; ++b) _Pragma("unroll") for (int m = 0; m < 4; ++m) _Pragma("unroll") for (int n = 0; n < 2; ++n) { \
        const int i_ = 4 * ((m & 1) * 2 + n); acc[a][b][m][n] = (f32x4){accw[a][b][m >> 1][i_], accw[a][b][m >> 1][i_ + 1], accw[a][b][m >> 1][i_ + 2], accw[a][b][m >> 1][i_ + 3]}; } } } while (0)
    PG8_ZERO_W();
#pragma unroll
    for (int a = 0; a < 2; ++a)
#pragma unroll
        for (int b = 0; b < 2; ++b)
#pragma unroll
            for (int m = 0; m < 4; ++m)
#pragma unroll
                for (int n = 0; n < 2; ++n) acc[a][b][m][n] = (f32x4){0.f, 0.f, 0.f, 0.f};
    bf16x8 At[4][2], B0[2][2], B1[2][2]; v8i32 At8[4], B08[2], B18[2];
    const char* cA = (const char*)g.A + (size_t)cur.pm * tstep; const char* cB = (const char*)g.Bt + (size_t)cur.pn * tstep;
    S.a_ready(cur);
    if constexpr (SP2) {
        PG8_STAGE(PG8_SB(0, 0), cB, voffB); PG8_STAGE(PG8_SB(0, 1), cB + hstepB, voffB); PG8_STAGE(PG8_SA(0, 0), cA, voffA); PG8_STAGE(PG8_SA(0, 1), cA + hstep, voffA);
        if (wr == 1) PG8_BAR;
        PG8_WAIT_V(2); PG8_BAR;
        PG8_STAGE(PG8_SB(1, 0), cB + kstep, voffB); PG8_STAGE(PG8_SA(1, 0), cA + kstep, voffA); PG8_STAGE(PG8_SB(1, 1), cB + hstepB + kstep, voffB);
        PG8_WAIT_V(6); PG8_BAR;
    } else {
        PG8_STAGE(PG8_SB(0, 0), cB, voffB); PG8_STAGE(PG8_SA(0, 0), cA, voffA); PG8_STAGE(PG8_SB(0, 1), cB + hstepB, voffB); PG8_STAGE(PG8_SA(0, 1), cA + hstep, voffA);
        if (wr == 1) PG8_BAR;
        PG8_WAIT_V(4); PG8_BAR;
        PG8_STAGE(PG8_SB(1, 0), cB + kstep, voffB); PG8_STAGE(PG8_SA(1, 0), cA + kstep, voffA); PG8_STAGE(PG8_SB(1, 1), cB + hstepB + kstep, voffB);
        PG8_WAIT_V(6); PG8_BAR;
    }
    for (;;) {
        const bool has_next = S.next(ui + 1, nxt);
        if constexpr (Epi::KHOOK) E.unit_begin(cur, wid, wr, fr, fq);
        const char* nA = has_next ? (const char*)g.A + (size_t)nxt.pm * tstep : cA; const char* nB = has_next ? (const char*)g.Bt + (size_t)nxt.pn * tstep : cB;
#pragma unroll 1
        for (int t = 0; t < nt; t += 2) {
            const bool last = (t == nt - 2);
            if constexpr (Epi::KHOOK) { if (t == Epi::K1 || t == Epi::K2) { E.khook(acc, t, wid, fr); PG8_SCHED; } }
            const char* a1 = cA + (size_t)(t + 1) * kstep;
            const char* a2 = last ? nA : cA + (size_t)(t + 2) * kstep; const char* b2 = last ? nB : cB + (size_t)(t + 2) * kstep;
            const char* a3 = a2 + kstep; const char* b3 = b2 + kstep;
            if (last && has_next) S.a_ready(nxt);
            if constexpr (SP2) {
            PG8_LDB(B0, 0, 0); PG8_LDB(B1, 0, 1); PG8_SCHED; PG8_LDA(At, 0, 0); PG8_STAGE(PG8_SA(1, 1), a1 + hstep, voffA);
            PG8_WAIT_V(8); PG8_WAIT_L(0); PG8_BAR; PG8_MMA(0, 0, At, B0); PG8_MMA(0, 1, At, B1); PG8_BAR; PG8_SCHED;
            PG8_LDA(At, 0, 1); PG8_STAGE(PG8_SB(0, 0), b2, voffB); PG8_STAGE(PG8_SB(0, 1), b2 + hstepB, voffB); PG8_STAGE(PG8_SA(0, 0), a2, voffA);
            PG8_WAIT_V(8); PG8_WAIT_L(0); PG8_BAR; PG8_MMA(1, 0, At, B0); PG8_MMA(1, 1, At, B1); PG8_BAR; PG8_SCHED;
            PG8_LDB(B0, 1, 0); PG8_LDB(B1, 1, 1); PG8_SCHED; PG8_LDA(At, 1, 0); PG8_STAGE(PG8_SA(0, 1), a2 + hstep, voffA);
            PG8_WAIT_V(8); PG8_WAIT_L(0); PG8_BAR; PG8_MMA(0, 0, At, B0); PG8_MMA(0, 1, At, B1); PG8_BAR; PG8_SCHED;
            PG8_LDA(At, 1, 1); PG8_STAGE(PG8_SB(1, 0), b3, voffB); PG8_STAGE(PG8_SB(1, 1), b3 + hstepB, voffB); PG8_STAGE(PG8_SA(1, 0), a3, voffA);
            PG8_WAIT_V(8); PG8_WAIT_L(0); PG8_BAR; PG8_MMA(1, 0, At, B0); PG8_MMA(1, 1, At, B1); PG8_BAR; PG8_SCHED;
            } else {
            PG8_LDB(B0, 0, 0); PG8_SCHED; PG8_LDA(At, 0, 0); PG8_STAGE(PG8_SA(1, 1), a1 + hstep, voffA);
            PG8_WAIT_L(8); PG8_BAR; PG8_WAIT_L(0); PG8_MMA(0, 0, At, B0); PG8_BAR; PG8_SCHED;
            PG8_LDB(B1, 0, 1); PG8_STAGE(PG8_SB(0, 0), b2, voffB);
            PG8_BAR; PG8_WAIT_L(0); PG8_MMA(0, 1, At, B1); PG8_BAR;
            PG8_LDA(At, 0, 1); PG8_STAGE(PG8_SA(0, 0), a2, voffA);
            PG8_BAR; PG8_WAIT_L(0); PG8_MMA(1, 0, At, B0); PG8_BAR; PG8_SCHED;
            PG8_STAGE(PG8_SB(0, 1), b2 + hstepB, voffB);
            PG8_WAIT_V(6); PG8_BAR; PG8_MMA(1, 1, At, B1); PG8_BAR;
            PG8_LDB(B0, 1, 0); PG8_SCHED; PG8_LDA(At, 1, 0); PG8_STAGE(PG8_SA(0, 1), a2 + hstep, voffA);
            PG8_WAIT_L(8); PG8_BAR; PG8_WAIT_L(0); PG8_MMA(0, 0, At, B0); PG8_BAR; PG8_SCHED;
            PG8_LDB(B1, 1, 1); PG8_STAGE(PG8_SB(1, 0), b3, voffB);
            PG8_BAR; PG8_WAIT_L(0); PG8_MMA(0, 1, At, B1); PG8_BAR;
            PG8_LDA(At, 1, 1); PG8_STAGE(PG8_SA(1, 0), a3, voffA);
            PG8_BAR; PG8_WAIT_L(0); PG8_MMA(1, 0, At, B0); PG8_BAR; PG8_SCHED;
            PG8_STAGE(PG8_SB(1, 1), b3 + hstepB, voffB);
            PG8_WAIT_V(6); PG8_BAR; PG8_MMA(1, 1, At, B1); PG8_BAR;
            }
        }
        if constexpr (ALIGN_EPI) { if (wr == 0) PG8_BAR; }
        PG8_UNPACK_W();
        if constexpr (S32) { float s_ = 0.f; _Pragma("unroll") for (int a = 0; a < 2; ++a) _Pragma("unroll") for (int b = 0; b < 2; ++b) _Pragma("unroll") for (int q = 0; q < 2; ++q) { _Pragma("unroll") for (int e_ = 0; e_ < 16; ++e_) s_ += acc32[a][b][q][e_]; acc32[a][b][q] = f32x16w{}; } E.sink[(wr * 4 + wc) * 64 + fq * 16 + fr] = s_; }
        else if constexpr (!Epi::AFTER_DRAIN) { E(acc, cur, wr, wc, fr, fq); S.done(cur); }
        if (!has_next) break;
#pragma unroll
        for (int a = 0; a < 2; ++a)
#pragma unroll
            for (int b = 0; b < 2; ++b)
#pragma unroll
                for (int m = 0; m < 4; ++m)
#pragma unroll
                    for (int n = 0; n < 2; ++n) acc[a][b][m][n] = (f32x4){0.f, 0.f, 0.f, 0.f};
        PG8_ZERO_W();
        cur = nxt; cA = nA; cB = nB; ++ui;
        if constexpr (ALIGN_EPI) { if (wr == 1) PG8_BAR; }
    }
    PG8_WAIT_V(0);
    if constexpr (!ALIGN_EPI) { if (wr == 0) PG8_BAR; }
    PG8_BAR;
    if constexpr (Epi::AFTER_DRAIN) { E.fused(acc, cur, wr, wc, fr, fq, lds, wid, lane); S.done(cur); }
#undef PG8_ZERO_W
#undef PG8_UNPACK_W
#undef PG8_SA
#undef PG8_SB
#undef PG8_STAGE
#undef PG8_LDA
#undef PG8_LDB
#undef PG8_MMA
#undef PG8_WAIT_V
#undef PG8_WAIT_L
#undef PG8_BAR
#undef PG8_SCHED
}
}

#include <hip/hip_bf16.h>
#include <cmath>
namespace attn_body {
using bf16=__hip_bfloat16;
using bf16x8=__attribute__((ext_vector_type(8)))short;
using s16x4=__attribute__((ext_vector_type(4)))short;
using f32x16=__attribute__((ext_vector_type(16)))float;
using u32x4=__attribute__((ext_vector_type(4)))unsigned;
using f32x4v=__attribute__((ext_vector_type(4)))float;
constexpr int BATCH=8,NHEAD=8,SEQ=4096,D=64,DM=NHEAD*D,OPITCH=1536,HP=D;
constexpr int NW=8,QBLK=32,QB=QBLK*NW,KVBLK=64,NQB=SEQ/QB;
constexpr int ATTN_PITCH=DM, ATTN_UNIT_ROWS=QB;
__device__ __forceinline__ int crow(int r,int hi){return (r&3)+8*(r>>2)+4*hi;}
#define SBAR() __builtin_amdgcn_sched_barrier(0)
__device__ __forceinline__ void cmask(f32x16&p0,f32x16&p1,int jb,int qrel,int hi){
  const float NEG=-INFINITY; int kb=64*jb+4*hi;
  #pragma unroll
  for(int r=0;r<16;++r){int kv=kb+(r&3)+8*(r>>2); if(kv>qrel)p0[r]=NEG; if(kv+32>qrel)p1[r]=NEG;}
}

constexpr int NSLOT=3, SLOTB=8192;
constexpr int LDS_K=0, LDS_V=NSLOT*SLOTB, LDS_WS=2*NSLOT*SLOTB, LDS_OST=LDS_WS+NW*64*4, LDS_BYTES=LDS_OST+NW*4096;
constexpr float C2=0.125f*1.4426950408889634f;
__device__ __forceinline__ void glds16(const void*gsrc,unsigned lds_dst){unsigned keep;
  asm volatile("s_mov_b32 %0, m0\n\ts_mov_b32 m0, %2\n\ts_nop 0\n\tglobal_load_lds_dwordx4 %1, off\n\ts_mov_b32 m0, %0":"=&s"(keep):"v"(gsrc),"s"(lds_dst):"memory");}
__device__ __forceinline__ float max3f(float a,float b,float c){float r;asm("v_max3_f32 %0, %1, %2, %3":"=v"(r):"v"(a),"v"(b),"v"(c));return r;}
__device__ __forceinline__ float max2f(float a,float b){float r;asm("v_max_f32_e32 %0, %1, %2":"=v"(r):"v"(a),"v"(b));return r;}
__device__ __forceinline__ float fadd_s(float a,float b){float r;asm("v_add_f32_e32 %0, %1, %2":"=v"(r):"v"(a),"v"(b));return r;}
__device__ __forceinline__ float fsub_s(float a,float b){float r;asm("v_sub_f32_e32 %0, %1, %2":"=v"(r):"v"(a),"v"(b));return r;}
typedef float f32x2_t __attribute__((ext_vector_type(2))); typedef __bf16 bf16x2_t __attribute__((ext_vector_type(2)));
__device__ __forceinline__ unsigned cvtpk_s(float lo,float hi){f32x2_t v={lo,hi};bf16x2_t b=__builtin_convertvector(v,bf16x2_t);return __builtin_bit_cast(unsigned,b);}
#define WAIT_BAR(N) asm volatile("s_waitcnt vmcnt(" #N ") lgkmcnt(0)\n\ts_barrier":::"memory")

__device__ __forceinline__ void qkt(f32x16&p0,f32x16&p1,const char*Kslot,const bf16x8*qr,const f32x16&negm,int r32,int hi){
  const char*kb=Kslot+hi*1024+r32*16;
  #pragma unroll
  for(int d0=0;d0<4;++d0){
    const bf16x8 b0=*reinterpret_cast<const bf16x8*>(kb+d0*2048);
    const bf16x8 b1=*reinterpret_cast<const bf16x8*>(kb+d0*2048+512);
    if(d0==0){p0=__builtin_amdgcn_mfma_f32_32x32x16_bf16(b0,qr[0],negm,0,0,0);p1=__builtin_amdgcn_mfma_f32_32x32x16_bf16(b1,qr[0],negm,0,0,0);}
    else{p0=__builtin_amdgcn_mfma_f32_32x32x16_bf16(b0,qr[d0],p0,0,0,0);p1=__builtin_amdgcn_mfma_f32_32x32x16_bf16(b1,qr[d0],p1,0,0,0);}}
}
typedef __attribute__((address_space(3))) const char* lds_cptr;
typedef short v4i16_t __attribute__((ext_vector_type(4)));
__device__ __forceinline__ void kload8(bf16x8*kf,lds_cptr kp){
  kf[0]=*(const __attribute__((address_space(3))) bf16x8*)(kp);      kf[1]=*(const __attribute__((address_space(3))) bf16x8*)(kp+512);
  kf[2]=*(const __attribute__((address_space(3))) bf16x8*)(kp+2048); kf[3]=*(const __attribute__((address_space(3))) bf16x8*)(kp+2560);
  kf[4]=*(const __attribute__((address_space(3))) bf16x8*)(kp+4096); kf[5]=*(const __attribute__((address_space(3))) bf16x8*)(kp+4608);
  kf[6]=*(const __attribute__((address_space(3))) bf16x8*)(kp+6144); kf[7]=*(const __attribute__((address_space(3))) bf16x8*)(kp+6656);
}
__device__ __forceinline__ void kload2(bf16x8*kf,lds_cptr kp,int j){ kf[2*j]=*(const __attribute__((address_space(3))) bf16x8*)(kp+j*2048); kf[2*j+1]=*(const __attribute__((address_space(3))) bf16x8*)(kp+j*2048+512); }
__device__ __forceinline__ s16x4 vtr(lds_cptr p){ return __builtin_bit_cast(s16x4,__builtin_amdgcn_ds_read_tr16_b64_v4i16((__attribute__((address_space(3))) v4i16_t*)p)); }
__device__ __forceinline__ float rowmax(const f32x16&p0,const f32x16&p1){
  float a=max3f(p0[0],p0[1],p1[0]),b=max3f(p0[2],p0[3],p1[1]);a=max3f(a,p1[2],p1[3]);
  #pragma unroll
  for(int r=4;r<16;r+=4){a=max3f(a,p0[r],p0[r+1]);b=max3f(b,p0[r+2],p0[r+3]);a=max3f(a,p1[r],p1[r+1]);b=max3f(b,p1[r+2],p1[r+3]);}
  const float m=max2f(a,b);
  auto rr=__builtin_amdgcn_permlane32_swap(__float_as_uint(m),__float_as_uint(m),false,false);
  return max2f(__uint_as_float(rr[0]),__uint_as_float(rr[1]));
}
__device__ __forceinline__ void pv(f32x16*o,int vb,bf16x8 pa0,bf16x8 pa1,bf16x8 pa2,bf16x8 pa3){
  #pragma unroll
  for(int d0=0;d0<2;++d0){s16x4 lo[4],hi[4];
    #pragma unroll
    for(int ks=0;ks<4;++ks){
      asm volatile("ds_read_b64_tr_b16 %0,%1 offset:%c2":"=&v"(lo[ks]):"v"(vb),"i"(d0*4096+ks*1024):"memory");
      asm volatile("ds_read_b64_tr_b16 %0,%1 offset:%c2":"=&v"(hi[ks]):"v"(vb),"i"(d0*4096+ks*1024+512):"memory");}
    asm volatile("s_waitcnt lgkmcnt(0)":::"memory");SBAR();
    #define PK(k) (bf16x8){lo[k][0],lo[k][1],lo[k][2],lo[k][3],hi[k][0],hi[k][1],hi[k][2],hi[k][3]}
    o[d0]=__builtin_amdgcn_mfma_f32_32x32x16_bf16(pa0,PK(0),o[d0],0,0,0);
    o[d0]=__builtin_amdgcn_mfma_f32_32x32x16_bf16(pa1,PK(1),o[d0],0,0,0);
    o[d0]=__builtin_amdgcn_mfma_f32_32x32x16_bf16(pa2,PK(2),o[d0],0,0,0);
    o[d0]=__builtin_amdgcn_mfma_f32_32x32x16_bf16(pa3,PK(3),o[d0],0,0,0);
    #undef PK
  }
}

#ifndef ATTN_STORE16
#define ATTN_STORE16(p,v) (*(u32x4*)(p)=(v))
#endif
template<int THRL,bool MOBA> __device__ __forceinline__ void attn_unit(int b,int h,int qb,const bf16*Q,const bf16*__restrict__ K,const bf16*__restrict__ V,bf16*O,const float*kmsum,float*ssq,char*shm){
  int tid_=threadIdx.x; asm volatile("":"+v"(tid_)); const int tid=tid_,lane=tid&63,r32=lane&31,hi=lane>>5; const int wid=__builtin_amdgcn_readfirstlane(tid>>6);
  const long rowbase=(long)b*SEQ; const int q0=qb*QB;
  const long hbase=((long)(b*NHEAD+h)*SEQ)*HP;
  const bf16*Qw=Q+hbase+(long)(q0+wid*QBLK)*HP;
  const bf16*Kh=K+hbase,*Vh=V+hbase;
  const unsigned lds0=(unsigned)(uintptr_t)shm;
  float*wsf=(float*)(shm+LDS_WS)+wid*64;
  const bf16*ksrc=Kh+(long)lane*HP+wid*8;
  const bf16*vsrc=Vh+(long)(16*(wid&3)+(lane>>2))*HP+(wid>>2)*32+(lane&3)*8;
  const unsigned kdst=lds0+LDS_K+wid*1024, vdst=lds0+LDS_V+wid*1024;
  #define DMA_K(t,slot) glds16(ksrc+(long)(t)*KVBLK*HP,(unsigned)__builtin_amdgcn_readfirstlane(kdst+(slot)))
  #define DMA_V(t,slot) glds16(vsrc+(long)(t)*KVBLK*HP,(unsigned)__builtin_amdgcn_readfirstlane(vdst+(slot)))
  const int vb0=(int)(lds0+LDS_V)+((lane>>4)&1)*32+(lane&3)*8+(4*hi+((lane&15)>>2))*64;
  const char*Kbase=shm+LDS_K; bf16x8 kf[8];
  const lds_cptr shm3=(lds_cptr)shm; const lds_cptr kp0=shm3+LDS_K+hi*1024+r32*16; const lds_cptr vp0=shm3+LDS_V+((lane>>4)&1)*32+(lane&3)*8+(4*hi+((lane&15)>>2))*64;
  const int NT=(q0+QB)/KVBLK;
  DMA_K(0,0);DMA_V(0,0);DMA_K(1,SLOTB);
  bf16x8 qr[4];
  #pragma unroll
  for(int d0=0;d0<4;++d0)qr[d0]=*reinterpret_cast<const bf16x8*>(&Qw[(long)r32*HP+d0*16+hi*8]);
  if(MOBA){ const int n_=tid>>5, d_=(tid&31)*2; const float*src_=kmsum+((long)b*16+n_)*DM+h*D+d_; const float k0_=src_[0],k1_=src_[1];
    float*kml_=(float*)(shm+LDS_BYTES)+n_*64+d_; kml_[0]=k0_; kml_[1]=k1_; }
  unsigned selmask=0u;
  float mhat=0.f,l_reg=0.f;f32x16 o[2];o[0]=f32x16{};o[1]=f32x16{};
  const int qrel=wid*QBLK+r32;
  #define SELM(P0,P1,t) do{ const float bs_=(!MOBA||((selmask>>((t)>>2))&1u))?-mhat:-INFINITY; _Pragma("unroll") for(int r_=0;r_<16;++r_){P0[r_]+=bs_;P1[r_]+=bs_;} }while(0)
  #define CMASK(P0,P1,t) do{int jb_=(t)-(NT-4); if(jb_>=0){ const float bm_=-mhat; _Pragma("unroll") for(int r_=0;r_<16;++r_){P0[r_]+=bm_;P1[r_]+=bm_;} cmask(P0,P1,jb_,qrel,hi);} else SELM(P0,P1,t);}while(0)
  bool resc=false;
  #define START(P0,P1) do{ const float rm=rowmax(P0,P1); resc=false; \
    { const float dl=(rm>-1e30f)?rm:0.f; mhat=fadd_s(mhat,dl); \
      _Pragma("unroll") for(int r=0;r<16;++r){P0[r]=fsub_s(P0[r],dl);P1[r]=fsub_s(P1[r],dl);} \
      } \
    _Pragma("unroll") for(int r=0;r<16;++r)P0[r]=__builtin_amdgcn_exp2f(P0[r]); }while(0)
  #define RESC() do{ if(resc){ asm volatile("s_waitcnt lgkmcnt(0)":::"memory"); \
      _Pragma("unroll") for(int d_=0;d_<2;++d_) _Pragma("unroll") for(int r=0;r<16;++r)o[d_][r]*=wsf[crow(r,hi)]; } }while(0)
  f32x16 pA0,pA1,pB0,pB1;
  int sl_prev=0,sl_cur=0,sl_next=SLOTB;
  #define ROT() do{sl_prev=sl_cur;sl_cur=sl_next;sl_next=(sl_next==(NSLOT-1)*SLOTB)?0:sl_next+SLOTB;}while(0)
  DMA_K(2,2*SLOTB);
  if(MOBA) asm volatile("s_waitcnt lgkmcnt(0)\n\ts_barrier":::"memory");
  if(MOBA){ float g[16];
    #pragma unroll
    for(int n=0;n<16;++n)g[n]=-INFINITY;
    const float*kmb=(const float*)(shm+LDS_BYTES)+hi*8;
    #pragma unroll
    for(int n=0;n<15;++n){ if(n<qb){ float a=0.f;
        #pragma unroll
        for(int d0=0;d0<4;++d0){ const f32x4v k0=*reinterpret_cast<const f32x4v*>(kmb+n*64+d0*16), k1=*reinterpret_cast<const f32x4v*>(kmb+n*64+d0*16+4);
          #pragma unroll
          for(int j=0;j<4;++j){ a+=__uint_as_float(((unsigned)(unsigned short)qr[d0][j])<<16)*k0[j]; a+=__uint_as_float(((unsigned)(unsigned short)qr[d0][4+j])<<16)*k1[j]; } }
        a=sum32(a); g[n]=a; } }
    #pragma unroll
    for(int j=0;j<3;++j){ int best=-1; float bv=-INFINITY;
      #pragma unroll
      for(int n=0;n<15;++n) if(g[n]>bv){bv=g[n];best=n;}
      if(best>=0)selmask|=1u<<best;
      #pragma unroll
      for(int n=0;n<15;++n) if(n==best)g[n]=-INFINITY; } }
  WAIT_BAR(3);
  qkt(pA0,pA1,Kbase,qr,f32x16{},r32,hi);asm volatile("s_nop 15\n\ts_nop 7":"+v"(pA0),"+v"(pA1));CMASK(pA0,pA1,0);
  START(pA0,pA1);
  _Pragma("unroll") for(int r=0;r<16;++r)pA1[r]=__builtin_amdgcn_exp2f(pA1[r]);
  WAIT_BAR(0);
  DMA_K(3,0);DMA_V(1,SLOTB);
  ROT();
  kload8(kf,kp0+sl_cur);
  WAIT_BAR(2);
  s16x4 vlo[8],vhi[8]; u32x4 pw0,pw1,pw2,pw3;
  #define PKW(P,B) cvtpk_s(P[B],P[B+1])
  #define PAF(k) __builtin_bit_cast(bf16x8,pw##k)
  #define VFR(i) (bf16x8){vlo[i][0],vlo[i][1],vlo[i][2],vlo[i][3],vhi[i][0],vhi[i][1],vhi[i][2],vhi[i][3]}
  #define PIN(x) asm volatile("":"+v"(x))
  #define MX3(a,b,c) __builtin_fmaxf(__builtin_fmaxf((a),(b)),(c))
  #define GAPA(MF,A0,A1,A2,A3,W0,W1,PW) do{ MF; sacc+=A0; sacc+=A1; sacc+=A2; sacc+=A3; PIN(sacc); W0; W1; PIN(PW); SBAR(); }while(0)
  #define EX(v) __builtin_amdgcn_exp2f(v)
  #define GAPB(MF,X,B) do{ MF; X[B]=EX(X[B]); X[B+1]=EX(X[B+1]); X[B+2]=EX(X[B+2]); X[B+3]=EX(X[B+3]); PIN(X); SBAR(); }while(0)
  #define VRD(i) do{ vlo[i]=vtr(vp_+(((i)>>2)*4096+((i)&3)*1024)); vhi[i]=vtr(vp_+(((i)>>2)*4096+((i)&3)*1024+512)); }while(0)
  #define KRD(G,j) do{ if(G){ kload2(kf,kp0+sl_next,j); SBAR(); } }while(0)
  #define STEP(C0,C1,P0,P1,t,GK,GV,GL) do{ SBAR(); \
    const lds_cptr vp_=vp0+sl_prev; \
    VRD(0); SBAR(); float sacc=(P0[0]+P0[1]); \
    GAPA(C0=__builtin_amdgcn_mfma_f32_32x32x16_bf16(kf[0],qr[0],(f32x16{}),0,0,0), P0[2],P0[3],P0[4],P0[5],     pw0[0]=PKW(P0,0), pw0[1]=PKW(P0,2), pw0); \
    VRD(4); SBAR(); GAPA(C1=__builtin_amdgcn_mfma_f32_32x32x16_bf16(kf[1],qr[0],(f32x16{}),0,0,0), P0[6],P0[7],P0[8],P0[9],     pw0[2]=PKW(P0,4), pw0[3]=PKW(P0,6), pw0); \
    VRD(1); SBAR(); GAPA(C0=__builtin_amdgcn_mfma_f32_32x32x16_bf16(kf[2],qr[1],C0,0,0,0),   P0[10],P0[11],P0[12],P0[13], pw1[0]=PKW(P0,8), pw1[1]=PKW(P0,10), pw1); \
    VRD(5); SBAR(); GAPA(C1=__builtin_amdgcn_mfma_f32_32x32x16_bf16(kf[3],qr[1],C1,0,0,0),   P0[14],P0[15],P1[0],P1[1],   pw1[2]=PKW(P0,12),pw1[3]=PKW(P0,14), pw1); \
    VRD(2); SBAR(); GAPA(C0=__builtin_amdgcn_mfma_f32_32x32x16_bf16(kf[4],qr[2],C0,0,0,0),   P1[2],P1[3],P1[4],P1[5],     pw2[0]=PKW(P1,0), pw2[1]=PKW(P1,2), pw2); \
    VRD(6); SBAR(); GAPA(C1=__builtin_amdgcn_mfma_f32_32x32x16_bf16(kf[5],qr[2],C1,0,0,0),   P1[6],P1[7],P1[8],P1[9],     pw2[2]=PKW(P1,4), pw2[3]=PKW(P1,6), pw2); \
    VRD(3); SBAR(); GAPA(C0=__builtin_amdgcn_mfma_f32_32x32x16_bf16(kf[6],qr[3],C0,0,0,0),   P1[10],P1[11],P1[12],P1[13], pw3[0]=PKW(P1,8), pw3[1]=PKW(P1,10), pw3); \
    VRD(7); SBAR(); GAPA(C1=__builtin_amdgcn_mfma_f32_32x32x16_bf16(kf[7],qr[3],C1,0,0,0),   P1[14],P1[15],0.f,0.f,       pw3[2]=PKW(P1,12),pw3[3]=PKW(P1,14), pw3); \
    l_reg+=sacc; \
    if(GK){DMA_K((t)+3,sl_cur);} if(GV){DMA_V((t)+1,sl_next);} \
    CMASK(C0,C1,t); \
    { float a=MX3(C0[0],C0[1],C1[0]),b=MX3(C0[2],C0[3],C1[1]); a=MX3(a,C1[2],C1[3]); \
      _Pragma("unroll") for(int r=4;r<16;r+=4){a=MX3(a,C0[r],C0[r+1]);b=MX3(b,C0[r+2],C0[r+3]);a=MX3(a,C1[r],C1[r+1]);b=MX3(b,C1[r+2],C1[r+3]);} \
      float rm=__builtin_fmaxf(a,b); { auto rr=__builtin_amdgcn_permlane32_swap(__float_as_uint(rm),__float_as_uint(rm),false,false); rm=__builtin_fmaxf(__uint_as_float(rr[0]),__uint_as_float(rr[1])); } \
      resc=false; \
      if(__builtin_expect(__any(rm>(float)THRL),0)){ const float dl=__builtin_fmaxf(rm,0.f); mhat+=dl; \
        _Pragma("unroll") for(int r=0;r<16;++r){C0[r]-=dl;C1[r]-=dl;} \
        const float f=__builtin_amdgcn_exp2f(-dl); l_reg*=f; if(hi==0)wsf[r32]=f; resc=true; } } \
    SBAR(); \
    GAPB(o[0]=__builtin_amdgcn_mfma_f32_32x32x16_bf16(PAF(0),VFR(0),o[0],0,0,0), C0,0); \
    GAPB(o[1]=__builtin_amdgcn_mfma_f32_32x32x16_bf16(PAF(0),VFR(4),o[1],0,0,0), C0,4); \
    KRD(GL,0); GAPB(o[0]=__builtin_amdgcn_mfma_f32_32x32x16_bf16(PAF(1),VFR(1),o[0],0,0,0), C0,8); \
    KRD(GL,1); GAPB(o[1]=__builtin_amdgcn_mfma_f32_32x32x16_bf16(PAF(1),VFR(5),o[1],0,0,0), C0,12); \
    KRD(GL,2); GAPB(o[0]=__builtin_amdgcn_mfma_f32_32x32x16_bf16(PAF(2),VFR(2),o[0],0,0,0), C1,0); \
    KRD(GL,3); GAPB(o[1]=__builtin_amdgcn_mfma_f32_32x32x16_bf16(PAF(2),VFR(6),o[1],0,0,0), C1,4); \
    GAPB(o[0]=__builtin_amdgcn_mfma_f32_32x32x16_bf16(PAF(3),VFR(3),o[0],0,0,0), C1,8); \
    GAPB(o[1]=__builtin_amdgcn_mfma_f32_32x32x16_bf16(PAF(3),VFR(7),o[1],0,0,0), C1,12); \
    }while(0)
  int t=1;
  #undef CMASK
  #define CMASK(P0,P1,t) SELM(P0,P1,t)
  for(;t+5<NT;t+=2){
    STEP(pB0,pB1,pA0,pA1,t,true,true,true);     WAIT_BAR(2); RESC(); ROT();
    STEP(pA0,pA1,pB0,pB1,t+1,true,true,true);   WAIT_BAR(2); RESC(); ROT();
  }
  #undef CMASK
  #define CMASK(P0,P1,t) do{int jb_=(t)-(NT-4); if(jb_>=0){ const float bm_=-mhat; _Pragma("unroll") for(int r_=0;r_<16;++r_){P0[r_]+=bm_;P1[r_]+=bm_;} cmask(P0,P1,jb_,qrel,hi);} else SELM(P0,P1,t);}while(0)
  #define ENDW(tt) do{ if((tt)+3<NT){WAIT_BAR(2);} else if((tt)+2<NT){WAIT_BAR(1);} else {WAIT_BAR(0);} }while(0)
  for(;t+1<NT;t+=2){
    STEP(pB0,pB1,pA0,pA1,t,(t+3<NT),(t+1<NT),(t+1<NT));       ENDW(t);   RESC(); ROT();
    STEP(pA0,pA1,pB0,pB1,t+1,(t+4<NT),(t+2<NT),(t+2<NT));     ENDW(t+1); RESC(); ROT();
  }
  STEP(pB0,pB1,pA0,pA1,NT-1,false,false,false); RESC();
  { float sacc=pB0[0]+pB0[1]; _Pragma("unroll") for(int r=2;r<16;++r)sacc+=pB0[r]; _Pragma("unroll") for(int r=0;r<16;++r)sacc+=pB1[r]; l_reg+=sacc;
    pw0=(u32x4){PKW(pB0,0),PKW(pB0,2),PKW(pB0,4),PKW(pB0,6)};pw1=(u32x4){PKW(pB0,8),PKW(pB0,10),PKW(pB0,12),PKW(pB0,14)};pw2=(u32x4){PKW(pB1,0),PKW(pB1,2),PKW(pB1,4),PKW(pB1,6)};pw3=(u32x4){PKW(pB1,8),PKW(pB1,10),PKW(pB1,12),PKW(pB1,14)};
    SBAR(); pv(o,vb0+sl_cur,PAF(0),PAF(1),PAF(2),PAF(3)); }
  #undef PKW
  #undef PAF
  #undef VFR
  #undef PIN
  #undef MX3
  #undef GAPA
  #undef GAPB
  #undef EX
  #undef VRD
  #undef KRD
  #undef STEP
  #undef ENDW
  {auto rr=__builtin_amdgcn_permlane32_swap(__float_as_uint(l_reg),__float_as_uint(l_reg),false,false);l_reg=__uint_as_float(rr[0])+__uint_as_float(rr[1]);}
  if(hi==0)wsf[32+r32]=l_reg;asm volatile("s_waitcnt lgkmcnt(0)":::"memory");
  float rli[16];
  #pragma unroll
  for(int r=0;r<16;++r)rli[r]=__builtin_amdgcn_rcpf(wsf[32+crow(r,hi)]);
  bf16*Ow=O+(rowbase+q0+wid*QBLK)*OPITCH+h*D;
  { bf16*stg=(bf16*)(shm+LDS_OST)+wid*2048;
    #pragma unroll
    for(int r=0;r<16;++r){const int orow=crow(r,hi);
      #pragma unroll
      for(int d0=0;d0<2;++d0)stg[orow*64+d0*32+r32]=__float2bfloat16(o[d0][r]*rli[r]);}
    asm volatile("s_waitcnt lgkmcnt(0)":::"memory");
    #pragma unroll
    for(int i=0;i<4;++i){const int row=i*8+(lane>>3),ch=lane&7; const u32x4 v=*(const u32x4*)(stg+row*64+ch*8); ATTN_STORE16(Ow+(long)row*OPITCH+ch*8,v);
      float sq=0.f;
      #pragma unroll
      for(int e=0;e<4;++e){const float lo=__uint_as_float(v[e]<<16),hi_=__uint_as_float(v[e]&0xffff0000u); sq+=lo*lo+hi_*hi_;}
      sq+=shx(sq,1);sq+=shx(sq,2);sq+=shx(sq,4); if(ch==0)atomicAdd(ssq+rowbase+q0+wid*QBLK+row,sq);} }
  asm volatile("s_waitcnt lgkmcnt(0)\n\ts_barrier":::"memory");
  #undef DMA_K
  #undef DMA_V
  #undef CMASK
  #undef SELM
  #undef START
  #undef RESC
  #undef ROT
}
constexpr int ATTN_LDS_BYTES=LDS_BYTES;
struct AttnTensors { const bf16* Q; const bf16* K; const bf16* V; bf16* O; const float* kmsum; float* ssq; };
struct AttnUnit { int bh; int qb; };
struct StaticOrder {
  int vcu,G;
  __device__ __forceinline__ explicit StaticOrder(int grid,int vcu_):vcu(vcu_),G(grid){}
  __device__ __forceinline__ bool next(int i,AttnUnit&u)const{ const int k=vcu+i*G; if(k>=1024)return false; const int v=k&255,ii=k>>8,s=v&7; u.bh=(v>>3)+32*(ii>>1); u.qb=(ii&1)?s:15-s; return true; }
  __device__ __forceinline__ void a_ready(const AttnUnit&)const{}
  __device__ __forceinline__ void done(const AttnUnit&)const{}
};
template<class Sched,bool MOBA=true,int THRL=8> __device__ __forceinline__ void attn_phase(char*lds,const AttnTensors&T,const Sched&S){
  AttnUnit u;
  for(int i=0;S.next(i,u);++i){ S.a_ready(u); attn_unit<THRL,MOBA>(u.bh/NHEAD,u.bh%NHEAD,u.qb,T.Q,T.K,T.V,T.O,T.kmsum,T.ssq,lds); S.done(u); }
}
template<class Sched,bool MOBA=true,int THRL=8> __device__ __forceinline__ void attn_range(char*lds,const AttnTensors&T,const Sched&S,const int i0,const int i1){
  AttnUnit u;
  for(int i=i0;i<i1&&S.next(i,u);++i){ attn_unit<THRL,MOBA>(u.bh/NHEAD,u.bh%NHEAD,u.qb,T.Q,T.K,T.V,T.O,T.kmsum,T.ssq,lds); }
}
#undef SBAR
#undef WAIT_BAR
}

constexpr int NWAVES = 8;
constexpr int BATCH = 8, SEQ = 4096, T = BATCH * SEQ, DMODEL = 1024, DFF = 2816, NCHUNK = 16;
constexpr int DATTN = 512, DSSM = 1024, DCONV = 1536, NPROJ = 4112, DMIX = 1536, NHSSM = 16, DSTATE = 128;
constexpr size_t MiB = 1u << 20;
constexpr size_t WS_CTL = 0, WS_ACC = 1 * MiB, CTL_ZERO_BYTES = 2 * MiB;
constexpr size_t ACC_SSX1 = WS_ACC, ACC_SSX2 = WS_ACC + 128 * 1024, ACC_SSX3 = WS_ACC + 256 * 1024, ACC_SSA = WS_ACC + 384 * 1024, ACC_SSG = WS_ACC + 512 * 1024  , ACC_KM = WS_ACC + 768 * 1024  ;
constexpr size_t WS_SSX0 = 2 * MiB, WS_CS = 2 * MiB + 256 * 1024  , WS_DTRAW = 3 * MiB  , WS_DTH = 5 * MiB  , WS_ACSH = 7 * MiB;
constexpr size_t WS_W13 = 10 * MiB  , WS_W2 = 21 * MiB  , WS_WIN = 27 * MiB  , WS_WDT = 35 * MiB  , WS_WOUT = 36 * MiB  ;
constexpr size_t WS_XB = 48 * MiB;
constexpr size_t WS_XT = 112 * MiB;
constexpr size_t WS_R = 240 * MiB;
constexpr size_t WS_Q = WS_R, WS_K = WS_R + 32 * MiB, WS_V = WS_R + 64 * MiB, WS_Z = WS_R + 96 * MiB, WS_BT = WS_R + 160 * MiB;
constexpr size_t WS_S = 416 * MiB;
constexpr size_t WS_ST = WS_S, WS_SP = WS_S + 64 * MiB;
constexpr size_t WS_XA8 = 176 * MiB;
constexpr size_t WS_END = 512 * MiB;
constexpr size_t DO_OY = 0, DO_BC = 96 * MiB;
constexpr int CW_BAR = 4096;
constexpr int CW_PANEL = 16384;
constexpr int RING_OFF = 0, RING_BYTES = 131072, LDSCTL_OFF = RING_BYTES, MISC_OFF = LDSCTL_OFF + 320, TAB_OFF = LDSCTL_OFF + 1024  , LDS_BYTES = 147456;
static_assert(TAB_OFF + 8 * 384 * 4 <= LDS_BYTES, "LDS map");

#define GAS __attribute__((address_space(1)))
#define LAS __attribute__((address_space(3)))
typedef unsigned short bf16;
typedef unsigned v4u __attribute__((ext_vector_type(4)));
typedef float f32x4 __attribute__((ext_vector_type(4)));
typedef short bf16x8 __attribute__((ext_vector_type(8)));
typedef GAS unsigned gu32;
typedef GAS unsigned long long gu64;
#define RLX_AGENT __ATOMIC_RELAXED, __HIP_MEMORY_SCOPE_AGENT
#define LDS_WAIT() asm volatile("s_waitcnt lgkmcnt(0)" ::: "memory")
#define VM_WAIT() asm volatile("s_waitcnt vmcnt(0)" ::: "memory")
__device__ __forceinline__ unsigned long long rt() { return __builtin_amdgcn_s_memrealtime(); }
__device__ __forceinline__ unsigned f2bf(float f) { unsigned u = __builtin_bit_cast(unsigned, f); return (u + 0x7fffu + ((u >> 16) & 1u)) >> 16; }
__device__ __forceinline__ unsigned pk2(float lo, float hi) { return f2bf(lo) | (f2bf(hi) << 16); }

#define XB_TMO      128
#define XB_XCNT(j)  (256  + 64 * (j))
#define XB_XSUB(j)  (1280 + 64 * (j))
#define XB_XGEN(j)  (2304 + 64 * (j))
#define XB_TOP      3328
#define XB_TOPGEN   3392
#define XCD_BAR_WORDS 3456
#define XB_SPIN_CAP (1u << 18)

__device__ __forceinline__ unsigned xb_ld(unsigned* p)              { return __hip_atomic_load(p, __ATOMIC_RELAXED, __HIP_MEMORY_SCOPE_AGENT); }
__device__ __forceinline__ unsigned xb_add(unsigned* p, unsigned v) { return __hip_atomic_fetch_add(p, v, __ATOMIC_RELAXED, __HIP_MEMORY_SCOPE_AGENT); }
__device__ __forceinline__ unsigned xb_xcc_id() { return (unsigned)__builtin_amdgcn_s_getreg((3 << 11) | 20) & 0xFu; }
#define XB_SPIN(cond, bar) do { unsigned _sp = 0; while (cond) { __builtin_amdgcn_s_sleep(1); \
    if ((++_sp & 255u) == 0u) { if (xb_ld(&(bar)[XB_TMO])) break; if (_sp > XB_SPIN_CAP) { atomicAdd(&(bar)[XB_TMO], 1u); break; } } } } while (0)

struct XcdBarrier {
    unsigned* bar; unsigned x;
    volatile LAS unsigned* st;
};

__device__ __forceinline__ XcdBarrier xcd_barrier_post(unsigned* bar, volatile LAS unsigned* st) {
    XcdBarrier b; b.bar = bar; b.x = xb_xcc_id(); b.st = st;
    if (threadIdx.x == 0) (void)xb_add(&bar[XB_XCNT(b.x)], 1u);
    return b;
}
__device__ __forceinline__ void xcd_barrier_complete(unsigned* bar, unsigned x, unsigned& nloc, unsigned& nx) {
    const unsigned G = gridDim.x * gridDim.y * gridDim.z;
    unsigned sum, cnt, mine, sp = 0u;
    for (;;) {
        sum = 0u; cnt = 0u; mine = 0u;
#pragma unroll
        for (unsigned j = 0; j < 16; ++j) { const unsigned c = xb_ld(&bar[XB_XCNT(j)]); sum += c; cnt += (c > 0u) ? 1u : 0u; mine = (j == x) ? c : mine; }
        if (sum == G) break;
        __builtin_amdgcn_s_sleep(1);
        if ((++sp & 255u) == 0u) { if (xb_ld(&bar[XB_TMO])) break; if (sp > XB_SPIN_CAP) { atomicAdd(&bar[XB_TMO], 1u); break; } }
    }
    nloc = mine > 0u ? mine : 1u; nx = cnt > 0u ? cnt : 1u;
}

__device__ __forceinline__ void xcd_barrier(const XcdBarrier& b) {
    asm volatile("s_waitcnt vmcnt(0)" ::: "memory");
    __syncthreads();
    if (threadIdx.x == 0) {
        unsigned* bar = b.bar;
        __builtin_amdgcn_s_waitcnt(0);
        unsigned nloc = b.st[0], nx = b.st[1];
        if (nloc == 0u) { xcd_barrier_complete(bar, b.x, nloc, nx); b.st[0] = nloc; b.st[1] = nx; }
        const unsigned old = xb_add(&bar[XB_XSUB(b.x)], 1u);
        const unsigned gen = old / nloc;
        if (old + 1u == (gen + 1u) * nloc) {
            __builtin_amdgcn_fence(__ATOMIC_RELEASE, "agent");
            asm volatile("s_waitcnt vmcnt(0)" ::: "memory");
            const unsigned og = xb_add(&bar[XB_TOP], 1u);
            const unsigned tg = og / nx;
            if (og + 1u == (tg + 1u) * nx) xb_add(&bar[XB_TOPGEN], 1u);
            else XB_SPIN(xb_ld(&bar[XB_TOPGEN]) == tg, bar);
            __builtin_amdgcn_fence(__ATOMIC_ACQUIRE, "agent");
            xb_add(&bar[XB_XGEN(b.x)], 1u);
            asm volatile("s_waitcnt vmcnt(0)" ::: "memory");
        } else {
            XB_SPIN(xb_ld(&bar[XB_XGEN(b.x)]) == gen, bar);
            __builtin_amdgcn_fence(__ATOMIC_ACQUIRE, "agent");
            asm volatile("s_waitcnt vmcnt(0)" ::: "memory");
        }
    }
    __syncthreads();
}

typedef float f32x16 __attribute__((ext_vector_type(16)));
typedef unsigned u32x2v __attribute__((ext_vector_type(2)));
__device__ __forceinline__ float bf2f(unsigned short h) { return __uint_as_float(((unsigned)h) << 16); }
__device__ __forceinline__ unsigned pkbf(float lo, float hi) { return pg8::cvt_pk_bf16(lo, hi); }
__device__ __forceinline__ int crow(int r, int hi) { return (r & 3) + 8 * (r >> 2) + 4 * hi; }
__device__ __forceinline__ int perm16(int i) { return 8 * ((i & 7) >> 2) + 4 * (i >> 3) + (i & 3); }

struct Frame {
    LAS unsigned char* lds;
    volatile LAS unsigned* MISC;
    gu32* ctl;
    int tid, lane, wave, vcu, G;
    float* out; unsigned char* ws;
};
struct Args { const float* in[20]; float* out; unsigned char* ws; };
__device__ __forceinline__ const float* inp(int i) { const __attribute__((address_space(4))) Args* p = (const __attribute__((address_space(4))) Args*)__builtin_amdgcn_kernarg_segment_ptr(); asm volatile("" : "+s"(p)); return p->in[i]; }
__device__ __forceinline__ float wave_sum(float v) {
#pragma unroll
    for (int o = 1; o < 64; o <<= 1) v += shx(v, o);
    return v;
}

__device__ __forceinline__ void wconv_item(const float* W, int K, int N, int item, int mode, const float* gain, const float* gain2, bf16* dst, bf16* dst2, LAS float* scr, int lane) {
    const int nblk = (N + 31) / 32, kb = item / nblk, nb = item % nblk, k0 = 64 * kb, n0 = 32 * nb;
    const bool nok = (n0 + (lane & 31)) < N;
    float wv_[32];
#pragma unroll
    for (int i = 0; i < 32; ++i) { const int kk = 2 * i + (lane >> 5); wv_[i] = nok ? ((const GAS float*)W)[(size_t)(k0 + kk) * N + n0 + (lane & 31)] : 0.f; }
#pragma unroll
    for (int i = 0; i < 32; ++i) { const int kk = 2 * i + (lane >> 5); scr[kk * 33 + (lane & 31)] = wv_[i]; }
    if (false)
    for (int i = 0; i < 32; ++i) { const int kk = 2 * i + (lane >> 5); scr[kk * 33 + (lane & 31)] = nok ? ((const GAS float*)W)[(size_t)(k0 + kk) * N + n0 + (lane & 31)] : 0.f; }
    LDS_WAIT(); asm volatile("" ::: "memory");
    const int c = lane & 7;
    float gv[8];
#pragma unroll
    for (int e = 0; e < 8; ++e) gv[e] = 1.0f;
    if (gain) {
        const int kb8 = k0 + 8 * c; const GAS float* gp = (gain2 && kb8 >= 512) ? (const GAS float*)gain2 + (kb8 - 512) : (const GAS float*)gain + kb8;
        const f32x4 g0 = *(const GAS f32x4*)gp, g1 = *(const GAS f32x4*)(gp + 4);
        gv[0] = g0.x; gv[1] = g0.y; gv[2] = g0.z; gv[3] = g0.w; gv[4] = g1.x; gv[5] = g1.y; gv[6] = g1.z; gv[7] = g1.w; }
#pragma unroll
    for (int j = 0; j < 4; ++j) { const int nl = (lane >> 3) + 8 * j, n = n0 + nl; const LAS float* s = scr + (8 * c) * 33 + nl;
        v4u o; o.x = pkbf(s[0 * 33] * gv[0], s[1 * 33] * gv[1]); o.y = pkbf(s[2 * 33] * gv[2], s[3 * 33] * gv[3]); o.z = pkbf(s[4 * 33] * gv[4], s[5 * 33] * gv[5]); o.w = pkbf(s[6 * 33] * gv[6], s[7 * 33] * gv[7]);
        bf16* d = dst; int nr = n;
        if (mode == 1) nr = 256 * (n >> 7) + (n & 127); else if (mode == 2) nr = 256 * (n >> 7) + 128 + (n & 127); else if (mode == 3 && n >= 4096) { d = dst2; nr = n - 4096; }
        if (n < N) *(GAS v4u*)(d + (size_t)nr * K + k0 + 8 * c) = o; }
    LDS_WAIT(); asm volatile("" ::: "memory");
}
__device__ __forceinline__ void wconv_item8(const float* W, int K, int N, int item, int mode, const float* gain, float scale, unsigned char* dst, LAS float* scr, int lane) {
    const int nblk = N / 32, kb = item / nblk, nb = item % nblk, k0 = 64 * kb, n0 = 32 * nb;
    float wv_[32];
#pragma unroll
    for (int i = 0; i < 32; ++i) { const int kk = 2 * i + (lane >> 5); wv_[i] = ((const GAS float*)W)[(size_t)(k0 + kk) * N + n0 + (lane & 31)]; }
#pragma unroll
    for (int i = 0; i < 32; ++i) { const int kk = 2 * i + (lane >> 5); scr[kk * 33 + (lane & 31)] = wv_[i]; }
    LDS_WAIT(); asm volatile("" ::: "memory");
    const int c = lane & 7;
    float gv[8];
#pragma unroll
    for (int e = 0; e < 8; ++e) gv[e] = scale;
    if (gain) { const GAS float* gp = (const GAS float*)gain + k0 + 8 * c; const f32x4 g0 = *(const GAS f32x4*)gp, g1 = *(const GAS f32x4*)(gp + 4);
        gv[0] *= g0.x; gv[1] *= g0.y; gv[2] *= g0.z; gv[3] *= g0.w; gv[4] *= g1.x; gv[5] *= g1.y; gv[6] *= g1.z; gv[7] *= g1.w; }
#pragma unroll
    for (int j = 0; j < 4; ++j) { const int nl = (lane >> 3) + 8 * j, n = n0 + nl; const LAS float* s = scr + (8 * c) * 33 + nl;
        pg8::u32x2 o; o.x = pg8::cvt4_fp8(s[0 * 33] * gv[0], s[1 * 33] * gv[1], s[2 * 33] * gv[2], s[3 * 33] * gv[3]); o.y = pg8::cvt4_fp8(s[4 * 33] * gv[4], s[5 * 33] * gv[5], s[6 * 33] * gv[6], s[7 * 33] * gv[7]);
        int nr = n; if (mode == 1) nr = 256 * (n >> 7) + (n & 127); else if (mode == 2) nr = 256 * (n >> 7) + 128 + (n & 127);
        *(GAS pg8::u32x2*)(dst + (size_t)nr * K + k0 + 8 * c) = o; }
    LDS_WAIT(); asm volatile("" ::: "memory");
}
constexpr int FP8_SB13 = 5, FP8_SB2 = 6;
__device__ __forceinline__ void ffn_weights8(Frame& F, const float* w1, const float* w3, const float* w2, const float* gain, int gw, int NGW, LAS float* scr) {
    constexpr int I13 = (DMODEL / 64) * (DFF / 32), I2 = (DFF / 64) * (DMODEL / 32);
    unsigned char* W13 = F.ws + WS_W13; unsigned char* W2 = F.ws + WS_W2;
    for (int it = gw; it < 2 * I13 + I2; it += NGW) {
        int r = it;
        if (r < I13) { wconv_item8(w1, DMODEL, DFF, r, 1, gain, (float)(1 << FP8_SB13), W13, scr, F.lane); continue; } r -= I13;
        if (r < I13) { wconv_item8(w3, DMODEL, DFF, r, 2, gain, (float)(1 << FP8_SB13), W13, scr, F.lane); continue; } r -= I13;
        wconv_item8(w2, DFF, DMODEL, r, 0, nullptr, (float)(1 << FP8_SB2), W2, scr, F.lane);
    }
}
__device__ __forceinline__ void ffn_weights(Frame& F, const float* w1, const float* w3, const float* w2, const float* gain, int gw, int NGW, LAS float* scr) {
    constexpr int I13 = (DMODEL / 64) * (DFF / 32), I2 = (DFF / 64) * (DMODEL / 32);
    bf16* W13 = (bf16*)(F.ws + WS_W13); bf16* W2 = (bf16*)(F.ws + WS_W2);
    for (int it = gw; it < 2 * I13 + I2; it += NGW) {
        int r = it;
        if (r < I13) { wconv_item(w1, DMODEL, DFF, r, 1, gain, nullptr, W13, nullptr, scr, F.lane); continue; } r -= I13;
        if (r < I13) { wconv_item(w3, DMODEL, DFF, r, 2, gain, nullptr, W13, nullptr, scr, F.lane); continue; } r -= I13;
        wconv_item(w2, DFF, DMODEL, r, 0, nullptr, nullptr, W2, nullptr, scr, F.lane);
    }
}

__device__ __forceinline__ void ffn_weights_sel(Frame& F, const float* w1, const float* w3, const float* w2, const float* gain, int gw, int NGW, LAS float* scr, bool up8, bool dn8) {
    constexpr int I13 = (DMODEL / 64) * (DFF / 32), I2 = (DFF / 64) * (DMODEL / 32);
    for (int it = gw; it < 2 * I13 + I2; it += NGW) {
        int r = it;
        if (r < 2 * I13) { const bool third = r >= I13; const int rr = third ? r - I13 : r; const float* w = third ? w3 : w1;
            if (up8) wconv_item8(w, DMODEL, DFF, rr, third ? 2 : 1, gain, (float)(1 << FP8_SB13), F.ws + WS_W13, scr, F.lane);
            else wconv_item(w, DMODEL, DFF, rr, third ? 2 : 1, gain, nullptr, (bf16*)(F.ws + WS_W13), nullptr, scr, F.lane);
            continue; }
        r -= 2 * I13;
        if (dn8) wconv_item8(w2, DFF, DMODEL, r, 0, nullptr, (float)(1 << FP8_SB2), F.ws + WS_W2, scr, F.lane);
        else wconv_item(w2, DFF, DMODEL, r, 0, nullptr, nullptr, (bf16*)(F.ws + WS_W2), nullptr, scr, F.lane);
    }
}
__device__ __forceinline__ void p0_prologue(Frame& F) {
    LAS float* scr = (LAS float*)(F.lds + RING_OFF + F.wave * 16384);
    const int gw = F.vcu * NWAVES + F.wave, NGW = F.G * NWAVES;
    ffn_weights_sel(F, inp(2), inp(3), inp(4), inp(1), gw, NGW, scr, MK_FP8_FFN1 == 1 || MK_FP8_FFN1 == 2, MK_FP8_FFN1 == 1 || MK_FP8_FFN1 == 3);
    {
        constexpr int IIN = (DMODEL / 64) * ((NPROJ + 31) / 32), IOUT = (DMIX / 64) * (DMODEL / 32);
        for (int it = gw; it < IIN + IOUT; it += NGW) {
            if (it < IIN) wconv_item(inp(6), DMODEL, NPROJ, it, 3, inp(5), nullptr, (bf16*)(F.ws + WS_WIN), (bf16*)(F.ws + WS_WDT), scr, F.lane);
            else wconv_item(inp(14), DMIX, DMODEL, it - IIN, 0, inp(12), inp(13), (bf16*)(F.ws + WS_WOUT), nullptr, scr, F.lane);
        }
    }
    {
        float* cs = (float*)(F.ws + WS_CS);
        for (int i = (F.vcu * NWAVES * 64) + F.tid; i < SEQ * 8; i += F.G * NWAVES * 64) {
            const int pos = i >> 3, k = i & 7;
            const float inv = powf(500000.0f, -(float)k * 0.125f), ang = (float)pos * inv;
            cs[pos * 16 + k] = cosf(ang); cs[pos * 16 + 8 + k] = sinf(ang);
        }
    }
    {
        const float* x = inp(0); bf16* XB = (bf16*)(F.ws + WS_XB); float* ss0 = (float*)(F.ws + WS_SSX0);
        f32x4 v[4][4], nv[4][4];
#define P0_LOAD(dst, mm0) do { _Pragma("unroll") for (int r_ = 0; r_ < 4; ++r_) { const int m_ = (mm0) + r_ * NGW; const GAS f32x4* xr_ = (const GAS f32x4*)(x + (size_t)(m_ < T ? m_ : 0) * DMODEL) + F.lane; \
            _Pragma("unroll") for (int j_ = 0; j_ < 4; ++j_) dst[r_][j_] = xr_[64 * j_]; } } while (0)
        if (gw < T) P0_LOAD(v, gw);
        for (int m0 = gw; m0 < T; m0 += 4 * NGW) {
            const bool more = (m0 + 4 * NGW) < T;
            if (more) P0_LOAD(nv, m0 + 4 * NGW);
#pragma unroll
            for (int r = 0; r < 4; ++r) { const int m = m0 + r * NGW; if (m < T) { float s = 0.f;
#pragma unroll
                for (int j = 0; j < 4; ++j) s += (v[r][j].x * v[r][j].x + v[r][j].y * v[r][j].y) + (v[r][j].z * v[r][j].z + v[r][j].w * v[r][j].w);
                s = wave_sum(s);
                if (F.lane == 0) ss0[m] = s;
                GAS unsigned long long* o8 = (GAS unsigned long long*)(XB + (size_t)m * DMODEL) + F.lane;
#pragma unroll
                for (int j = 0; j < 4; ++j) o8[64 * j] = (unsigned long long)pkbf(v[r][j].x, v[r][j].y) | ((unsigned long long)pkbf(v[r][j].z, v[r][j].w) << 32);
#if MK_FP8_FFN1
                GAS unsigned* o4 = (GAS unsigned*)(F.ws + WS_XA8 + (size_t)m * DMODEL) + F.lane;
#pragma unroll
                for (int j = 0; j < 4; ++j) o4[64 * j] = pg8::cvt4_fp8(v[r][j].x, v[r][j].y, v[r][j].z, v[r][j].w);
#endif
            } }
            if (more) {
#pragma unroll
                for (int r = 0; r < 4; ++r)
#pragma unroll
                    for (int j = 0; j < 4; ++j) v[r][j] = nv[r][j]; }
        }
#undef P0_LOAD
    }
}

__device__ __forceinline__ void dt_proj(Frame& F) {
    const int gw = F.vcu * NWAVES + F.wave, NGW = F.G * NWAVES;
    const bf16* XB = (const bf16*)(F.ws + WS_XB); const bf16* Wdt = (const bf16*)(F.ws + WS_WDT); const float* ss1 = (const float*)(F.ws + ACC_SSX1); float* dtr = (float*)(F.ws + WS_DTRAW);
    const int fr = F.lane & 15, fq = F.lane >> 4;
    for (int it = gw; it < T / 16; it += NGW) {
        const int row0 = it * 16;
        f32x4 a0 = {0.f, 0.f, 0.f, 0.f}, a1 = {0.f, 0.f, 0.f, 0.f};
        const bf16* ap0 = XB + (size_t)(row0 + fr) * DMODEL + 8 * fq; const bf16* bp = Wdt + (size_t)fr * DMODEL + 8 * fq;
#pragma unroll 8
        for (int k = 0; k < DMODEL; k += 64) {
            const bf16x8 b0 = *(const GAS bf16x8*)(bp + k), x0 = *(const GAS bf16x8*)(ap0 + k), b1 = *(const GAS bf16x8*)(bp + k + 32), x1 = *(const GAS bf16x8*)(ap0 + k + 32);
            a0 = __builtin_amdgcn_mfma_f32_16x16x32_bf16(x0, b0, a0, 0, 0, 0);
            a1 = __builtin_amdgcn_mfma_f32_16x16x32_bf16(x1, b1, a1, 0, 0, 0);
        }
#pragma unroll
        for (int r = 0; r < 4; ++r) { const int t0 = row0 + 4 * fq + r; dtr[(size_t)t0 * 16 + fr] = (a0[r] + a1[r]) * rsqrtf(ss1[t0] * (1.0f / 1024.0f) + pg8::RMS_EPS); }
    }
}
__device__ __forceinline__ void glds16(const void* gsrc, LAS unsigned char* ldst) { __builtin_amdgcn_global_load_lds((const GAS unsigned*)gsrc, (LAS unsigned*)ldst, 16, 0, 0); }
template <class TT> __device__ __forceinline__ TT ldu(const void* ubase, unsigned voff) { return *(const GAS TT*)((const GAS char*)ubase + voff); }
#define LDS_BAR() asm volatile("s_waitcnt lgkmcnt(0)\n\ts_barrier" ::: "memory")
__device__ __forceinline__ void p4_conv(Frame& F, const int j0 = 0, const int j1 = 1 << 20) {
    const bf16* XBC = (const bf16*)(F.ws + WS_S); bf16* XT = (bf16*)(F.ws + WS_XT); bf16* BT = (bf16*)(F.ws + WS_BT); bf16* BC = (bf16*)((unsigned char*)F.out + DO_BC);
    const float* cw = inp(7); const float* cbias = inp(8);
    LAS bf16* U = (LAS bf16*)(F.lds + RING_OFF);
    LAS bf16* Vt = (LAS bf16*)(F.lds + RING_OFF + 34816);
    const int tid = F.tid;
    v4u pre[5];
#define P4_FETCH(uu) do { const int bc_ = (uu) / 24, cb_ = (uu) % 24, c_ = bc_ & 15, t0_ = bc_ * 256, ch0_ = cb_ * 64; \
        _Pragma("unroll") for (int k_ = 0; k_ < 5; ++k_) { const int i_ = tid + 512 * k_, rr_ = i_ >> 3, ck_ = i_ & 7; pre[k_] = (v4u){0u, 0u, 0u, 0u}; \
            if (i_ < 259 * 8 && !(c_ == 0 && rr_ < 3)) pre[k_] = *(const GAS v4u*)(XBC + (size_t)(t0_ - 3 + rr_) * DCONV + ch0_ + ck_ * 8); } } while (0)
    const int uend = (j1 >= (1 << 20)) ? 128 * 24 : min(128 * 24, F.vcu + j1 * (int)F.G);
    if (F.vcu + j0 * (int)F.G < uend) P4_FETCH(F.vcu + j0 * (int)F.G);
    for (int u = F.vcu + j0 * (int)F.G; u < uend; u += F.G) {
        const int bc = u / 24, cb = u % 24, t0 = bc * 256, ch0 = cb * 64;
#pragma unroll
        for (int k = 0; k < 5; ++k) { const int i = tid + 512 * k; if (i < 259 * 8) *(LAS v4u*)(U + (i >> 3) * 64 + (i & 7) * 8) = pre[k]; }
        const int ch_ = tid & 63, cg_ = ch0 + ch_;
        float w0 = cw[cg_], w1 = cw[DCONV + cg_], w2 = cw[2 * DCONV + cg_], w3 = cw[3 * DCONV + cg_], bb = cbias[cg_];
        asm volatile("" : "+v"(w0), "+v"(w1), "+v"(w2), "+v"(w3), "+v"(bb));
        LDS_BAR();
        if (u + F.G < uend) P4_FETCH(u + F.G);
        {   const int ch = tid & 63, tg = tid >> 6;
            float u0 = bf2f(U[(32 * tg) * 64 + ch]), u1 = bf2f(U[(32 * tg + 1) * 64 + ch]), u2 = bf2f(U[(32 * tg + 2) * 64 + ch]);
#pragma unroll 8
            for (int t = 32 * tg; t < 32 * tg + 32; ++t) {
                const float u3 = bf2f(U[(t + 3) * 64 + ch]);
                const float a = bb + w0 * u0 + w1 * u1 + w2 * u2 + w3 * u3;
                const float s = pg8::silu_f(a);
                Vt[t * 72 + ch] = (bf16)(pkbf(s, 0.f) & 0xffffu);
                u0 = u1; u1 = u2; u2 = u3;
            } }
        LDS_BAR();
        if (cb < 20) {
            bf16* dstT = cb < 16 ? XT + (size_t)((bc * 16 + cb) * 2) * 16 * 512 : BT + (size_t)(((bc * 2 + ((cb - 16) >> 1)) * 4 + ((cb - 16) & 1) * 2)) * 16 * 512;
#pragma unroll 1
            for (int j = 0; j < 4; ++j) { const int it = tid + 512 * j, r = it & 31, h = (it >> 5) & 1, kst = (it >> 6) & 15, pt = it >> 10, ch = 32 * pt + r;
                unsigned short e[8];
#pragma unroll
                for (int k = 0; k < 8; ++k) { const int tok = 16 * kst + perm16(8 * h + k); e[k] = Vt[tok * 72 + ch]; }
                v4u o; o.x = e[0] | ((unsigned)e[1] << 16); o.y = e[2] | ((unsigned)e[3] << 16); o.z = e[4] | ((unsigned)e[5] << 16); o.w = e[6] | ((unsigned)e[7] << 16);
                *(GAS v4u*)(dstT + ((size_t)(pt * 16 + kst) * 64 + h * 32 + r) * 8) = o; }
        }
        if (cb >= 16) {
            const int which = (cb - 16) >> 2, gg = ((cb - 16) >> 1) & 1, nh = (cb - 16) & 1;
            bf16* dstF = BC + (size_t)(((bc * 2 + gg) * 2 + which) * 64) * 512;
#pragma unroll 1
            for (int j = 0; j < 4; ++j) { const int it = tid + 512 * j, r = it & 31, h = (it >> 5) & 1, ksl = (it >> 6) & 3, tile = it >> 8;
                const v4u v = *(const LAS v4u*)(Vt + (32 * tile + r) * 72 + (2 * ksl + h) * 8);
                *(GAS v4u*)(dstF + ((size_t)(tile * 8 + 4 * nh + ksl) * 64 + h * 32 + r) * 8) = v; }
        }
        LDS_BAR();
    }
#undef P4_FETCH
}
__device__ __forceinline__ void p4_misc(Frame& F) {
    const int tid = F.tid; (void)tid;
    {   const int gw = F.vcu * NWAVES + F.wave, NGW = F.G * NWAVES;
        const float* dtr = (const float*)(F.ws + WS_DTRAW); float* dtH = (float*)(F.ws + WS_DTH); float* acsH = (float*)(F.ws + WS_ACSH);
        for (int it = gw; it < 128 * 16; it += NGW) {
            const int bc = it >> 4, hh = it & 15, b = bc >> 4, c = bc & 15;
            const float A = -__expf(inp(10)[hh]), bias = inp(9)[hh];
            f32x4 d, a; float run = 0.f;
            float xr_[4];
#pragma unroll
            for (int i = 0; i < 4; ++i) xr_[i] = ((const GAS float*)dtr)[(size_t)(bc * 256 + 4 * F.lane + i) * 16 + hh];
#pragma unroll
            for (int i = 0; i < 4; ++i) { const float x = xr_[i] + bias; const float sp = x > 20.f ? x : log1pf(__expf(x)); d[i] = sp; run += sp * A; a[i] = run; }
            float inc = run;
#pragma unroll
            for (int o = 1; o < 64; o <<= 1) { const float v = __shfl_up(inc, o); if (F.lane >= o) inc += v; }
            const float excl = inc - run;
#pragma unroll
            for (int i = 0; i < 4; ++i) a[i] += excl;
            const size_t off = (size_t)(b * 16 + hh) * SEQ + c * 256 + 4 * F.lane;
            *(GAS f32x4*)(dtH + off) = d; *(GAS f32x4*)(acsH + off) = a;
        }
#if MK_FP8
        ffn_weights8(F, inp(16), inp(17), inp(18), inp(15), gw, NGW, (LAS float*)(F.lds + RING_OFF + F.wave * 16384));
#else
        ffn_weights(F, inp(16), inp(17), inp(18), inp(15), gw, NGW, (LAS float*)(F.lds + RING_OFF + F.wave * 16384));
#endif
    }
}

__device__ __forceinline__ void ssd_states(Frame& F) {
    const bf16* XT = (const bf16*)(F.ws + WS_XT); const bf16* BT = (const bf16*)(F.ws + WS_BT); const float* dtH = (const float*)(F.ws + WS_DTH); const float* acsH = (const float*)(F.ws + WS_ACSH);
    float* ST = (float*)(F.ws + WS_ST);
    LAS unsigned char* L = F.lds + RING_OFF;
    const int lane = F.lane, w = F.wave, r32 = lane & 31, hi = lane >> 5;
    const unsigned o_f = (unsigned)lane * 16u;
    LAS float* dec = (LAS float*)(L + 65536 + w * 2048);
    for (int u = F.vcu; u < 256; u += F.G) {
        const int bc = u >> 1, g = u & 1, b = bc >> 4, c = bc & 15, hh = g * 8 + w;
        {   int ln0 = lane; asm volatile("" : "+v"(ln0));
            const bf16* BTu = BT + (size_t)((bc * 2 + g) * 4) * 16 * 512;
#pragma unroll
            for (int i = 0; i < 8; ++i) { const int f = w * 8 + i; glds16(BTu + (size_t)f * 512 + ln0 * 8, L + f * 1024); }
            const size_t o = (size_t)(b * 16 + hh) * SEQ + c * 256 + 4 * ln0;
            const f32x4 a4 = *(const GAS f32x4*)(acsH + o), d4 = *(const GAS f32x4*)(dtH + o);
            *(LAS f32x4*)(dec + 4 * ln0) = a4; *(LAS f32x4*)(dec + 256 + 4 * ln0) = d4;
            VM_WAIT(); LDS_WAIT(); __syncthreads(); }
        const float alast = dec[255];
        const bf16* xt = XT + (size_t)((bc * 16 + hh) * 2) * 16 * 512;
        f32x16 acc[2][4];
#pragma unroll
        for (int i = 0; i < 2; ++i)
#pragma unroll
            for (int j = 0; j < 4; ++j) acc[i][j] = f32x16{};
#pragma unroll 1
        for (int half = 0; half < 2; ++half) {
            bf16x8 xv[8][2];
#pragma unroll
            for (int k = 0; k < 8; ++k)
#pragma unroll
                for (int pt = 0; pt < 2; ++pt) xv[k][pt] = ldu<bf16x8>(xt + (size_t)(pt * 16 + 8 * half + k) * 512, o_f);
#pragma unroll
            for (int k = 0; k < 8; ++k) {
                const int ks = 8 * half + k;
                const f32x4 a0 = *(const LAS f32x4*)(dec + 16 * ks + 4 * hi), a1 = *(const LAS f32x4*)(dec + 16 * ks + 8 + 4 * hi);
                const f32x4 d0 = *(const LAS f32x4*)(dec + 256 + 16 * ks + 4 * hi), d1 = *(const LAS f32x4*)(dec + 256 + 16 * ks + 8 + 4 * hi);
                float wv[8];
#pragma unroll
                for (int j = 0; j < 4; ++j) { wv[j] = __expf(alast - a0[j]) * d0[j]; wv[4 + j] = __expf(alast - a1[j]) * d1[j]; }
                bf16x8 af[2];
#pragma unroll
                for (int pt = 0; pt < 2; ++pt) { const bf16x8 x = xv[k][pt];
                    v4u o; o.x = pkbf(bf2f(x[0]) * wv[0], bf2f(x[1]) * wv[1]); o.y = pkbf(bf2f(x[2]) * wv[2], bf2f(x[3]) * wv[3]); o.z = pkbf(bf2f(x[4]) * wv[4], bf2f(x[5]) * wv[5]); o.w = pkbf(bf2f(x[6]) * wv[6], bf2f(x[7]) * wv[7]);
                    af[pt] = __builtin_bit_cast(bf16x8, o); }
#pragma unroll
                for (int nt = 0; nt < 4; ++nt) { const bf16x8 bv = *(const LAS bf16x8*)(L + (nt * 16 + ks) * 1024 + lane * 16);
#pragma unroll
                    for (int pt = 0; pt < 2; ++pt) acc[pt][nt] = __builtin_amdgcn_mfma_f32_32x32x16_bf16(af[pt], bv, acc[pt][nt], 0, 0, 0); }
            }
        }
        GAS unsigned short* st = (GAS unsigned short*)ST + (size_t)(bc * 16 + hh) * 8192;
#pragma unroll
        for (int pt = 0; pt < 2; ++pt)
#pragma unroll
            for (int nt = 0; nt < 4; ++nt)
#pragma unroll
                for (int r = 0; r < 16; ++r) st[(32 * pt + crow(r, hi)) * 128 + 32 * nt + r32] = (unsigned short)(pkbf(acc[pt][nt][r], 0.f) & 0xffffu);
        __syncthreads();
    }
}

__device__ __forceinline__ void ssd_scan(Frame& F) {
    const float* ST = (const float*)(F.ws + WS_ST); bf16* SP = (bf16*)(F.ws + WS_SP); const float* acsH = (const float*)(F.ws + WS_ACSH);
    for (int gid = F.vcu * NWAVES * 64 + F.tid; gid < BATCH * 16 * 64 * 16; gid += F.G * NWAVES * 64) {
        const int n8 = gid & 15, p = (gid >> 4) & 63, hh = (gid >> 10) & 15, b = gid >> 14;
        float s[8];
#pragma unroll
        for (int j = 0; j < 8; ++j) s[j] = 0.f;
        const float* ap = acsH + (size_t)(b * 16 + hh) * SEQ + 255;
#pragma unroll 4
        for (int c = 0; c < NCHUNK; ++c) {
            const size_t off = (size_t)((b * 16 + c) * 16 + hh) * 8192 + p * 128 + n8 * 8;
            v4u o; o.x = pkbf(s[0], s[1]); o.y = pkbf(s[2], s[3]); o.z = pkbf(s[4], s[5]); o.w = pkbf(s[6], s[7]);
            *(GAS v4u*)(SP + ((size_t)(((b * 16 + c) * 16 + hh) * 2 + (p >> 5)) * 8 + (n8 >> 1)) * 512 + ((n8 & 1) * 32 + (p & 31)) * 8) = o;
            const float dec = __expf(ap[c * 256]);
            const v4u xs = *(const GAS v4u*)((const GAS unsigned short*)ST + off);
#pragma unroll
            for (int j = 0; j < 4; ++j) { s[2 * j] = dec * s[2 * j] + __uint_as_float(xs[j] << 16); s[2 * j + 1] = dec * s[2 * j + 1] + __uint_as_float(xs[j] & 0xffff0000u); }
        }
    }
}

__device__ __forceinline__ float reduce16x32(const float (&v)[16], int r32) {
    float a[8], b[4], c2[2];
    const bool b4 = r32 & 16, b3 = r32 & 8, b2 = r32 & 4, b1 = r32 & 2;
#pragma unroll
    for (int k = 0; k < 8; ++k) { const float keep = b4 ? v[8 + k] : v[k], send = b4 ? v[k] : v[8 + k]; a[k] = keep + shx(send, 16); }
#pragma unroll
    for (int k = 0; k < 4; ++k) { const float keep = b3 ? a[4 + k] : a[k], send = b3 ? a[k] : a[4 + k]; b[k] = keep + shx(send, 8); }
#pragma unroll
    for (int k = 0; k < 2; ++k) { const float keep = b2 ? b[2 + k] : b[k], send = b2 ? b[k] : b[2 + k]; c2[k] = keep + shx(send, 4); }
    const float keep = b1 ? c2[1] : c2[0], send = b1 ? c2[0] : c2[1];
    float d = keep + shx(send, 2);
    d += shx(d, 1);
    return d;
}
__device__ __forceinline__ float ssd_tile_out(const f32x16 (&y)[2], const u32x2v (&zq)[2][4], bf16* Ot, int r32_, int hi_) {
    int r32 = r32_, hi = hi_; asm volatile("" : "+v"(r32), "+v"(hi));
    const unsigned oo = (unsigned)(r32 * 1536 + 4 * hi) * 2u;
    float ssq = 0.f;
#pragma unroll
    for (int pt = 0; pt < 2; ++pt)
#pragma unroll
        for (int q = 0; q < 4; ++q) { const int p0 = 32 * pt + 8 * q;
            const u32x2v zz = zq[pt][q];
            const float v0 = y[pt][4 * q] * pg8::silu_f(__uint_as_float(zz.x << 16)), v1 = y[pt][4 * q + 1] * pg8::silu_f(__uint_as_float(zz.x & 0xffff0000u));
            const float v2 = y[pt][4 * q + 2] * pg8::silu_f(__uint_as_float(zz.y << 16)), v3 = y[pt][4 * q + 3] * pg8::silu_f(__uint_as_float(zz.y & 0xffff0000u));
            ssq += (v0 * v0 + v1 * v1) + (v2 * v2 + v3 * v3);
            u32x2v o; o.x = pkbf(v0, v1); o.y = pkbf(v2, v3);
            *(GAS u32x2v*)((GAS char*)(Ot + p0) + oo) = o; }
    return ssq;
}
#ifdef MK_STAMP
#define P7_STAMP(k) do { if (blockIdx.x == 0 && threadIdx.x == 0) __hip_atomic_store((unsigned long long*)(F.ws + 9 * MiB + 512 * 1024) + 32 + (k), rt(), __ATOMIC_RELAXED, __HIP_MEMORY_SCOPE_AGENT); } while (0)
#else
#define P7_STAMP(k) do {} while (0)
#endif
__device__ __forceinline__ void ssd_out(Frame& F, float* ssg) {
    const bf16* XT = (const bf16*)(F.ws + WS_XT); const bf16* BC = (const bf16*)((const unsigned char*)F.out + DO_BC); const bf16* SP = (const bf16*)(F.ws + WS_SP);
    const bf16* Z = (const bf16*)(F.ws + WS_Z); bf16* OY = (bf16*)((unsigned char*)F.out + DO_OY);
    const float* dtH = (const float*)(F.ws + WS_DTH); const float* acsH = (const float*)(F.ws + WS_ACSH);
    LAS unsigned char* L = F.lds + RING_OFF;
    const int lane = F.lane, w = F.wave, r32 = lane & 31, hi = lane >> 5;
    const unsigned o_f = (unsigned)lane * 16u, o_a = (unsigned)(4 * hi) * 4u, o_l = (unsigned)r32 * 4u;
    const int ltA = w, ltB = 7 - w;
    for (int u = F.vcu; u < 256; u += F.G) {
        const int bc = u >> 1, g = u & 1, b = bc >> 4, c = bc & 15, t0 = bc * 256;
        const bf16* BCu = BC + (size_t)(((bc * 2 + g) * 2) * 64) * 512;
        {
            int ln0 = lane; asm volatile("" : "+v"(ln0));
#pragma unroll
            for (int i = 0; i < 16; ++i) { const int f = w * 16 + i; glds16(BCu + (size_t)f * 512 + ln0 * 8, L + f * 1024); }
            P7_STAMP(0); VM_WAIT(); __syncthreads(); P7_STAMP(1); }
        unsigned cbp[9][8];
#pragma unroll
        for (int t = 0; t < 9; ++t) {
            const int lt = t <= w ? ltA : ltB, st = t <= w ? t : t - w - 1;
            f32x16 cb = f32x16{};
#pragma unroll
            for (int ks = 0; ks < 8; ++ks) { const bf16x8 bv = *(const LAS bf16x8*)(L + (st * 8 + ks) * 1024 + lane * 16), cv = *(const LAS bf16x8*)(L + 65536 + (lt * 8 + ks) * 1024 + lane * 16);
                cb = __builtin_amdgcn_mfma_f32_32x32x16_bf16(bv, cv, cb, 0, 0, 0); }
#pragma unroll
            for (int k = 0; k < 8; ++k) cbp[t][k] = pkbf(cb[2 * k], cb[2 * k + 1]);
        }
        P7_STAMP(2);
        __syncthreads();
        P7_STAMP(3);
        const bf16* xtg = XT + (size_t)((bc * 16 + 8 * g) * 2) * 16 * 512;
#define XT_ISSUE(it, slotp) do { int ln_ = lane; asm volatile("" : "+v"(ln_)); _Pragma("unroll") for (int i_ = 0; i_ < 8; ++i_) { const int f_ = w * 8 + i_, hl_ = (f_ < 32 ? 0 : 4) + (it); \
            glds16(xtg + ((size_t)hl_ * 32 + (f_ & 31)) * 512 + ln_ * 8, (slotp) + f_ * 1024); } } while (0)
        float ssA = 0.f, ssB = 0.f;
        LAS float* DEC = (LAS float*)(F.lds + TAB_OFF);
#pragma unroll 1
        for (int it = 0; it < 4; ++it) {
            if (it > 0) __syncthreads();
            XT_ISSUE(it, L);
            {   const int ps = F.tid >> 8, ix = F.tid & 255; const size_t o = (size_t)(b * 16 + 8 * g + 4 * ps + it) * SEQ + c * 256 + ix;
                DEC[ps * 512 + ix] = acsH[o]; DEC[ps * 512 + 256 + ix] = dtH[o]; }
            if (it == 0) P7_STAMP(4);
            VM_WAIT(); LDS_WAIT(); __syncthreads();
            if (it == 0) P7_STAMP(5);
            int dl_ = 4 * hi - r32; asm volatile("" : "+v"(dl_));
#pragma unroll
            for (int pass = 0; pass < 2; ++pass) {
                int wl = w; asm volatile("" : "+s"(wl));
                const int lt = pass ? 7 - wl : wl, hh = 8 * g + 4 * pass + it;
                const LAS unsigned char* slot = L + pass * 32768;
                const LAS float* ap = DEC + pass * 512; const LAS float* dp = ap + 256;
                const float Dh = inp(11)[hh];
                const bf16* sp = SP + (size_t)((bc * 16 + hh) * 2) * 8 * 512;
                f32x16 y[2];
                u32x2v zq[2][4];
                {   const bf16* Zt = Z + (size_t)(t0 + 32 * lt) * 1024 + hh * 64; const unsigned oz = (unsigned)(r32 * 1024 + 4 * hi) * 2u;
#pragma unroll
                    for (int pt = 0; pt < 2; ++pt)
#pragma unroll
                        for (int q = 0; q < 4; ++q) zq[pt][q] = ldu<u32x2v>(Zt + 32 * pt + 8 * q, oz); }
                {
                    bf16x8 sv[2][8];
#pragma unroll
                    for (int pt = 0; pt < 2; ++pt)
#pragma unroll
                        for (int k = 0; k < 8; ++k) sv[pt][k] = ldu<bf16x8>(sp + (size_t)(pt * 8 + k) * 512, o_f);
#pragma unroll
                    for (int pt = 0; pt < 2; ++pt) {
                        f32x16 a = f32x16{};
#pragma unroll
                        for (int k = 0; k < 8; ++k) { const bf16x8 ca = *(const LAS bf16x8*)(L + 65536 + (lt * 8 + k) * 1024 + lane * 16); a = __builtin_amdgcn_mfma_f32_32x32x16_bf16(sv[pt][k], ca, a, 0, 0, 0); }
                        y[pt] = a;
                    }
                    asm volatile("" ::: "memory");
                }
                const float al = ap[32 * lt + r32];
                { const float ea = __expf(al); y[0] = y[0] * ea; y[1] = y[1] * ea; }
#pragma unroll
                for (int t = 0; t < 9; ++t) {
                    const bool mine = pass ? (t > wl) : (t <= wl);
                    if (mine) {
                        const int st = pass ? t - wl - 1 : t;
                        const bool diag = (st == lt);
#pragma unroll
                        for (int s2 = 0; s2 < 2; ++s2) {
                            float mv[8];
#pragma unroll
                            for (int q2 = 0; q2 < 2; ++q2) { const int q = 2 * s2 + q2;
                                const f32x4 as = *(const LAS f32x4*)(ap + 32 * st + 8 * q + 4 * hi), ds = *(const LAS f32x4*)(dp + 32 * st + 8 * q + 4 * hi);
                                float cbv[4];
#pragma unroll
                                for (int j = 0; j < 2; ++j) { unsigned pw = cbp[t][2 * q + j]; asm volatile("" : "+v"(pw));
                                    cbv[2 * j] = __uint_as_float(pw << 16); cbv[2 * j + 1] = __uint_as_float(pw & 0xffff0000u); }
#pragma unroll
                                for (int i = 0; i < 4; ++i) {
                                    float m = cbv[i] * __expf(al - as[i]) * ds[i];
                                    if (diag) { m = (dl_ > -(8 * q + i)) ? 0.f : m; m = (dl_ == -(8 * q + i)) ? m + Dh : m; }
                                    mv[4 * q2 + i] = m; } }
                            v4u o; o.x = pkbf(mv[0], mv[1]); o.y = pkbf(mv[2], mv[3]); o.z = pkbf(mv[4], mv[5]); o.w = pkbf(mv[6], mv[7]);
                            const bf16x8 mf = __builtin_bit_cast(bf16x8, o);
#pragma unroll
                            for (int pt = 0; pt < 2; ++pt) { const bf16x8 xv = *(const LAS bf16x8*)(slot + (pt * 16 + 2 * st + s2) * 1024 + lane * 16);
                                y[pt] = __builtin_amdgcn_mfma_f32_32x32x16_bf16(xv, mf, y[pt], 0, 0, 0); }
                        }
                        asm volatile("" ::: "memory");
                    }
                }
                const float s_ = ssd_tile_out(y, zq, OY + (size_t)(t0 + 32 * lt) * 1536 + 512 + hh * 64, r32, hi);
                if (pass) ssB += s_; else ssA += s_;
                if (it == 0) P7_STAMP(6 + pass);
                asm volatile("" ::: "memory");
            }
        }
#undef XT_ISSUE
        P7_STAMP(8);
        ssA = sum32(ssA); ssB = sum32(ssB);
        if (hi == 0) { atomicAdd(ssg + (size_t)(t0 + 32 * ltA + r32) * 2 + g, ssA); atomicAdd(ssg + (size_t)(t0 + 32 * ltB + r32) * 2 + g, ssB); }
        __syncthreads();
    }
}

__device__ __forceinline__ void final_norm(Frame& F) {
    const int gw = F.vcu * NWAVES + F.wave, NGW = F.G * NWAVES;
    const float* ss3 = (const float*)(F.ws + ACC_SSX3); const float* gn = inp(19); const bf16* XB = (const bf16*)(F.ws + WS_XB);
    f32x4 gv[4];
#pragma unroll
    for (int j = 0; j < 4; ++j) gv[j] = *(const GAS f32x4*)(gn + 4 * F.lane + 256 * j);
    u32x2v w[4][4], nw[4][4]; float rs[4], nrs[4];
#define P11_LOAD(dw, drs, mm0) do { _Pragma("unroll") for (int r_ = 0; r_ < 4; ++r_) { const int m_ = (mm0) + r_ * NGW, mc_ = m_ < T ? m_ : 0; const GAS u32x2v* xb_ = (const GAS u32x2v*)(XB + (size_t)mc_ * DMODEL) + F.lane; \
        _Pragma("unroll") for (int j_ = 0; j_ < 4; ++j_) dw[r_][j_] = xb_[64 * j_]; drs[r_] = ss3[mc_]; } } while (0)
    if (gw < T) P11_LOAD(w, rs, gw);
    for (int m0 = gw; m0 < T; m0 += 4 * NGW) {
        const bool more = (m0 + 4 * NGW) < T;
        if (more) P11_LOAD(nw, nrs, m0 + 4 * NGW);
#pragma unroll
        for (int r = 0; r < 4; ++r) { const int m = m0 + r * NGW; if (m < T) { GAS f32x4* xr = (GAS f32x4*)(F.out + (size_t)m * DMODEL) + F.lane;
            const float rr = rsqrtf(rs[r] * (1.0f / 1024.0f) + pg8::RMS_EPS);
#pragma unroll
            for (int j = 0; j < 4; ++j) { const f32x4 v = {__uint_as_float(w[r][j].x << 16), __uint_as_float(w[r][j].x & 0xffff0000u), __uint_as_float(w[r][j].y << 16), __uint_as_float(w[r][j].y & 0xffff0000u)}; xr[64 * j] = v * gv[j] * rr; } } }
        if (more) {
#pragma unroll
            for (int r = 0; r < 4; ++r) { rs[r] = nrs[r];
#pragma unroll
                for (int j = 0; j < 4; ++j) w[r][j] = nw[r][j]; } }
    }
#undef P11_LOAD
}

__device__ __forceinline__ void final_norm_panel(Frame& F, int pm) {
    const float* ss3 = (const float*)(F.ws + ACC_SSX3); const float* gn = inp(19); const bf16* XB = (const bf16*)(F.ws + WS_XB);
    f32x4 gv[4];
#pragma unroll
    for (int j = 0; j < 4; ++j) gv[j] = *(const GAS f32x4*)(gn + 4 * F.lane + 256 * j);
#pragma unroll 1
    for (int t = 0; t < 8; ++t) {
        u32x2v w[4][4]; float rs[4];
#pragma unroll
        for (int r = 0; r < 4; ++r) { const int m = pm * 256 + F.wave + 8 * (4 * t + r); const GAS u32x2v* xb = (const GAS u32x2v*)(XB + (size_t)m * DMODEL) + F.lane;
#pragma unroll
            for (int j = 0; j < 4; ++j) w[r][j] = xb[64 * j];
            rs[r] = ((const GAS float*)ss3)[m]; }
#pragma unroll
        for (int r = 0; r < 4; ++r) { const int m = pm * 256 + F.wave + 8 * (4 * t + r); GAS f32x4* xr = (GAS f32x4*)(F.out + (size_t)m * DMODEL) + F.lane;
            const float rr = rsqrtf(rs[r] * (1.0f / 1024.0f) + pg8::RMS_EPS);
#pragma unroll
            for (int j = 0; j < 4; ++j) { const f32x4 v = {__uint_as_float(w[r][j].x << 16), __uint_as_float(w[r][j].x & 0xffff0000u), __uint_as_float(w[r][j].y << 16), __uint_as_float(w[r][j].y & 0xffff0000u)}; xr[64 * j] = v * gv[j] * rr; } }
    }
}
#ifndef MK_DUP
#define MK_DUP 0
#endif
constexpr size_t WS_DUMMY = 9 * MiB;
#define DUPN(k) (((MK_DUP >> (k)) & 1) ? 2 : 1)
__global__ void __launch_bounds__(NWAVES * 64, 2) mk_fwd(Args args) {
    extern __shared__ __attribute__((aligned(16))) unsigned char lds[];
    Frame F;
    F.lds = (LAS unsigned char*)lds;
    F.MISC = (volatile LAS unsigned*)(F.lds + MISC_OFF);
    F.tid = threadIdx.x; F.lane = F.tid & 63; F.wave = __builtin_amdgcn_readfirstlane(F.tid >> 6);
    F.G = gridDim.x; { const int bx = blockIdx.x; F.vcu = (F.G % 8 == 0) ? (bx % 8) * (F.G / 8) + bx / 8 : bx; }
    F.ws = args.ws; F.out = args.out; F.ctl = (gu32*)(args.ws + WS_CTL);
    for (int u = F.tid; u < (LDS_BYTES - LDSCTL_OFF) / 4; u += NWAVES * 64) ((LAS unsigned*)(F.lds + LDSCTL_OFF))[u] = 0u;
    __syncthreads();
#ifdef MK_STAMP
    const unsigned long long t_start_ = rt();
#endif
    XcdBarrier bar = xcd_barrier_post((unsigned*)(F.ctl + CW_BAR), F.MISC + 8);
#ifdef MK_STAMP
    int n_stamp_ = 0;
#define GRID_BAR() do { xcd_barrier(bar); if (blockIdx.x == 0 && threadIdx.x == 0) __hip_atomic_store((unsigned long long*)(args.ws + WS_DUMMY + 512 * 1024) + n_stamp_, rt(), __ATOMIC_RELAXED, __HIP_MEMORY_SCOPE_AGENT); ++n_stamp_; } while (0)
#else
#define GRID_BAR() xcd_barrier(bar)
#endif
#define PH_BEGIN() \
    { int t_ = threadIdx.x; asm volatile("" : "+v"(t_)); F.tid = t_; F.lane = t_ & 63; F.wave = __builtin_amdgcn_readfirstlane(t_ >> 6); } \
    int z_ = 0; asm volatile("" : "+s"(z_)); unsigned char* ws = args.ws + z_; F.ws = ws; F.out = args.out + z_; \
    bf16* XB = (bf16*)(ws + WS_XB); bf16* W13 = (bf16*)(ws + WS_W13); bf16* W2 = (bf16*)(ws + WS_W2); bf16* HB = (bf16*)(ws + WS_R); \
    float* ss0 = (float*)(ws + WS_SSX0); float* ss1 = (float*)(ws + ACC_SSX1); float* ss2 = (float*)(ws + ACC_SSX2); float* ss3 = (float*)(ws + ACC_SSX3); \
    float* ssa = (float*)(ws + ACC_SSA); float* ssg = (float*)(ws + ACC_SSG); float* km = (float*)(ws + ACC_KM); bf16* OY = (bf16*)((unsigned char*)F.out + DO_OY); \
    (void)XB; (void)W13; (void)W2; (void)HB; (void)ss0; (void)ss1; (void)ss2; (void)ss3; (void)ssa; (void)ssg; (void)km; (void)OY;
    const int bx = (int)blockIdx.x;

    for (int rep = 0; rep < DUPN(0); ++rep) { PH_BEGIN(); p0_prologue(F); GRID_BAR(); }
#if MK_FP8_FFN1
    {   PH_BEGIN();
#if MK_FP8_FFN1 == 3
        pg8::Gemm g{XB, W13, T, 2 * DFF, DMODEL}; pg8::StaticOrder S; S.init(T, 2 * DFF, F.G, bx);
        pg8::EpiSwigluT<true, 0> E{HB, ss0, DFF};
        pg8::gemm_phase<pg8::EpiSwigluT<true, 0>, pg8::StaticOrder, true, true, false>(F.lds + RING_OFF, g, S, E);
#elif MK_FP8_FFN1 == 2
        pg8::Gemm g{(bf16*)(ws + WS_XA8), W13, T, 2 * DFF, DMODEL / 2}; pg8::StaticOrder S; S.init(T, 2 * DFF, F.G, bx);
        pg8::EpiSwigluT<false, FP8_SB13> E{HB, ss0, DFF};
        pg8::gemm_phase<pg8::EpiSwigluT<false, FP8_SB13>, pg8::StaticOrder, true, true, true>(F.lds + RING_OFF, g, S, E);
#else
        pg8::Gemm g{(bf16*)(ws + WS_XA8), W13, T, 2 * DFF, DMODEL / 2}; pg8::StaticOrder S; S.init(T, 2 * DFF, F.G, bx);
        pg8::EpiSwigluT<true, FP8_SB13> E{HB, ss0, DFF}; E.rt = (PG8_LAS float*)(F.lds + TAB_OFF);
        pg8::gemm_phase<pg8::EpiSwigluT<true, FP8_SB13>, pg8::StaticOrder, true, true, true>(F.lds + RING_OFF, g, S, E);
#endif
    }
    GRID_BAR();
    {   PH_BEGIN();
#if MK_FP8_FFN1 == 2
        pg8::Gemm g{HB, W2, T, DMODEL, DFF}; pg8::StaticOrder S; S.init(T, DMODEL, F.G, bx);
        pg8::EpiResid<false> E{XB, ss1, 0.5f, nullptr, nullptr, nullptr, nullptr};
        pg8::gemm_phase<pg8::EpiResid<false>, pg8::StaticOrder, true, true>(F.lds + RING_OFF, g, S, E);
#else
        pg8::Gemm g{HB, W2, T, DMODEL, DFF / 2}; pg8::StaticOrder S; S.init(T, DMODEL, F.G, bx);
        pg8::EpiResid<false, FP8_SB2> E{XB, ss1, 0.5f, nullptr, nullptr, nullptr, nullptr};
        pg8::gemm_phase<pg8::EpiResid<false, FP8_SB2>, pg8::StaticOrder, true, true, true>(F.lds + RING_OFF, g, S, E);
#endif
    }
    GRID_BAR();
#else
    {   PH_BEGIN(); pg8::Gemm g{XB, W13, T, 2 * DFF, DMODEL}; pg8::StaticOrder S; S.init(T, 2 * DFF, F.G, bx);
        pg8::EpiSwiglu E{HB, ss0, DFF}; E.rt = (PG8_LAS float*)(F.lds + TAB_OFF);
        if ((MK_DUP >> 18) & 1) { pg8::EpiNull E0{(float*)(ws + WS_DUMMY)}; pg8::gemm_phase<pg8::EpiNull, pg8::StaticOrder, true, true>(F.lds + RING_OFF, g, S, E0); GRID_BAR(); }
        if ((MK_DUP >> 23) & 1) { pg8::EpiNull E0{(float*)(ws + WS_DUMMY)}; pg8::gemm_phase<pg8::EpiNull, pg8::StaticOrder, true, true, false, true>(F.lds + RING_OFF, g, S, E0); GRID_BAR(); }
        if ((MK_DUP >> 22) & 1) { pg8::EpiSwiglu E0{HB, ss0, DFF}; pg8::gemm_phase<pg8::EpiSwiglu, pg8::StaticOrder, true, true>(F.lds + RING_OFF, g, S, E0); GRID_BAR(); }
        for (int rep = 0; rep < DUPN(1); ++rep) { pg8::gemm_phase<pg8::EpiSwiglu, pg8::StaticOrder, true, true>(F.lds + RING_OFF, g, S, E); GRID_BAR(); } }
    {   PH_BEGIN(); pg8::Gemm g{HB, W2, T, DMODEL, DFF}; pg8::StaticOrder S; S.init(T, DMODEL, F.G, bx);
        for (int rep = 0; rep < DUPN(2); ++rep) { pg8::EpiResid<false> E{rep ? (bf16*)(ws + WS_S) : XB, rep ? (float*)(ws + WS_DUMMY) : ss1, 0.5f, nullptr, nullptr, nullptr, nullptr};
        pg8::gemm_phase<pg8::EpiResid<false>, pg8::StaticOrder, true, true>(F.lds + RING_OFF, g, S, E); GRID_BAR(); }
        if ((MK_DUP >> 14) & 1) { pg8::EpiSwiglu E2{(bf16*)(ws + WS_S), ss0, 512}; pg8::gemm_phase<pg8::EpiSwiglu, pg8::StaticOrder, true, true>(F.lds + RING_OFF, g, S, E2); GRID_BAR(); } }
#endif
    {   PH_BEGIN(); pg8::Gemm g{XB, (bf16*)(ws + WS_WIN), T, 4096, DMODEL}; pg8::StaticOrder S; S.init(T, 4096, F.G, bx);
        if ((MK_DUP >> 16) & 1) { pg8::EpiSwiglu E2{HB, ss0, DFF}; pg8::gemm_phase<pg8::EpiSwiglu, pg8::StaticOrder, true, true>(F.lds + RING_OFF, g, S, E2); GRID_BAR(); }
        if ((MK_DUP >> 20) & 1) { pg8::EpiProjT<MK_LITE> E2{(bf16*)(ws + WS_Q), (bf16*)(ws + WS_K), (bf16*)(ws + WS_V), (bf16*)(ws + WS_Z), (bf16*)(ws + WS_S), ss1, (const float*)(ws + WS_CS), (float*)(ws + WS_DUMMY), attn_body::C2}; pg8::gemm_phase<pg8::EpiProjT<MK_LITE>, pg8::StaticOrder, true, true>(F.lds + RING_OFF, g, S, E2); GRID_BAR(); }
        if ((MK_DUP >> 17) & 1) { pg8::EpiProjT<1> E2{(bf16*)(ws + WS_Q), (bf16*)(ws + WS_K), (bf16*)(ws + WS_V), (bf16*)(ws + WS_Z), (bf16*)(ws + WS_S), ss1, (const float*)(ws + WS_CS), (float*)(ws + WS_DUMMY), attn_body::C2}; pg8::gemm_phase<pg8::EpiProjT<1>, pg8::StaticOrder, true, true>(F.lds + RING_OFF, g, S, E2); GRID_BAR(); }
        for (int rep = 0; rep < DUPN(3); ++rep) { pg8::EpiProj E{(bf16*)(ws + WS_Q), (bf16*)(ws + WS_K), (bf16*)(ws + WS_V), (bf16*)(ws + WS_Z), (bf16*)(ws + WS_S), ss1, (const float*)(ws + WS_CS), rep ? (float*)(ws + WS_DUMMY) : km, attn_body::C2};
        pg8::gemm_phase<pg8::EpiProj, pg8::StaticOrder, true, true>(F.lds + RING_OFF, g, S, E);
        dt_proj(F); if ((MK_DUP >> 19) & 1) { dt_proj(F); dt_proj(F); dt_proj(F); dt_proj(F); } GRID_BAR(); } }
#if MK_MERGE45
#pragma unroll 1
    for (int seg = 0; seg < 4; ++seg) {   PH_BEGIN();
        const int pat = (F.vcu >> 5) & 1, ncu = (128 * 24 + (int)F.G - 1) / (int)F.G, nh = (ncu + 1) >> 1;
        if ((seg & 1) == pat) p4_conv(F, (seg >> 1) * nh, (seg >> 1) ? ncu : nh);
        else { const attn_body::AttnTensors AT{(const attn_body::bf16*)(ws + WS_Q), (const attn_body::bf16*)(ws + WS_K), (const attn_body::bf16*)(ws + WS_V), (attn_body::bf16*)OY, km, ssa};
            const attn_body::StaticOrder S((int)F.G, F.vcu);
            attn_body::attn_range<attn_body::StaticOrder>((char*)lds + RING_OFF, AT, S, (seg >> 1) * 2, (seg >> 1) * 2 + 2); }
        __syncthreads();
    }
    {   PH_BEGIN(); p4_misc(F); GRID_BAR(); }
    {   PH_BEGIN(); ssd_states(F); GRID_BAR(); }
#else
    for (int rep = 0; rep < DUPN(4); ++rep) { PH_BEGIN(); p4_conv(F);
#ifdef MK_SPLIT4
        GRID_BAR();
#endif
        p4_misc(F); GRID_BAR(); }
    for (int rep = 0; rep < DUPN(5); ++rep) {   PH_BEGIN();
        const bool last = (rep == DUPN(5) - 1);
        const attn_body::AttnTensors AT{(const attn_body::bf16*)(ws + WS_Q), (const attn_body::bf16*)(ws + WS_K), (const attn_body::bf16*)(ws + WS_V), (attn_body::bf16*)OY, km, last ? ssa : (float*)(ws + WS_DUMMY)};
        const attn_body::StaticOrder S((int)F.G, F.vcu);
        if (last) attn_body::attn_phase<attn_body::StaticOrder>((char*)lds + RING_OFF, AT, S);
        else if (!((MK_DUP >> 12) & 1)) { if ((MK_DUP >> 15) & 1) attn_body::attn_phase<attn_body::StaticOrder, false>((char*)lds + RING_OFF, AT, S); else attn_body::attn_phase<attn_body::StaticOrder>((char*)lds + RING_OFF, AT, S); }
#ifdef MK_SPLIT5
        GRID_BAR();
#endif
        if (!((MK_DUP >> 13) & 1) || last) ssd_states(F);
        GRID_BAR(); }
#endif
#ifdef MK_XBAR
    for (int xb_ = 0; xb_ < MK_XBAR; ++xb_) GRID_BAR();
#endif
    for (int rep = 0; rep < DUPN(6); ++rep) { PH_BEGIN(); ssd_scan(F); GRID_BAR(); }
    for (int rep = 0; rep < DUPN(7); ++rep) { PH_BEGIN(); ssd_out(F, rep ? (float*)(ws + WS_DUMMY) : ssg); GRID_BAR(); }
    {   PH_BEGIN(); pg8::Gemm g{OY, (bf16*)(ws + WS_WOUT), T, DMODEL, DMIX}; pg8::StaticOrder S; S.init(T, DMODEL, F.G, bx);
        if ((MK_DUP >> 21) & 1) { pg8::EpiSwiglu E2{HB, ss0, 512}; pg8::gemm_phase<pg8::EpiSwiglu, pg8::StaticOrder, true, true>(F.lds + RING_OFF, g, S, E2); GRID_BAR(); }
        if (DUPN(8) == 2) { pg8::EpiResid<true> E{HB, (float*)(ws + WS_DUMMY), 1.0f, ssa, ssg, (PG8_LAS float*)(F.lds + TAB_OFF), nullptr};
        pg8::gemm_phase<pg8::EpiResid<true>, pg8::StaticOrder, true, true>(F.lds + RING_OFF, g, S, E); GRID_BAR(); }
        pg8::EpiResid<true> E{XB, ss2, 1.0f, ssa, ssg, (PG8_LAS float*)(F.lds + TAB_OFF), MK_FP8 ? (unsigned char*)(ws + WS_XA8) : nullptr};
        pg8::gemm_phase<pg8::EpiResid<true>, pg8::StaticOrder, true, true>(F.lds + RING_OFF, g, S, E); }
    GRID_BAR();
#if MK_FP8
    {   PH_BEGIN(); pg8::Gemm g{(bf16*)(ws + WS_XA8), W13, T, 2 * DFF, DMODEL / 2}; pg8::StaticOrder S; S.init(T, 2 * DFF, F.G, bx);
        pg8::EpiSwigluT<true, FP8_SB13> E{HB, ss2, DFF}; E.rt = (PG8_LAS float*)(F.lds + TAB_OFF);
        pg8::gemm_phase<pg8::EpiSwigluT<true, FP8_SB13>, pg8::StaticOrder, true, MK_SP2_FP8, true>(F.lds + RING_OFF, g, S, E); }
    GRID_BAR();
    {   PH_BEGIN(); pg8::Gemm g{HB, W2, T, DMODEL, DFF / 2}; pg8::StaticOrder S; S.init(T, DMODEL, F.G, bx);
        pg8::EpiResid<false, FP8_SB2> E{XB, ss3, 0.5f, nullptr, nullptr, nullptr, nullptr};
        pg8::gemm_phase<pg8::EpiResid<false, FP8_SB2>, pg8::StaticOrder, true, MK_SP2_FP8, true>(F.lds + RING_OFF, g, S, E);
#if MK_FUSE_FINAL
        { int t_ = threadIdx.x; asm volatile("" : "+v"(t_)); F.tid = t_; F.lane = t_ & 63; F.wave = __builtin_amdgcn_readfirstlane(t_ >> 6); }
        __threadfence();
        __syncthreads();
        if (F.tid == 0) { unsigned m_ = 0u; pg8::Unit u_;
            for (int i = 0; i < 2; ++i) if (S.next(i, u_)) { const unsigned old_ = __hip_atomic_fetch_add((unsigned*)(F.ctl + CW_PANEL) + 64 * u_.pm, 1u, __ATOMIC_RELAXED, __HIP_MEMORY_SCOPE_AGENT); if (old_ == 3u) m_ |= 1u << i; }
            F.MISC[16] = m_; }
        __syncthreads();
        const unsigned mine_ = F.MISC[16];
        if (mine_) { __threadfence();
            pg8::Unit u_;
            for (int i = 0; i < 2; ++i) if (((mine_ >> i) & 1u) && S.next(i, u_)) final_norm_panel(F, u_.pm); }
#endif
    }
#if !MK_FUSE_FINAL
    GRID_BAR();
#endif
#else
    {   PH_BEGIN(); pg8::Gemm g{XB, W13, T, 2 * DFF, DMODEL}; pg8::StaticOrder S; S.init(T, 2 * DFF, F.G, bx);
        pg8::EpiSwiglu E{HB, ss2, DFF};
        pg8::gemm_phase<pg8::EpiSwiglu, pg8::StaticOrder, true, true>(F.lds + RING_OFF, g, S, E); }
    GRID_BAR();
    {   PH_BEGIN(); pg8::Gemm g{HB, W2, T, DMODEL, DFF}; pg8::StaticOrder S; S.init(T, DMODEL, F.G, bx);
        pg8::EpiResid<false> E{XB, ss3, 0.5f, nullptr, nullptr, nullptr, nullptr};
        pg8::gemm_phase<pg8::EpiResid<false>, pg8::StaticOrder, true, true>(F.lds + RING_OFF, g, S, E); }
    GRID_BAR();
#endif
#if !(MK_FP8 && MK_FUSE_FINAL)
    { PH_BEGIN(); final_norm(F); }
#endif
#ifdef MK_STAMP
    GRID_BAR();
    if (blockIdx.x == 0 && threadIdx.x == 0) { asm volatile("s_waitcnt vmcnt(0)" ::: "memory"); const unsigned long long* st_ = (const unsigned long long*)(args.ws + WS_DUMMY + 512 * 1024);
#ifdef MK_SA
        const unsigned long long t1_ = __hip_atomic_load(st_ + MK_SA, __ATOMIC_RELAXED, __HIP_MEMORY_SCOPE_AGENT), t0_ = __hip_atomic_load(st_ + MK_SB, __ATOMIC_RELAXED, __HIP_MEMORY_SCOPE_AGENT);
#else
        const unsigned long long t1_ = __hip_atomic_load(st_ + MK_STAMP, __ATOMIC_RELAXED, __HIP_MEMORY_SCOPE_AGENT), t0_ = MK_STAMP > 0 ? __hip_atomic_load(st_ + MK_STAMP - 1, __ATOMIC_RELAXED, __HIP_MEMORY_SCOPE_AGENT) : t_start_;
#endif
        args.out[0] = 8.0f + (float)(t1_ - t0_) * (0.01f / MK_STAMP_DIV); }
#endif
#undef GRID_BAR
}

extern "C" void kernel_launch(void* const* d_in, const int* in_sizes, int n_in, void* d_out, int out_size, void* d_ws, size_t ws_size, hipStream_t stream) {
    static int grid = 0;
    if (grid == 0) {
        if (n_in != 20 || in_sizes[0] != T * DMODEL || out_size != T * DMODEL || ws_size < WS_END) { fprintf(stderr, "kernel_launch: unexpected shapes (n_in %d, in0 %d, out %d, ws %zu)\n", n_in, n_in > 0 ? in_sizes[0] : -1, out_size, ws_size); grid = -1; return; }
        int dev = 0, cus = 0, per_cu = 0;
        if (hipGetDevice(&dev) != hipSuccess || hipDeviceGetAttribute(&cus, hipDeviceAttributeMultiprocessorCount, dev) != hipSuccess) { grid = -1; return; }
        if (hipFuncSetAttribute((const void*)mk_fwd, hipFuncAttributeMaxDynamicSharedMemorySize, LDS_BYTES) != hipSuccess) { fprintf(stderr, "kernel_launch: hipFuncSetAttribute failed\n"); grid = -1; return; }
        if (hipOccupancyMaxActiveBlocksPerMultiprocessor(&per_cu, (const void*)mk_fwd, NWAVES * 64, LDS_BYTES) != hipSuccess || per_cu < 1) { fprintf(stderr, "kernel_launch: occupancy query says %d blocks per CU\n", per_cu); per_cu = 1; }
        (void)hipGetLastError();
        grid = cus;
        fprintf(stderr, "kernel_launch: grid %d (occupancy query %d per CU), ws %zu\n", grid, per_cu, ws_size);
    }
    if (grid < 0) return;
    if (hipMemsetAsync((char*)d_ws + WS_CTL, 0, CTL_ZERO_BYTES, stream) != hipSuccess) { fprintf(stderr, "kernel_launch: memset failed\n"); return; }
    Args a{};
    for (int i = 0; i < 20; ++i) a.in[i] = (const float*)d_in[i];
    a.out = (float*)d_out; a.ws = (unsigned char*)d_ws;
    hipLaunchKernelGGL(mk_fwd, dim3(grid), dim3(NWAVES * 64), LDS_BYTES, stream, a);
    const hipError_t le = hipPeekAtLastError();
    if (le != hipSuccess) fprintf(stderr, "kernel_launch: launch failed: %s\n", hipGetErrorName(le));
}
```
